# Optimizing an MI355X kernel written in HIP

```python
import math
import jax
import jax.numpy as jnp
from jax import lax
import numpy as np


D_MODEL = 2048
BATCH = 8
SEQ = 2048
DEPTH = 1

MEM_LEN = 256
MIX_WIDTH = D_MODEL
MOBA_WIDTH = MIX_WIDTH // 2
MOBA_HEADS = 8
MOBA_HEAD_DIM = MOBA_WIDTH // MOBA_HEADS
MOBA_BLOCK = 256
MOBA_TOPK = 3
MOBA_Q_CHUNK = 16
GLA_WIDTH = MIX_WIDTH - MOBA_WIDTH
GLA_HEADS = 4
GLA_KEY_DIM = GLA_WIDTH // (2 * GLA_HEADS)
GLA_VAL_DIM = GLA_WIDTH // GLA_HEADS
GLA_GATE_RANK = 16
GLA_GATE_TAU = 16.0
GLA_CHUNK = 64
XATTN_HEADS = 4
XATTN_HEAD_DIM = D_MODEL // XATTN_HEADS
PEER_HEADS = 8
PEER_N_KEYS = 128
PEER_N_EXPERTS = PEER_N_KEYS * PEER_N_KEYS
PEER_QUERY_DIM = 256
PEER_TOPK = 16
PEER_TOKEN_CHUNK = 128
DEEPNORM_ALPHA = (2.0 * DEPTH) ** 0.25
DEEPNORM_BETA = (8.0 * DEPTH) ** -0.25
LN_EPS = 1e-5
RMS_EPS = 1e-6
NEG_INF = -1e30
W_IN_SIZES = (MOBA_WIDTH, MOBA_WIDTH, MOBA_WIDTH, GLA_HEADS * GLA_KEY_DIM, GLA_HEADS * GLA_KEY_DIM, GLA_WIDTH, GLA_WIDTH, GLA_GATE_RANK)
W_IN_COLS = 3 * MOBA_WIDTH + 2 * GLA_HEADS * GLA_KEY_DIM + 2 * GLA_WIDTH + GLA_GATE_RANK

kernel_name = 'hybrid_moba_gla_peer_deepnorm'


def _split_heads(a, n_heads):
    b, s, _ = a.shape
    return a.reshape(b, s, n_heads, -1).transpose(0, 2, 1, 3)


def _merge_heads(a):
    b, h, s, d = a.shape
    return a.transpose(0, 2, 1, 3).reshape(b, s, h * d)


def layer_norm(x, g, b):
    xf = x.astype(jnp.float32)
    mu = jnp.mean(xf, axis=-1, keepdims=True)
    var = jnp.mean(jnp.square(xf - mu), axis=-1, keepdims=True)
    y = (xf - mu) * lax.rsqrt(var + LN_EPS) * g.astype(jnp.float32) + b.astype(jnp.float32)
    return y.astype(x.dtype)


def moba_attention(q, k, v):
    B, H, S, Dh = q.shape
    nb = -(-S // MOBA_BLOCK)
    s_pad = nb * MOBA_BLOCK
    pad = ((0, 0), (0, 0), (0, s_pad - S), (0, 0))
    kb = jnp.pad(k, pad).reshape(B, H, nb, MOBA_BLOCK, Dh)
    vb = jnp.pad(v, pad).reshape(B, H, nb, MOBA_BLOCK, Dh)
    k_mean = jnp.mean(kb.astype(jnp.float32), axis=3)
    gate = jnp.einsum('bhsd,bhnd->bhsn', q.astype(jnp.float32), k_mean)
    q_block = jnp.arange(S) // MOBA_BLOCK
    past = jnp.arange(nb)[None, :] < q_block[:, None]
    gate = jnp.where(past, gate, NEG_INF)
    n_sel = min(MOBA_TOPK, nb)
    sel_score, sel_idx = lax.top_k(gate, n_sel)
    sel_valid = sel_score > 0.5 * NEG_INF

    nc = S // MOBA_Q_CHUNK

    def to_chunks(a):
        a = a.reshape(B, H, nc, MOBA_Q_CHUNK, *a.shape[3:])
        return jnp.moveaxis(a, 2, 0)

    starts = jnp.arange(nc) * MOBA_Q_CHUNK
    b_idx = jnp.arange(B)[:, None, None, None]
    h_idx = jnp.arange(H)[None, :, None, None]
    scale = Dh ** -0.5
    key_off = jnp.arange(MOBA_BLOCK)
    q_off = jnp.arange(MOBA_Q_CHUNK)

    def attend(args):
        qc, idx, valid, start = args
        k_sel = kb[b_idx, h_idx, idx]
        v_sel = vb[b_idx, h_idx, idx]
        own = start // MOBA_BLOCK
        k_own = lax.dynamic_index_in_dim(kb, own, axis=2, keepdims=False)
        v_own = lax.dynamic_index_in_dim(vb, own, axis=2, keepdims=False)
        s_sel = jnp.einsum('bhqd,bhqtkd->bhqtk', qc, k_sel).astype(jnp.float32) * scale
        s_sel = jnp.where(valid[..., None], s_sel, NEG_INF)
        s_own = jnp.einsum('bhqd,bhkd->bhqk', qc, k_own).astype(jnp.float32) * scale
        causal = (own * MOBA_BLOCK + key_off)[None, :] <= (start + q_off)[:, None]
        s_own = jnp.where(causal, s_own, NEG_INF)
        scores = jnp.concatenate([s_sel.reshape(B, H, MOBA_Q_CHUNK, -1), s_own], axis=-1)
        p = jax.nn.softmax(scores, axis=-1).astype(v.dtype)
        p_sel = p[..., : n_sel * MOBA_BLOCK].reshape(B, H, MOBA_Q_CHUNK, n_sel, MOBA_BLOCK)
        p_own = p[..., n_sel * MOBA_BLOCK:]
        return (jnp.einsum('bhqtk,bhqtkd->bhqd', p_sel, v_sel)
                + jnp.einsum('bhqk,bhkd->bhqd', p_own, v_own))

    out = lax.map(attend, (to_chunks(q), to_chunks(sel_idx), to_chunks(sel_valid), starts))
    return jnp.moveaxis(out, 0, 2).reshape(B, H, S, Dh)


def gla_attention(q, k, v, log_a):
    B, H, S, Dk = q.shape
    Dv = v.shape[-1]
    n = S // GLA_CHUNK
    f32 = jnp.float32
    qf = q.astype(f32).reshape(B, H, n, GLA_CHUNK, Dk) * Dk ** -0.5
    kf = k.astype(f32).reshape(B, H, n, GLA_CHUNK, Dk)
    vf = v.astype(f32).reshape(B, H, n, GLA_CHUNK, Dv)
    cum = jnp.cumsum(log_a.astype(f32).reshape(B, H, n, GLA_CHUNK, Dk), axis=3)
    cum_last = cum[..., -1:, :]
    q_dec = qf * jnp.exp(cum)
    k_dec = kf * jnp.exp(-cum)
    k_state = kf * jnp.exp(cum_last - cum)
    causal = jnp.tril(jnp.ones((GLA_CHUNK, GLA_CHUNK), dtype=bool))
    a_intra = jnp.where(causal, jnp.einsum('bhnid,bhnjd->bhnij', q_dec, k_dec), 0.0)
    o_intra = jnp.einsum('bhnij,bhnje->bhnie', a_intra, vf)
    delta = jnp.einsum('bhncd,bhnce->bhnde', k_state, vf)
    decay = jnp.exp(cum_last[..., 0, :])

    def step(state, inp):
        dec, dlt = inp
        return state * dec[..., None] + dlt, state

    _, states = lax.scan(step, jnp.zeros((B, H, Dk, Dv), f32),
                         (jnp.moveaxis(decay, 2, 0), jnp.moveaxis(delta, 2, 0)))
    states = jnp.moveaxis(states, 0, 2)
    o_inter = jnp.einsum('bhncd,bhnde->bhnce', q_dec, states)
    return (o_intra + o_inter).reshape(B, H, S, Dv)


def hybrid_mixer(x, w_in, gla_gate_up, gla_gate_bias, gla_norm_g, w_out):
    proj = x @ w_in
    cuts = np.cumsum(W_IN_SIZES)[:-1].tolist()
    q_m, k_m, v_m, q_g, k_g, v_g, r_g, gate_lr = jnp.split(proj, cuts, axis=-1)
    o_moba = moba_attention(_split_heads(q_m, MOBA_HEADS), _split_heads(k_m, MOBA_HEADS),
                            _split_heads(v_m, MOBA_HEADS))
    o_moba = _merge_heads(o_moba)
    log_a = jax.nn.log_sigmoid((gate_lr @ gla_gate_up + gla_gate_bias).astype(jnp.float32)) / GLA_GATE_TAU
    o_gla = gla_attention(_split_heads(q_g, GLA_HEADS), _split_heads(k_g, GLA_HEADS),
                          _split_heads(v_g, GLA_HEADS), _split_heads(log_a, GLA_HEADS))
    o_gla = o_gla * lax.rsqrt(jnp.mean(jnp.square(o_gla), axis=-1, keepdims=True) + RMS_EPS)
    o_gla = o_gla * gla_norm_g.astype(jnp.float32)
    o_gla = (_merge_heads(o_gla) * jax.nn.silu(r_g.astype(jnp.float32))).astype(x.dtype)
    return jnp.concatenate([o_moba, o_gla], axis=-1) @ w_out


def memory_cross_attention(x, mem, w_q, w_kv, w_o):
    q = _split_heads(x @ w_q, XATTN_HEADS)
    k, v = jnp.split(mem @ w_kv, 2, axis=-1)
    k = _split_heads(k, XATTN_HEADS)
    v = _split_heads(v, XATTN_HEADS)
    s = jnp.einsum('bhsd,bhmd->bhsm', q, k).astype(jnp.float32) * XATTN_HEAD_DIM ** -0.5
    p = jax.nn.softmax(s, axis=-1).astype(v.dtype)
    o = jnp.einsum('bhsm,bhmd->bhsd', p, v)
    return _merge_heads(o) @ w_o


def peer_ffn(x, w_query, sub_keys, expert_down, expert_up):
    B, S, D = x.shape
    T = B * S
    xt = x.reshape(T, D)
    q = (xt @ w_query).reshape(T, PEER_HEADS, 2, PEER_QUERY_DIM // 2)
    s = jnp.einsum('thpd,hpnd->thpn', q, sub_keys).astype(jnp.float32)
    s_top, i_top = lax.top_k(s, PEER_TOPK)
    cand = s_top[:, :, 0, :, None] + s_top[:, :, 1, None, :]
    cand_idx = i_top[:, :, 0, :, None] * PEER_N_KEYS + i_top[:, :, 1, None, :]
    cand = cand.reshape(T, PEER_HEADS, PEER_TOPK * PEER_TOPK)
    cand_idx = cand_idx.reshape(T, PEER_HEADS, PEER_TOPK * PEER_TOPK)
    best, pos = lax.top_k(cand, PEER_TOPK)
    expert_idx = jnp.take_along_axis(cand_idx, pos, axis=-1)
    gates = jax.nn.softmax(best, axis=-1)
    nc = T // PEER_TOKEN_CHUNK

    def apply(args):
        xc, idx, g = args
        u = expert_down[idx]
        h = jax.nn.gelu(jnp.einsum('td,thkd->thk', xc, u).astype(jnp.float32), approximate=False)
        vsel = expert_up[idx]
        return jnp.einsum('thk,thkd->td', (g * h).astype(x.dtype), vsel)

    out = lax.map(apply, (xt.reshape(nc, PEER_TOKEN_CHUNK, D),
                          expert_idx.reshape(nc, PEER_TOKEN_CHUNK, PEER_HEADS, PEER_TOPK),
                          gates.reshape(nc, PEER_TOKEN_CHUNK, PEER_HEADS, PEER_TOPK)))
    return out.reshape(B, S, D)


def setup_inputs(seed: int = 0) -> dict:
    key = jax.random.key(seed)
    ks = jax.random.split(key, 20)
    L = DEPTH
    d = D_MODEL

    def nrm(k, shape, scale):
        return jax.random.normal(k, shape, jnp.float32) * scale

    return {
        'x': nrm(ks[0], (BATCH, SEQ, d), 1.0),
        'mem': nrm(ks[1], (BATCH, MEM_LEN, d), 1.0),
        'w_in': nrm(ks[2], (L, d, W_IN_COLS), d ** -0.5),
        'gla_gate_up': nrm(ks[3], (L, GLA_GATE_RANK, GLA_HEADS * GLA_KEY_DIM), GLA_GATE_RANK ** -0.5),
        'gla_gate_bias': nrm(ks[4], (L, GLA_HEADS * GLA_KEY_DIM), 0.1),
        'gla_norm_g': 1.0 + nrm(ks[5], (L, GLA_VAL_DIM), 0.02),
        'w_out': nrm(ks[6], (L, MIX_WIDTH, d), DEEPNORM_BETA * MIX_WIDTH ** -0.5),
        'ln1_g': 1.0 + nrm(ks[7], (L, d), 0.02),
        'ln1_b': nrm(ks[8], (L, d), 0.02),
        'xattn_wq': nrm(ks[9], (L, d, d), d ** -0.5),
        'xattn_wkv': nrm(ks[10], (L, d, 2 * d), d ** -0.5),
        'xattn_wo': nrm(ks[11], (L, d, d), DEEPNORM_BETA * d ** -0.5),
        'ln2_g': 1.0 + nrm(ks[12], (L, d), 0.02),
        'ln2_b': nrm(ks[13], (L, d), 0.02),
        'peer_wq': nrm(ks[14], (L, d, PEER_HEADS * PEER_QUERY_DIM), d ** -0.5),
        'peer_sub_keys': nrm(ks[15], (L, PEER_HEADS, 2, PEER_N_KEYS, PEER_QUERY_DIM // 2), (PEER_QUERY_DIM // 2) ** -0.5),
        'peer_u': nrm(ks[16], (L, PEER_N_EXPERTS, d), d ** -0.5),
        'peer_v': nrm(ks[17], (L, PEER_N_EXPERTS, d), DEEPNORM_BETA * PEER_HEADS ** -0.5),
        'ln3_g': 1.0 + nrm(ks[18], (L, d), 0.02),
        'ln3_b': nrm(ks[19], (L, d), 0.02),
    }


def reference(x, mem, w_in, gla_gate_up, gla_gate_bias, gla_norm_g, w_out, ln1_g, ln1_b,
              xattn_wq, xattn_wkv, xattn_wo, ln2_g, ln2_b,
              peer_wq, peer_sub_keys, peer_u, peer_v, ln3_g, ln3_b):
    h = x
    for l in range(DEPTH):
        mix = hybrid_mixer(h, w_in[l], gla_gate_up[l], gla_gate_bias[l], gla_norm_g[l], w_out[l])
        h = layer_norm(DEEPNORM_ALPHA * h + mix, ln1_g[l], ln1_b[l])
        xa = memory_cross_attention(h, mem, xattn_wq[l], xattn_wkv[l], xattn_wo[l])
        h = layer_norm(DEEPNORM_ALPHA * h + xa, ln2_g[l], ln2_b[l])
        ff = peer_ffn(h, peer_wq[l], peer_sub_keys[l], peer_u[l], peer_v[l])
        h = layer_norm(DEEPNORM_ALPHA * h + ff, ln3_g[l], ln3_b[l])
    return h
```

```cpp
#include <hip/hip_runtime.h>
#include <cstdio>
#include <cstdint>
namespace pg8 {
#define PG8_LAS __attribute__((address_space(3)))
typedef unsigned short bf16_t;
typedef short bf16x8 __attribute__((ext_vector_type(8)));
typedef float f32x4 __attribute__((ext_vector_type(4)));
typedef unsigned u32x4 __attribute__((ext_vector_type(4)));
constexpr int BM = 256, BK = 64, HALF = 128, HTB = HALF * BK * 2  , STAGE_BYTES = 8 * HTB, NXCD = 8, WGM = 8;

__host__ __device__ __forceinline__ int lds_byte(int r, int c) { const int st = (r >> 4) * 2 + (c >> 5), rr = r & 15, cc = c & 31, ob = rr * 64 + cc * 2; return st * 1024 + (ob ^ (((ob >> 9) & 1) << 5)); }
__host__ __device__ __forceinline__ void stage_rc(int b, int& R, int& C) { const int st = b / 1024, sb = b % 1024, swz = sb ^ (((sb >> 9) & 1) << 5); R = (st >> 1) * 16 + swz / 64; C = (st & 1) * 32 + (swz % 64) / 2; }
__host__ __device__ __forceinline__ int perm32(int rho) { const int n = rho >> 4, i = rho & 15; return 8 * (i >> 2) + 4 * n + (i & 3); }

struct Unit { int pm, pn; };
struct Gemm { const bf16_t* A; const bf16_t* Bt; int M, N, K; };

struct StaticOrder {
    int nM, nN, nwg, G, c;
    __host__ __device__ void init(int M, int N, int G_, int c_) { nM = M / BM; nN = N / BM; nwg = nM * nN; G = G_; c = c_; }
    __host__ __device__ bool next(int i, Unit& u) const {
        const long L = (long)i * G + c; if (L >= nwg) return false;
        int wgid = (int)L; { const int q = nwg / NXCD, r = nwg % NXCD, xcd = wgid % NXCD, off = wgid / NXCD; wgid = (xcd < r ? xcd * (q + 1) : r * (q + 1) + (xcd - r) * q) + off; }
        const int nig = WGM * nN, gid = wgid / nig, fm = gid * WGM, gsz = (nM - fm) < WGM ? (nM - fm) : WGM;
        u.pm = fm + ((wgid % nig) % gsz); u.pn = (wgid % nig) / gsz; return true;
    }
    __device__ __forceinline__ void a_ready(const Unit&) const {}
    __device__ __forceinline__ void done(const Unit&) const {}
};

__device__ __forceinline__ unsigned cvt_pk_bf16(float lo, float hi) { unsigned r; asm volatile("v_cvt_pk_bf16_f32 %0, %1, %2" : "=v"(r) : "v"(lo), "v"(hi)); return r; }
typedef float f32x2 __attribute__((ext_vector_type(2)));
__device__ __forceinline__ f32x2 gelu_pk(f32x2 v) {
    const f32x2 av = __builtin_elementwise_abs(v), d = av * 0.2316418882f + 1.0f;
    f32x2 t; t.x = __builtin_amdgcn_rcpf(d.x); t.y = __builtin_amdgcn_rcpf(d.y);
    f32x2 q = t * 0.5307027145f + (-0.7265760135f); q = q * t + 0.7107068705f; q = q * t + (-0.142248368f); q = q * t + 0.127414796f; q = q * t;
    const f32x2 s = (v * v) * (-0.72134752044f);
    f32x2 e; e.x = __builtin_amdgcn_exp2f(s.x); e.y = __builtin_amdgcn_exp2f(s.y);
    const f32x2 m = v * (q * e), r = v - m;
    f32x2 o; o.x = v.x < 0.f ? m.x : r.x; o.y = v.y < 0.f ? m.y : r.y; return o;
}

template <int ACT  > struct EpiBf16 {
    static constexpr bool PERM = true, AFTER_DRAIN = false; static_assert(ACT == 0 || ACT == 1, "EpiBf16: ACT is 0 (none) or 1 (gelu_pk)");
    bf16_t* O; int ldc; const float* bias; int split_cols; size_t split_stride; float scale0;
    __device__ __forceinline__ void operator()(const f32x4 (&acc)[2][2][4][2], const Unit& u, int wr, int wc, int fr, int fq) const {
        const int row0 = u.pm * BM + wr * 64 + fr; int colt = u.pn * BM; bf16_t* base = O;
        float sc = 1.f; if (split_cols) { const int t = colt / split_cols; base += (size_t)t * split_stride; colt -= t * split_cols; if (t == 0) sc = scale0; }
        const int col0 = colt + wc * 32 + 8 * fq, bcol0 = u.pn * BM + wc * 32 + 8 * fq;
        f32x4 bv[2][2];
#pragma unroll
        for (int bj = 0; bj < 2; ++bj)
#pragma unroll
            for (int n = 0; n < 2; ++n) bv[bj][n] = bias ? *(const f32x4*)(bias + bcol0 + bj * HALF + 4 * n) : (f32x4){0.f, 0.f, 0.f, 0.f};
#pragma unroll
        for (int ai = 0; ai < 2; ++ai)
#pragma unroll
            for (int m = 0; m < 4; ++m) { bf16_t* rowp = base + (size_t)(row0 + ai * HALF + m * 16) * ldc + col0;
#pragma unroll
                for (int bj = 0; bj < 2; ++bj) { f32x4 v0 = acc[ai][bj][m][0] + bv[bj][0], v1 = acc[ai][bj][m][1] + bv[bj][1];
                    if (ACT == 1) { f32x2 a = gelu_pk((f32x2){v0[0], v0[1]}), b = gelu_pk((f32x2){v0[2], v0[3]}), c = gelu_pk((f32x2){v1[0], v1[1]}), d = gelu_pk((f32x2){v1[2], v1[3]});
                        v0 = (f32x4){a.x, a.y, b.x, b.y}; v1 = (f32x4){c.x, c.y, d.x, d.y}; }
                    v0 = v0 * sc; v1 = v1 * sc; u32x4 w; w.x = cvt_pk_bf16(v0[0], v0[1]); w.y = cvt_pk_bf16(v0[2], v0[3]); w.z = cvt_pk_bf16(v1[0], v1[1]); w.w = cvt_pk_bf16(v1[2], v1[3]);
                    *(u32x4*)(rowp + bj * HALF) = w; } }
    }
};

struct PanelStats {
    unsigned* xbuf;
    unsigned* cnt;
    unsigned* tmo;
    int ntn; float eps;
    unsigned code;
    __device__ __forceinline__ bool run(const f32x4 (&v)[2][2][4][2], const Unit& u, int wr, int wc, int fr, int fq, PG8_LAS unsigned char* lds, int wid, int lane) const {
        typedef float f32x2v __attribute__((ext_vector_type(2)));
        PG8_LAS f32x2v* P = (PG8_LAS f32x2v*)lds;
        PG8_LAS f32x2v* S = (PG8_LAS f32x2v*)(lds + 8192);
        PG8_LAS unsigned* flag = (PG8_LAS unsigned*)(lds + 8192 + 2048);
#pragma unroll
        for (int ai = 0; ai < 2; ++ai)
#pragma unroll
            for (int m = 0; m < 4; ++m) {
                float s = 0.f;
#pragma unroll
                for (int bj = 0; bj < 2; ++bj)
#pragma unroll
                    for (int n = 0; n < 2; ++n) { const f32x4 x = v[ai][bj][m][n]; s += (x[0] + x[1]) + (x[2] + x[3]); }
                s += __shfl_xor(s, 16); s += __shfl_xor(s, 32);
                const float mw = s * (1.0f / 64.0f); float q = 0.f;
#pragma unroll
                for (int bj = 0; bj < 2; ++bj)
#pragma unroll
                    for (int n = 0; n < 2; ++n) { const f32x4 d = v[ai][bj][m][n] - mw; q += (d[0] * d[0] + d[1] * d[1]) + (d[2] * d[2] + d[3] * d[3]); }
                q += __shfl_xor(q, 16); q += __shfl_xor(q, 32);
                if (fq == 0) P[(ai * HALF + wr * 64 + m * 16 + fr) * 4 + wc] = (f32x2v){mw, q};
            }
        asm volatile("s_waitcnt lgkmcnt(0)" ::: "memory"); __builtin_amdgcn_s_barrier(); asm volatile("" ::: "memory");
#if defined(BROKEN_EXCHANGE_NO_WAIT)
#warning BROKEN CONTROL BUILD: the row-statistics exchange does not wait; results are wrong by design
        if (blockIdx.x >= 64) { const long long t0_ = clock64(); while (clock64() - t0_ < 60000) __builtin_amdgcn_s_sleep(8); }
#endif
        const int row = wid * 32 + (lane & 31);
        if (lane < 32) {
            const f32x2v a = P[row * 4 + 0], b = P[row * 4 + 1], c = P[row * 4 + 2], d = P[row * 4 + 3];
            const float mt = (a.x + b.x + c.x + d.x) * 0.25f;
            const float da = a.x - mt, db = b.x - mt, dc = c.x - mt, dd = d.x - mt;
            const float m2 = (a.y + b.y) + (c.y + d.y) + 64.0f * ((da * da + db * db) + (dc * dc + dd * dd));
            unsigned long long* slot = (unsigned long long*)xbuf + ((size_t)(u.pm * BM + row) * 4 + u.pn);
            __hip_atomic_store(slot, ((unsigned long long)__float_as_uint(m2) << 32) | __float_as_uint(mt), __ATOMIC_RELAXED, __HIP_MEMORY_SCOPE_AGENT);
        }
        asm volatile("s_waitcnt vmcnt(0)" ::: "memory");
        if (lane == 0) __hip_atomic_fetch_add(cnt + 64 * u.pm, 1u, __ATOMIC_RELAXED, __HIP_MEMORY_SCOPE_AGENT);
        if (wid == 0) {
            bool dead = false; const unsigned long long t0 = __builtin_amdgcn_s_memrealtime(); const unsigned want = 8u * (unsigned)ntn;
            for (;;) {
#if defined(BROKEN_EXCHANGE_NO_WAIT)
                break;
#endif
                if ((unsigned)__builtin_amdgcn_readfirstlane(__hip_atomic_load(cnt + 64 * u.pm, __ATOMIC_RELAXED, __HIP_MEMORY_SCOPE_AGENT)) >= want) break;
                if (__builtin_amdgcn_s_memrealtime() - t0 > 2000000ull) {
                    if (lane == 0) { unsigned expect = 0u; __hip_atomic_compare_exchange_strong(tmo + 1, &expect, code | (unsigned)(u.pm & 0xff), __ATOMIC_RELAXED, __ATOMIC_RELAXED, __HIP_MEMORY_SCOPE_AGENT);
                                     __hip_atomic_store(tmo, 1u, __ATOMIC_RELAXED, __HIP_MEMORY_SCOPE_AGENT); }
                    dead = true; break; }
                __builtin_amdgcn_s_sleep(2);
            }
            __builtin_amdgcn_fence(__ATOMIC_ACQUIRE, "agent");
            if (lane == 0) flag[0] = dead ? 1u : 0u;
        }
        asm volatile("s_waitcnt vmcnt(0) lgkmcnt(0)" ::: "memory"); __builtin_amdgcn_s_barrier(); asm volatile("" ::: "memory");
        const bool bad = flag[0] != 0u;
        if (lane < 32) {
            const unsigned long long* slot = (const unsigned long long*)xbuf + (size_t)(u.pm * BM + row) * 4; float mt[4], m2[4]; float ms = 0.f;
#pragma unroll
            for (int t = 0; t < 4; ++t) { if (t < ntn) { const unsigned long long w = __hip_atomic_load(slot + t, __ATOMIC_RELAXED, __HIP_MEMORY_SCOPE_AGENT); mt[t] = __uint_as_float((unsigned)w); m2[t] = __uint_as_float((unsigned)(w >> 32)); } else { mt[t] = 0.f; m2[t] = 0.f; } ms += mt[t]; }
            const float mean = ms / (float)ntn; float q = 0.f;
#pragma unroll
            for (int t = 0; t < 4; ++t) if (t < ntn) { const float dm = mt[t] - mean; q += m2[t] + 256.0f * dm * dm; }
            S[row] = (f32x2v){mean, 1.0f / sqrtf(q / (256.0f * (float)ntn) + eps)};
        }
        asm volatile("s_waitcnt lgkmcnt(0)" ::: "memory"); __builtin_amdgcn_s_barrier(); asm volatile("" ::: "memory");
        return bad;
    }
};
struct EpiLnRes {
    static constexpr bool PERM = false, AFTER_DRAIN = true;
    const float* base; float* out; int ldc; const float* bias; PanelStats st; unsigned poison;
    __device__ __forceinline__ void fused(f32x4 (&acc)[2][2][4][2], const Unit& u, int wr, int wc, int fr, int fq, PG8_LAS unsigned char* lds, int wid, int lane) const {
        typedef float f32x2v __attribute__((ext_vector_type(2)));
        const PG8_LAS f32x2v* S = (const PG8_LAS f32x2v*)(lds + 8192);
        const int col0 = u.pn * BM + wc * 32 + 4 * fq;
#pragma unroll
        for (int bj = 0; bj < 2; ++bj)
#pragma unroll
            for (int n = 0; n < 2; ++n) { const f32x4 bv = bias ? *(const f32x4*)(bias + col0 + bj * HALF + n * 16) : (f32x4){0.f, 0.f, 0.f, 0.f};
#pragma unroll
                for (int ai = 0; ai < 2; ++ai)
#pragma unroll
                    for (int m = 0; m < 4; ++m) acc[ai][bj][m][n] += bv; }
        f32x4 pre[4][2][2];
#pragma unroll
        for (int m = 0; m < 4; ++m) { const size_t off = (size_t)(u.pm * BM + wr * 64 + m * 16 + fr) * ldc + col0;
#pragma unroll
            for (int bj = 0; bj < 2; ++bj)
#pragma unroll
                for (int n = 0; n < 2; ++n) pre[m][bj][n] = *(const f32x4*)(base + off + bj * HALF + n * 16); }
        const bool bad = st.run(acc, u, wr, wc, fr, fq, lds, wid, lane) || poison != 0u;
        const float qnan = __builtin_nanf("");
#pragma unroll
        for (int ai = 0; ai < 2; ++ai)
#pragma unroll
            for (int m = 0; m < 4; ++m) { const int r = ai * HALF + wr * 64 + m * 16 + fr; const f32x2v sr = S[r]; const size_t off = (size_t)(u.pm * BM + r) * ldc + col0;
#pragma unroll
                for (int bj = 0; bj < 2; ++bj)
#pragma unroll
                    for (int n = 0; n < 2; ++n) { const f32x4 bs = ai == 0 ? pre[m][bj][n] : *(const f32x4*)(base + off + bj * HALF + n * 16); f32x4 o = bs + (acc[ai][bj][m][n] - sr.x) * sr.y;
                        if (bad) o = (f32x4){qnan, qnan, qnan, qnan}; *(f32x4*)(out + off + bj * HALF + n * 16) = o; }
                if (m & 1) asm volatile("" ::: "memory"); }
    }
};
struct EpiLnResLn {
    static constexpr bool PERM = false, AFTER_DRAIN = true;
    const float* base; float* out; bf16_t* xn; int ldc; const float* bias; PanelStats st1, st2; unsigned poison;
    __device__ __forceinline__ void fused(f32x4 (&acc)[2][2][4][2], const Unit& u, int wr, int wc, int fr, int fq, PG8_LAS unsigned char* lds, int wid, int lane) const {
        typedef float f32x2v __attribute__((ext_vector_type(2))); typedef unsigned u32x2v __attribute__((ext_vector_type(2)));
        const PG8_LAS f32x2v* S = (const PG8_LAS f32x2v*)(lds + 8192);
        const int col0 = u.pn * BM + wc * 32 + 4 * fq;
#pragma unroll
        for (int bj = 0; bj < 2; ++bj)
#pragma unroll
            for (int n = 0; n < 2; ++n) { const f32x4 bv = bias ? *(const f32x4*)(bias + col0 + bj * HALF + n * 16) : (f32x4){0.f, 0.f, 0.f, 0.f};
#pragma unroll
                for (int ai = 0; ai < 2; ++ai)
#pragma unroll
                    for (int m = 0; m < 4; ++m) acc[ai][bj][m][n] += bv; }
        bool bad = st1.run(acc, u, wr, wc, fr, fq, lds, wid, lane) || poison != 0u;
        const float qnan = __builtin_nanf("");
#pragma unroll
        for (int ai = 0; ai < 2; ++ai)
#pragma unroll
            for (int m = 0; m < 4; ++m) { const int r = ai * HALF + wr * 64 + m * 16 + fr; const f32x2v sr = S[r]; const size_t off = (size_t)(u.pm * BM + r) * ldc + col0;
#pragma unroll
                for (int bj = 0; bj < 2; ++bj)
#pragma unroll
                    for (int n = 0; n < 2; ++n) { const f32x4 bs = *(const f32x4*)(base + off + bj * HALF + n * 16); acc[ai][bj][m][n] = bs + (acc[ai][bj][m][n] - sr.x) * sr.y; }
                asm volatile("" : "+v"(acc[ai][0][m][0]), "+v"(acc[ai][0][m][1]), "+v"(acc[ai][1][m][0]), "+v"(acc[ai][1][m][1]));
                if (m & 1) asm volatile("" ::: "memory"); }
        const bool bad1 = bad;
        bad = st2.run(acc, u, wr, wc, fr, fq, lds, wid, lane) || bad;
#pragma unroll
        for (int ai = 0; ai < 2; ++ai)
#pragma unroll
            for (int m = 0; m < 4; ++m) { const int r = ai * HALF + wr * 64 + m * 16 + fr; const f32x2v sr = S[r]; const size_t off = (size_t)(u.pm * BM + r) * ldc + col0;
#pragma unroll
                for (int bj = 0; bj < 2; ++bj)
#pragma unroll
                    for (int n = 0; n < 2; ++n) { const f32x4 x1 = acc[ai][bj][m][n]; *(f32x4*)(out + off + bj * HALF + n * 16) = bad1 ? (f32x4){qnan, qnan, qnan, qnan} : x1;
                        const f32x4 o = (x1 - sr.x) * sr.y; u32x2v w; w.x = cvt_pk_bf16(o[0], o[1]); w.y = cvt_pk_bf16(o[2], o[3]);
                        if (bad) { w.x = 0x7fc07fc0u; w.y = 0x7fc07fc0u; } *(u32x2v*)(xn + off + bj * HALF + n * 16) = w; }
                asm volatile("" ::: "memory"); }
    }
};

template <class Epi, class Sched, bool ALIGN_EPI = false, bool SP2 = false>
__device__ __forceinline__ void gemm_phase(PG8_LAS unsigned char* lds, const Gemm g, const Sched& S, const Epi& E) {
    const int tid = threadIdx.x, wid = __builtin_amdgcn_readfirstlane(tid >> 6), lane = tid & 63, wr = wid >> 2, wc = wid & 3, fr = lane & 15, fq = lane >> 4;
    const int K = g.K, nt = K / BK;
    unsigned voffA[2], voffB[2];
#pragma unroll
    for (int i = 0; i < 2; ++i) { int R, C; stage_rc(tid * 16 + i * 8192, R, C); const int Rb = Epi::PERM ? ((R & ~31) + perm32(R & 31)) : R;
        voffA[i] = (unsigned)(R * K + C) * 2u; voffB[i] = (unsigned)(Rb * K + C) * 2u; }
    const size_t kstep = (size_t)(BK * 2);
    const size_t hstep = (size_t)HALF * K * 2;
    const size_t tstep = 2 * hstep;
    const unsigned ldsw = (unsigned)wid * 1024u;
    const int aoff = lds_byte(wr * 64 + fr, fq * 8), boff = lds_byte(wc * 32 + fr, fq * 8);
#define PG8_SA(b, h) (((b) * 2 + (h)) * HTB)
#define PG8_SB(b, h) ((4 + (b) * 2 + (h)) * HTB)
#define PG8_STAGE(bufoff, gbase, voff) do { _Pragma("unroll") for (int _i = 0; _i < 2; ++_i) \
        __builtin_amdgcn_global_load_lds((const unsigned*)((const char*)(gbase) + (voff)[_i]), (PG8_LAS unsigned*)(lds + (bufoff) + ldsw + _i * 8192), 16, 0, 0); } while (0)
#define PG8_LDA(dst, b, h) do { _Pragma("unroll") for (int m = 0; m < 4; ++m) _Pragma("unroll") for (int k = 0; k < 2; ++k) dst[m][k] = *(const PG8_LAS bf16x8*)(lds + PG8_SA(b, h) + aoff + m * 2048 + k * 1024); } while (0)
#define PG8_LDB(dst, b, h) do { _Pragma("unroll") for (int n = 0; n < 2; ++n) _Pragma("unroll") for (int k = 0; k < 2; ++k) dst[n][k] = *(const PG8_LAS bf16x8*)(lds + PG8_SB(b, h) + boff + n * 2048 + k * 1024); } while (0)
#define PG8_MMA(ai, bj, At, Bt) do { __builtin_amdgcn_s_setprio(1); _Pragma("unroll") for (int m = 0; m < 4; ++m) _Pragma("unroll") for (int n = 0; n < 2; ++n) _Pragma("unroll") for (int k = 0; k < 2; ++k) \
        acc[ai][bj][m][n] = __builtin_amdgcn_mfma_f32_16x16x32_bf16(Bt[n][k], At[m][k], acc[ai][bj][m][n], 0, 0, 0); __builtin_amdgcn_s_setprio(0); } while (0)
#define PG8_WAIT_V(n) asm volatile("s_waitcnt vmcnt(" #n ")" ::: "memory")
#define PG8_WAIT_L(n) asm volatile("s_waitcnt lgkmcnt(" #n ")" ::: "memory")
#define PG8_BAR __builtin_amdgcn_s_barrier()
#define PG8_SCHED __builtin_amdgcn_sched_barrier(0)
    Unit cur, nxt; int ui = 0;
    if (!S.next(0, cur)) return;
    f32x4 acc[2][2][4][2];
#pragma unroll
    for (int a = 0; a < 2; ++a)
#pragma unroll
        for (int b = 0; b < 2; ++b)
#pragma unroll
            for (int m = 0; m < 4; ++m)
#pragma unroll
                for (int n = 0; n < 2; ++n) acc[a][b][m][n] = (f32x4){0.f, 0.f, 0.f, 0.f};
    bf16x8 At[4][2], B0[2][2], B1[2][2];
    const char* cA = (const char*)g.A + (size_t)cur.pm * tstep; const char* cB = (const char*)g.Bt + (size_t)cur.pn * tstep;
    S.a_ready(cur);
    if constexpr (SP2) {
        PG8_STAGE(PG8_SB(0, 0), cB, voffB); PG8_STAGE(PG8_SB(0, 1), cB + hstep, voffB); PG8_STAGE(PG8_SA(0, 0), cA, voffA); PG8_STAGE(PG8_SA(0, 1), cA + hstep, voffA);
        if (wr == 1) PG8_BAR;
        PG8_WAIT_V(2); PG8_BAR;
        PG8_STAGE(PG8_SB(1, 0), cB + kstep, voffB); PG8_STAGE(PG8_SA(1, 0), cA + kstep, voffA); PG8_STAGE(PG8_SB(1, 1), cB + hstep + kstep, voffB);
        PG8_WAIT_V(6); PG8_BAR;
    } else {
        PG8_STAGE(PG8_SB(0, 0), cB, voffB); PG8_STAGE(PG8_SA(0, 0), cA, voffA); PG8_STAGE(PG8_SB(0, 1), cB + hstep, voffB); PG8_STAGE(PG8_SA(0, 1), cA + hstep, voffA);
        if (wr == 1) PG8_BAR;
        PG8_WAIT_V(4); PG8_BAR;
        PG8_STAGE(PG8_SB(1, 0), cB + kstep, voffB); PG8_STAGE(PG8_SA(1, 0), cA + kstep, voffA); PG8_STAGE(PG8_SB(1, 1), cB + hstep + kstep, voffB);
        PG8_WAIT_V(6); PG8_BAR;
    }
    for (;;) {
        const bool has_next = S.next(ui + 1, nxt);
        const char* nA = has_next ? (const char*)g.A + (size_t)nxt.pm * tstep : cA; const char* nB = has_next ? (const char*)g.Bt + (size_t)nxt.pn * tstep : cB;
        for (int t = 0; t < nt; t += 2) {
            const bool last = (t == nt - 2);
            const char* a1 = cA + (size_t)(t + 1) * kstep;
            const char* a2 = last ? nA : cA + (size_t)(t + 2) * kstep; const char* b2 = last ? nB : cB + (size_t)(t + 2) * kstep;
            const char* a3 = a2 + kstep; const char* b3 = b2 + kstep;
            if (last && has_next) S.a_ready(nxt);
            if constexpr (SP2) {
            PG8_LDB(B0, 0, 0); PG8_LDB(B1, 0, 1); PG8_SCHED; PG8_LDA(At, 0, 0); PG8_STAGE(PG8_SA(1, 1), a1 + hstep, voffA);
            PG8_WAIT_V(8); PG8_WAIT_L(0); PG8_BAR; PG8_MMA(0, 0, At, B0); PG8_MMA(0, 1, At, B1); PG8_BAR; PG8_SCHED;
            PG8_LDA(At, 0, 1); PG8_STAGE(PG8_SB(0, 0), b2, voffB); PG8_STAGE(PG8_SB(0, 1), b2 + hstep, voffB); PG8_STAGE(PG8_SA(0, 0), a2, voffA);
            PG8_WAIT_V(8); PG8_WAIT_L(0); PG8_BAR; PG8_MMA(1, 0, At, B0); PG8_MMA(1, 1, At, B1); PG8_BAR; PG8_SCHED;
            PG8_LDB(B0, 1, 0); PG8_LDB(B1, 1, 1); PG8_SCHED; PG8_LDA(At, 1, 0); PG8_STAGE(PG8_SA(0, 1), a2 + hstep, voffA);
            PG8_WAIT_V(8); PG8_WAIT_L(0); PG8_BAR; PG8_MMA(0, 0, At, B0); PG8_MMA(0, 1, At, B1); PG8_BAR; PG8_SCHED;
            PG8_LDA(At, 1, 1); PG8_STAGE(PG8_SB(1, 0), b3, voffB); PG8_STAGE(PG8_SB(1, 1), b3 + hstep, voffB); PG8_STAGE(PG8_SA(1, 0), a3, voffA);
            PG8_WAIT_V(8); PG8_WAIT_L(0); PG8_BAR; PG8_MMA(1, 0, At, B0); PG8_MMA(1, 1, At, B1); PG8_BAR; PG8_SCHED;
            } else {
            PG8_LDB(B0, 0, 0); PG8_SCHED; PG8_LDA(At, 0, 0); PG8_STAGE(PG8_SA(1, 1), a1 + hstep, voffA);
            PG8_WAIT_L(8); PG8_BAR; PG8_WAIT_L(0); PG8_MMA(0, 0, At, B0); PG8_BAR; PG8_SCHED;
            PG8_LDB(B1, 0, 1); PG8_STAGE(PG8_SB(0, 0), b2, voffB);
            PG8_BAR; PG8_WAIT_L(0); PG8_MMA(0, 1, At, B1); PG8_BAR;
            PG8_LDA(At, 0, 1); PG8_STAGE(PG8_SA(0, 0), a2, voffA);
            PG8_BAR; PG8_WAIT_L(0); PG8_MMA(1, 0, At, B0); PG8_BAR; PG8_SCHED;
            PG8_STAGE(PG8_SB(0, 1), b2 + hstep, voffB);
            PG8_WAIT_V(6); PG8_BAR; PG8_MMA(1, 1, At, B1); PG8_BAR;
            PG8_LDB(B0, 1, 0); PG8_SCHED; PG8_LDA(At, 1, 0); PG8_STAGE(PG8_SA(0, 1), a2 + hstep, voffA);
            PG8_WAIT_L(8); PG8_BAR; PG8_WAIT_L(0); PG8_MMA(0, 0, At, B0); PG8_BAR; PG8_SCHED;
            PG8_LDB(B1, 1, 1); PG8_STAGE(PG8_SB(1, 0), b3, voffB);
            PG8_BAR; PG8_WAIT_L(0); PG8_MMA(0, 1, At, B1); PG8_BAR;
            PG8_LDA(At, 1, 1); PG8_STAGE(PG8_SA(1, 0), a3, voffA);
            PG8_BAR; PG8_WAIT_L(0); PG8_MMA(1, 0, At, B0); PG8_BAR; PG8_SCHED;
            PG8_STAGE(PG8_SB(1, 1), b3 + hstep, voffB);
            PG8_WAIT_V(6); PG8_BAR; PG8_MMA(1, 1, At, B1); PG8_BAR;
            }
        }
        if constexpr (ALIGN_EPI) { if (wr == 0) PG8_BAR; }
        if constexpr (!Epi::AFTER_DRAIN) { E(acc, cur, wr, wc, fr, fq); S.done(cur); }
        if (!has_next) break;
#pragma unroll
        for (int a = 0; a < 2; ++a)
#pragma unroll
            for (int b = 0; b < 2; ++b)
#pragma unroll
                for (int m = 0; m < 4; ++m)
#pragma unroll
                    for (int n = 0; n < 2; ++n) acc[a][b][m][n] = (f32x4){0.f, 0.f, 0.f, 0.f};
        cur = nxt; cA = nA; cB = nB; ++ui;
        if constexpr (ALIGN_EPI) { if (wr == 1) PG8_BAR; }
    }
    PG8_WAIT_V(0);
    if constexpr (!ALIGN_EPI) { if (wr == 0) PG8_BAR; }
    PG8_BAR;
    if constexpr (Epi::AFTER_DRAIN) { E.fused(acc, cur, wr, wc, fr, fq, lds, wid, lane); S.done(cur); }
#undef PG8_SA
#undef PG8_SB
#undef PG8_STAGE
#undef PG8_LDA
#undef PG8_LDB
#undef PG8_MMA
#undef PG8_WAIT_V
#undef PG8_WAIT_L
#undef PG8_BAR
#undef PG8_SCHED
}
}
#ifndef PG8_SP2
#define PG8_SP2 true
#endif
#ifndef PG8_ALIGN
#define PG8_ALIGN true
#endif
#include <cmath>
constexpr int NWAVES = 8;
#ifndef MK_N_LAUNCHES
#define MK_N_LAUNCHES 1
#endif
constexpr int PER_PHASE = 12;
constexpr int N_LAUNCHES = MK_N_LAUNCHES;

constexpr int BATCH = 8, SEQ = 2048, DM = 2048, TOK = BATCH * SEQ, MEMLEN = 256;
constexpr int NPROJ = 6144, NPROJ_PAD = 6400, WIN_COLS = 6160;
constexpr int C_QM = 0, C_KM = 1024, C_VM = 2048, C_QG = 3072, C_KG = 3584, C_VG = 4096, C_RG = 5120;
constexpr float DN_ALPHA = 1.189207115002721f;
constexpr float LN_EPS = 1e-5f, RMS_EPS = 1e-6f;

constexpr size_t MiB = 1u << 20;
constexpr size_t WS_CTL = 0, CTL_ZERO_BYTES = 1 * MiB;
constexpr size_t WS_SUBK = 1 * MiB, WS_KMEAN = 1 * MiB + 512 * 1024;
constexpr size_t WS_WOUT = 2 * MiB, WS_WQ = 10 * MiB, WS_WO = 18 * MiB, WS_WPQ = 26 * MiB;
constexpr size_t WS_KV = 34 * MiB, WS_GATE = 50 * MiB;
constexpr size_t WS_PROJ = 52 * MiB, WS_HB = 52 * MiB, WS_Q = 116 * MiB, WS_XO = 180 * MiB, WS_PU = 180 * MiB;
constexpr size_t WS_ATT = 244 * MiB, WS_PV = 244 * MiB;
constexpr size_t WS_Z = 308 * MiB, WS_XB = 308 * MiB, WS_WIN = 372 * MiB, WS_WKV = 397 * MiB, WS_MEMB = 413 * MiB;
constexpr size_t WS_END = 436 * MiB;
constexpr int CW_BAR = 4096;

constexpr int RING_OFF = 0, RING_BYTES = 131072;
constexpr int LDSCTL_OFF = RING_BYTES, MISC_OFF = LDSCTL_OFF + 320;
constexpr int LDS_BYTES = 147456;
#define GAS __attribute__((address_space(1)))
#define LAS __attribute__((address_space(3)))
typedef unsigned short bf16;
typedef unsigned v4u __attribute__((ext_vector_type(4)));
typedef float f32x4 __attribute__((ext_vector_type(4)));
typedef short bf16x8 __attribute__((ext_vector_type(8)));
typedef GAS unsigned gu32;
typedef GAS unsigned long long gu64;
#define RLX_AGENT __ATOMIC_RELAXED, __HIP_MEMORY_SCOPE_AGENT
#define LDS_WAIT() asm volatile("s_waitcnt lgkmcnt(0)" ::: "memory")
#define VM_WAIT() asm volatile("s_waitcnt vmcnt(0)" ::: "memory")
__device__ __forceinline__ unsigned long long rt() { return __builtin_amdgcn_s_memrealtime(); }
__device__ __forceinline__ unsigned f2bf(float f) { unsigned u = __builtin_bit_cast(unsigned, f); return (u + 0x7fffu + ((u >> 16) & 1u)) >> 16; }
__device__ __forceinline__ unsigned pk2(float lo, float hi) { return f2bf(lo) | (f2bf(hi) << 16); }

#define XB_TMO      128
#define XB_XCNT(j)  (256  + 64 * (j))
#define XB_XSUB(j)  (1280 + 64 * (j))
#define XB_XGEN(j)  (2304 + 64 * (j))
#define XB_TOP      3328
#define XB_TOPGEN   3392
#define XCD_BAR_WORDS 3456
#define XB_SPIN_CAP (1u << 18)

__device__ __forceinline__ unsigned xb_ld(unsigned* p)              { return __hip_atomic_load(p, __ATOMIC_RELAXED, __HIP_MEMORY_SCOPE_AGENT); }
__device__ __forceinline__ unsigned xb_add(unsigned* p, unsigned v) { return __hip_atomic_fetch_add(p, v, __ATOMIC_RELAXED, __HIP_MEMORY_SCOPE_AGENT); }
__device__ __forceinline__ unsigned xb_xcc_id() { return (unsigned)__builtin_amdgcn_s_getreg((3 << 11) | 20) & 0xFu; }
#define XB_SPIN(cond, bar) do { unsigned _sp = 0; while (cond) { __builtin_amdgcn_s_sleep(1); \
    if ((++_sp & 255u) == 0u) { if (xb_ld(&(bar)[XB_TMO])) break; if (_sp > XB_SPIN_CAP) { atomicAdd(&(bar)[XB_TMO], 1u); break; } } } } while (0)

struct XcdBarrier {
    unsigned* bar; unsigned x;
    volatile LAS unsigned* st;
};

__device__ __forceinline__ XcdBarrier xcd_barrier_post(unsigned* bar, volatile LAS unsigned* st) {
    XcdBarrier b; b.bar = bar; b.x = xb_xcc_id(); b.st = st;
    if (threadIdx.x == 0) (void)xb_add(&bar[XB_XCNT(b.x)], 1u);
    return b;
}
__device__ __forceinline__ void xcd_barrier_complete(unsigned* bar, unsigned x, unsigned& nloc, unsigned& nx) {
    const unsigned G = gridDim.x * gridDim.y * gridDim.z;
    unsigned sum, cnt, mine, sp = 0u;
    for (;;) {
        sum = 0u; cnt = 0u; mine = 0u;
#pragma unroll
        for (unsigned j = 0; j < 16; ++j) { const unsigned c = xb_ld(&bar[XB_XCNT(j)]); sum += c; cnt += (c > 0u) ? 1u : 0u; mine = (j == x) ? c : mine; }
        if (sum == G) break;
        __builtin_amdgcn_s_sleep(1);
        if ((++sp & 255u) == 0u) { if (xb_ld(&bar[XB_TMO])) break; if (sp > XB_SPIN_CAP) { atomicAdd(&bar[XB_TMO], 1u); break; } }
    }
    nloc = mine > 0u ? mine : 1u; nx = cnt > 0u ? cnt : 1u;
}

__device__ __forceinline__ void xcd_barrier(const XcdBarrier& b) {
    asm volatile("s_waitcnt vmcnt(0)" ::: "memory");
    __syncthreads();
    if (threadIdx.x == 0) {
        unsigned* bar = b.bar;
        __builtin_amdgcn_s_waitcnt(0);
        unsigned nloc = b.st[0], nx = b.st[1];
        if (nloc == 0u) { xcd_barrier_complete(bar, b.x, nloc, nx); b.st[0] = nloc; b.st[1] = nx; }
        const unsigned old = xb_add(&bar[XB_XSUB(b.x)], 1u);
        const unsigned gen = old / nloc;
        if (old + 1u == (gen + 1u) * nloc) {
            __builtin_amdgcn_fence(__ATOMIC_RELEASE, "agent");
            asm volatile("s_waitcnt vmcnt(0)" ::: "memory");
            const unsigned og = xb_add(&bar[XB_TOP], 1u);
            const unsigned tg = og / nx;
            if (og + 1u == (tg + 1u) * nx) xb_add(&bar[XB_TOPGEN], 1u);
            else XB_SPIN(xb_ld(&bar[XB_TOPGEN]) == tg, bar);
            __builtin_amdgcn_fence(__ATOMIC_ACQUIRE, "agent");
            xb_add(&bar[XB_XGEN(b.x)], 1u);
            asm volatile("s_waitcnt vmcnt(0)" ::: "memory");
        } else {
            XB_SPIN(xb_ld(&bar[XB_XGEN(b.x)]) == gen, bar);
            __builtin_amdgcn_fence(__ATOMIC_ACQUIRE, "agent");
            asm volatile("s_waitcnt vmcnt(0)" ::: "memory");
        }
    }
    __syncthreads();
}
struct Frame {
    LAS unsigned char* lds;
    volatile LAS unsigned* MISC;
    gu32* ctl;
    int tid, lane, wave;
    int vcu, G;
    const float* in[20]; float* out; unsigned char* ws;
};
__device__ __forceinline__ float bf2f(unsigned short h) { return __uint_as_float(((unsigned)h) << 16); }
__device__ __forceinline__ float wave_sum(float v) {
#pragma unroll
    for (int o = 1; o < 64; o <<= 1) v += __shfl_xor(v, o);
    return v;
}
__device__ __forceinline__ float wave_max(float v) {
#pragma unroll
    for (int o = 1; o < 64; o <<= 1) v = fmaxf(v, __shfl_xor(v, o));
    return v;
}
typedef unsigned short us8 __attribute__((ext_vector_type(8)));

__device__ __forceinline__ void p0_transpose_item(const float* W, int K, int N, int Npad, bf16* WT, LAS float* scr, int item, int lane) {
    const int nblk = Npad / 32, kb = item / nblk, nb = item % nblk, k0 = 64 * kb, n0 = 32 * nb;
    const int nn = n0 + (lane & 31); const bool ok = nn < N;
#pragma unroll 8
    for (int i = 0; i < 32; ++i) { const int kk = 2 * i + (lane >> 5); scr[kk * 33 + (lane & 31)] = ok ? W[(size_t)(k0 + kk) * N + nn] : 0.f; }
    LDS_WAIT(); asm volatile("" ::: "memory");
    const int c = lane & 7;
#pragma unroll
    for (int j = 0; j < 4; ++j) { const int n = (lane >> 3) + 8 * j; const LAS float* s = scr + (8 * c) * 33 + n;
        v4u o; o.x = pk2(s[0 * 33], s[1 * 33]); o.y = pk2(s[2 * 33], s[3 * 33]); o.z = pk2(s[4 * 33], s[5 * 33]); o.w = pk2(s[6 * 33], s[7 * 33]);
        *(GAS v4u*)(WT + (size_t)(n0 + n) * K + k0 + 8 * c) = o; }
    LDS_WAIT(); asm volatile("" ::: "memory");
}
__device__ __forceinline__ void cvt_linear(Frame& F, const float* src, bf16* dst, size_t n8) {
    const size_t nth = (size_t)F.G * NWAVES * 64;
    for (size_t i = (size_t)F.vcu * NWAVES * 64 + F.tid; i < n8; i += nth) {
        const f32x4 a = *(const GAS f32x4*)(src + i * 8), b = *(const GAS f32x4*)(src + i * 8 + 4);
        v4u o; o.x = pk2(a.x, a.y); o.y = pk2(a.z, a.w); o.z = pk2(b.x, b.y); o.w = pk2(b.z, b.w);
        *(GAS v4u*)(dst + i * 8) = o;
    }
}
__device__ __forceinline__ void p0_prologue(Frame& F) {
    LAS float* scr = (LAS float*)(F.lds + RING_OFF + F.wave * 16384);
    const int gw = F.vcu * NWAVES + F.wave, NGW = F.G * NWAVES;
    constexpr int I_IN = (DM / 64) * (NPROJ_PAD / 32), I_SQ = (DM / 64) * (DM / 32), I_KV = (DM / 64) * (2 * DM / 32);
    constexpr int NITEMS = I_IN + 4 * I_SQ + I_KV;
    unsigned char* ws = F.ws;
    for (int it = gw; it < NITEMS; it += NGW) {
        int r = it;
        if (r < I_IN) { p0_transpose_item(F.in[2], DM, WIN_COLS, NPROJ_PAD, (bf16*)(ws + WS_WIN), scr, r, F.lane); continue; } r -= I_IN;
        if (r < I_KV) { p0_transpose_item(F.in[10], DM, 2 * DM, 2 * DM, (bf16*)(ws + WS_WKV), scr, r, F.lane); continue; } r -= I_KV;
        if (r < I_SQ) { p0_transpose_item(F.in[6], DM, DM, DM, (bf16*)(ws + WS_WOUT), scr, r, F.lane); continue; } r -= I_SQ;
        if (r < I_SQ) { p0_transpose_item(F.in[9], DM, DM, DM, (bf16*)(ws + WS_WQ), scr, r, F.lane); continue; } r -= I_SQ;
        if (r < I_SQ) { p0_transpose_item(F.in[11], DM, DM, DM, (bf16*)(ws + WS_WO), scr, r, F.lane); continue; } r -= I_SQ;
        p0_transpose_item(F.in[14], DM, DM, DM, (bf16*)(ws + WS_WPQ), scr, r, F.lane);
    }
    cvt_linear(F, F.in[0], (bf16*)(ws + WS_XB), (size_t)TOK * DM / 8);
    cvt_linear(F, F.in[1], (bf16*)(ws + WS_MEMB), (size_t)BATCH * MEMLEN * DM / 8);
    cvt_linear(F, F.in[15], (bf16*)(ws + WS_SUBK), (size_t)16 * 128 * 128 / 8);
}

struct EpiProj {
    static constexpr bool PERM = true, AFTER_DRAIN = false;
    pg8::bf16_t* O; float* gate;
    __device__ __forceinline__ void operator()(const pg8::f32x4 (&acc)[2][2][4][2], const pg8::Unit& u, int wr, int wc, int fr, int fq) const {
        const int row0 = u.pm * 256 + wr * 64 + fr;
        if (u.pn < 24) {
            const int col0 = u.pn * 256 + wc * 32 + 8 * fq;
#pragma unroll
            for (int ai = 0; ai < 2; ++ai)
#pragma unroll
                for (int m = 0; m < 4; ++m) { pg8::bf16_t* rowp = O + (size_t)(row0 + ai * 128 + m * 16) * NPROJ + col0;
#pragma unroll
                    for (int bj = 0; bj < 2; ++bj) { const pg8::f32x4 v0 = acc[ai][bj][m][0], v1 = acc[ai][bj][m][1];
                        pg8::u32x4 w; w.x = pg8::cvt_pk_bf16(v0[0], v0[1]); w.y = pg8::cvt_pk_bf16(v0[2], v0[3]); w.z = pg8::cvt_pk_bf16(v1[0], v1[1]); w.w = pg8::cvt_pk_bf16(v1[2], v1[3]);
                        *(pg8::u32x4*)(rowp + bj * 128) = w; } }
        } else if (wc == 0 && fq < 2) {
#pragma unroll
            for (int ai = 0; ai < 2; ++ai)
#pragma unroll
                for (int m = 0; m < 4; ++m) { float* gp = gate + (size_t)(row0 + ai * 128 + m * 16) * 16 + 8 * fq;
                    *(pg8::f32x4*)(gp) = acc[ai][0][m][0]; *(pg8::f32x4*)(gp + 4) = acc[ai][0][m][1]; }
        }
    }
};
struct EpiRes {
    static constexpr bool PERM = false, AFTER_DRAIN = false;
    const float* base; float* out; float alpha;
    __device__ __forceinline__ void operator()(const pg8::f32x4 (&acc)[2][2][4][2], const pg8::Unit& u, int wr, int wc, int fr, int fq) const {
        const int row0 = u.pm * 256 + wr * 64 + fr, col0 = u.pn * 256 + wc * 32 + 4 * fq;
#pragma unroll
        for (int ai = 0; ai < 2; ++ai)
#pragma unroll
            for (int m = 0; m < 4; ++m) { const size_t off = (size_t)(row0 + ai * 128 + m * 16) * DM + col0;
#pragma unroll
                for (int bj = 0; bj < 2; ++bj)
#pragma unroll
                    for (int n = 0; n < 2; ++n) { const pg8::f32x4 b = *(const pg8::f32x4*)(base + off + bj * 128 + n * 16);
                        *(pg8::f32x4*)(out + off + bj * 128 + n * 16) = b * alpha + acc[ai][bj][m][n]; } }
    }
};

__device__ __forceinline__ void kmean_phase(Frame& F) {
    const bf16* PROJ = (const bf16*)(F.ws + WS_PROJ); float* KMEAN = (float*)(F.ws + WS_KMEAN);
    const int gw = F.vcu * NWAVES + F.wave, NGW = F.G * NWAVES;
    for (int it = gw; it < BATCH * 8 * 16; it += NGW) {
        const int b = it >> 7, blk = (it >> 4) & 7, cc = it & 15;
        const bf16* p = PROJ + (size_t)(b * SEQ + blk * 256) * NPROJ + C_KM + cc * 64 + F.lane;
        float s = 0.f;
#pragma unroll 8
        for (int r = 0; r < 256; ++r) s += bf2f(p[(size_t)r * NPROJ]);
        KMEAN[(size_t)(b * 8 + blk) * 1024 + cc * 64 + F.lane] = s * (1.f / 256.f);
    }
}

template <int HD, int KC, int MODE>
__device__ __forceinline__ void naive_attn_unit(Frame& F, int unit) {
    constexpr int DPT = HD / 8, PIECES = KC * HD / 8;
    LAS bf16* Kc = (LAS bf16*)(F.lds + RING_OFF); LAS bf16* Vc = Kc + KC * HD;
    const int tid = F.tid, qi = tid >> 3, sub = tid & 7;
    int b, h, qt; const bf16 *Qp, *Kp, *Vp; bf16* Op; int ldq, ldk, ldo, nchunks, qb = 0, qpos = 0; float scale;
    if (MODE == 0) {
        b = unit >> 8; h = (unit >> 5) & 7; qt = unit & 31; qb = qt >> 2; qpos = qt * 64 + qi;
        const bf16* PROJ = (const bf16*)(F.ws + WS_PROJ);
        Qp = PROJ + (size_t)(b * SEQ + qt * 64 + qi) * NPROJ + C_QM + h * 128; ldq = NPROJ;
        Kp = PROJ + (size_t)(b * SEQ) * NPROJ + C_KM + h * 128; Vp = PROJ + (size_t)(b * SEQ) * NPROJ + C_VM + h * 128; ldk = NPROJ;
        Op = (bf16*)(F.ws + WS_ATT) + (size_t)(b * SEQ + qt * 64 + qi) * DM + h * 128; ldo = DM;
        nchunks = 4 * (qb + 1); scale = 0.08838834764831845f;
    } else {
        b = unit >> 7; h = (unit >> 5) & 3; qt = unit & 31;
        Qp = (const bf16*)(F.ws + WS_Q) + (size_t)(b * SEQ + qt * 64 + qi) * DM + h * 512; ldq = DM;
        const bf16* KV = (const bf16*)(F.ws + WS_KV);
        Kp = KV + (size_t)(b * MEMLEN) * (2 * DM) + h * 512; Vp = Kp + DM; ldk = 2 * DM;
        Op = (bf16*)(F.ws + WS_XO) + (size_t)(b * SEQ + qt * 64 + qi) * DM + h * 512; ldo = DM;
        nchunks = MEMLEN / KC; scale = 0.04419417382415922f;
    }
    (void)ldq; (void)ldo;
    float qv[DPT], o[DPT];
#pragma unroll
    for (int j = 0; j < DPT; j += 8) { const us8 w = *(const GAS us8*)(Qp + sub * DPT + j);
#pragma unroll
        for (int e = 0; e < 8; ++e) { qv[j + e] = bf2f(w[e]) * scale; o[j + e] = 0.f; } }
    unsigned sel = 0;
    if (MODE == 0) {
        const float* KM = (const float*)(F.ws + WS_KMEAN) + (size_t)(b * 8) * 1024 + h * 128 + sub * DPT;
        float g[8];
#pragma unroll
        for (int n = 0; n < 8; ++n) { float s = 0.f;
            if (n < qb) {
#pragma unroll
                for (int j = 0; j < DPT; ++j) s += qv[j] * KM[(size_t)n * 1024 + j]; }
            s += __shfl_xor(s, 1); s += __shfl_xor(s, 2); s += __shfl_xor(s, 4); g[n] = s; }
#pragma unroll
        for (int n = 0; n < 8; ++n) { int cnt = 0;
#pragma unroll
            for (int m = 0; m < 8; ++m) if (m != n && m < qb && (g[m] > g[n] || (g[m] == g[n] && m < n))) ++cnt;
            if (n < qb && cnt < 3) sel |= 1u << n; }
    }
    float mrun = -1e30f, lrun = 0.f;
    for (int c = 0; c < nchunks; ++c) {
        int key0; if (MODE == 0) key0 = (c < 4) ? qb * 256 + 64 * c : (c - 4) * 64; else key0 = c * KC;
        __syncthreads();
#pragma unroll
        for (int p = tid; p < PIECES; p += NWAVES * 64) { const int row = p / (HD / 8), c8 = p % (HD / 8);
            *(LAS v4u*)(Kc + row * HD + c8 * 8) = *(const GAS v4u*)(Kp + (size_t)(key0 + row) * ldk + c8 * 8);
            *(LAS v4u*)(Vc + row * HD + c8 * 8) = *(const GAS v4u*)(Vp + (size_t)(key0 + row) * ldk + c8 * 8); }
        __syncthreads();
        const bool blk_ok = (MODE == 1) || (c < 4) || ((sel >> ((c - 4) >> 2)) & 1u);
        for (int kk = 0; kk < KC; ++kk) {
            const LAS bf16* kr = Kc + kk * HD + sub * DPT; float part = 0.f;
#pragma unroll
            for (int j = 0; j < DPT; j += 8) { const us8 w = *(const LAS us8*)(kr + j);
#pragma unroll
                for (int e = 0; e < 8; ++e) part += qv[j + e] * bf2f(w[e]); }
            part += __shfl_xor(part, 1); part += __shfl_xor(part, 2); part += __shfl_xor(part, 4);
            bool ok = blk_ok; if (MODE == 0 && c < 4) ok = (key0 + kk) <= qpos;
            if (ok) {
                const float mn = fmaxf(mrun, part), al = __expf(mrun - mn), pp = __expf(part - mn);
                lrun = lrun * al + pp; mrun = mn;
                const LAS bf16* vr = Vc + kk * HD + sub * DPT;
#pragma unroll
                for (int j = 0; j < DPT; j += 8) { const us8 w = *(const LAS us8*)(vr + j);
#pragma unroll
                    for (int e = 0; e < 8; ++e) o[j + e] = o[j + e] * al + pp * bf2f(w[e]); }
            }
        }
    }
    const float inv = 1.f / lrun;
#pragma unroll
    for (int j = 0; j < DPT; j += 8) { v4u w; w.x = pk2(o[j] * inv, o[j + 1] * inv); w.y = pk2(o[j + 2] * inv, o[j + 3] * inv); w.z = pk2(o[j + 4] * inv, o[j + 5] * inv); w.w = pk2(o[j + 6] * inv, o[j + 7] * inv);
        *(GAS v4u*)(Op + sub * DPT + j) = w; }
}

__device__ __forceinline__ void naive_gla_unit(Frame& F, int unit) {
    const int b = unit >> 2, h = unit & 3, tid = F.tid, e = tid & 255, dh = tid >> 8;
    LAS float* GU = (LAS float*)(F.lds + RING_OFF);
    LAS float* GL = GU + 16 * 128;
    LAS float* As = GL + 32 * 16;
    LAS float* Ks = As + 32 * 128; LAS float* Qs = Ks + 32 * 128;
    LAS float* Op = Qs + 32 * 128;
    const bf16* PROJ = (const bf16*)(F.ws + WS_PROJ); const float* GATE = (const float*)(F.ws + WS_GATE);
    const float* gup = F.in[3]; const float* gbias = F.in[4]; const float* gnorm = F.in[5];
    bf16* ATT = (bf16*)(F.ws + WS_ATT);
    __syncthreads();
    for (int i = tid; i < 16 * 128; i += NWAVES * 64) GU[i] = gup[(size_t)(i >> 7) * 512 + h * 128 + (i & 127)];
    float st[64];
#pragma unroll
    for (int j = 0; j < 64; ++j) st[j] = 0.f;
    for (int ch = 0; ch < SEQ / 32; ++ch) {
        const size_t row0 = (size_t)b * SEQ + ch * 32;
        __syncthreads();
        GL[tid] = GATE[row0 * 16 + tid];
        __syncthreads();
        { const int tt = tid >> 4, dg = tid & 15;
          const us8 qw = *(const GAS us8*)(PROJ + (row0 + tt) * NPROJ + C_QG + h * 128 + dg * 8);
          const us8 kw = *(const GAS us8*)(PROJ + (row0 + tt) * NPROJ + C_KG + h * 128 + dg * 8);
#pragma unroll
          for (int j = 0; j < 8; ++j) { const int d = dg * 8 + j; float z = gbias[h * 128 + d];
#pragma unroll
              for (int r = 0; r < 16; ++r) z += GL[tt * 16 + r] * GU[r * 128 + d];
              const float ls = fminf(z, 0.f) - log1pf(__expf(-fabsf(z)));
              As[tt * 128 + d] = __expf(ls * (1.f / 16.f)); Ks[tt * 128 + d] = bf2f(kw[j]); Qs[tt * 128 + d] = bf2f(qw[j]) * 0.08838834764831845f; } }
        __syncthreads();
        for (int tt = 0; tt < 32; ++tt) {
            const float v = bf2f(PROJ[(row0 + tt) * NPROJ + C_VG + h * 256 + e]); float op = 0.f;
            const LAS float* ar = As + tt * 128 + dh * 64; const LAS float* kr = Ks + tt * 128 + dh * 64; const LAS float* qr = Qs + tt * 128 + dh * 64;
#pragma unroll
            for (int j = 0; j < 64; ++j) { st[j] = ar[j] * st[j] + kr[j] * v; op += qr[j] * st[j]; }
            Op[(dh * 32 + tt) * 256 + e] = op;
        }
        __syncthreads();
#pragma unroll
        for (int ti = 0; ti < 4; ++ti) { const int tt = F.wave * 4 + ti; float val[4], ss = 0.f;
#pragma unroll
            for (int i = 0; i < 4; ++i) { const int ee = F.lane + 64 * i; val[i] = Op[tt * 256 + ee] + Op[(32 + tt) * 256 + ee]; ss += val[i] * val[i]; }
            ss = wave_sum(ss); const float rs = 1.f / sqrtf(ss * (1.f / 256.f) + RMS_EPS);
#pragma unroll
            for (int i = 0; i < 4; ++i) { const int ee = F.lane + 64 * i; const float r = bf2f(PROJ[(row0 + tt) * NPROJ + C_RG + h * 256 + ee]);
                const float y = val[i] * rs * gnorm[ee] * (r / (1.f + __expf(-r)));
                ATT[(row0 + tt) * DM + 1024 + h * 256 + ee] = (bf16)f2bf(y); } }
    }
}

__device__ __forceinline__ void ln_phase(Frame& F, const float* g, const float* bb) {
    float* Z = (float*)(F.ws + WS_Z); bf16* HB = (bf16*)(F.ws + WS_HB);
    const int gw = F.vcu * NWAVES + F.wave, NGW = F.G * NWAVES;
    for (int m = gw; m < TOK; m += NGW) {
        GAS f32x4* zr = (GAS f32x4*)(Z + (size_t)m * DM) + F.lane;
        f32x4 v[8]; float s = 0.f;
#pragma unroll
        for (int j = 0; j < 8; ++j) { v[j] = zr[64 * j]; s += (v[j].x + v[j].y) + (v[j].z + v[j].w); }
        const float mean = wave_sum(s) * (1.f / DM); float s2 = 0.f;
#pragma unroll
        for (int j = 0; j < 8; ++j) { v[j] = v[j] - mean; s2 += (v[j].x * v[j].x + v[j].y * v[j].y) + (v[j].z * v[j].z + v[j].w * v[j].w); }
        const float rstd = 1.f / sqrtf(wave_sum(s2) * (1.f / DM) + LN_EPS);
        GAS unsigned long long* o8 = (GAS unsigned long long*)(HB + (size_t)m * DM) + F.lane;
#pragma unroll
        for (int j = 0; j < 8; ++j) { const f32x4 gg = *((const GAS f32x4*)g + F.lane + 64 * j), b4 = *((const GAS f32x4*)bb + F.lane + 64 * j);
            const f32x4 y = v[j] * rstd * gg + b4; zr[64 * j] = y;
            o8[64 * j] = (unsigned long long)pk2(y.x, y.y) | ((unsigned long long)pk2(y.z, y.w) << 32); }
    }
}

typedef short s16x8 __attribute__((ext_vector_type(8)));
__device__ __forceinline__ void top16_128(float v0, float v1, int lane, float& outv, int& outi) {
    outv = -INFINITY; outi = 0;
#pragma unroll 1
    for (int r = 0; r < 16; ++r) {
        const float wm = wave_max(fmaxf(v0, v1));
        const unsigned long long b0 = __ballot(v0 == wm), b1 = __ballot(v1 == wm);
        const int idx = b0 ? (int)__builtin_ctzll(b0) : 64 + (int)__builtin_ctzll(b1);
        if (lane == idx) v0 = -INFINITY;
        if (lane + 64 == idx) v1 = -INFINITY;
        if (lane == r) { outv = wm; outi = idx; }
    }
}
__device__ __forceinline__ float gelu_erf(float x) { return 0.5f * x * (1.f + erff(x * 0.7071067811865476f)); }
__device__ __forceinline__ void peer_phase(Frame& F) {
    LAS float* sc = (LAS float*)(F.lds + RING_OFF);
    const bf16* PQ = (const bf16*)(F.ws + WS_Q); const bf16* SUBK = (const bf16*)(F.ws + WS_SUBK);
    const bf16* PU = (const bf16*)(F.ws + WS_PU); const bf16* PV = (const bf16*)(F.ws + WS_PV);
    const float* Z = (const float*)(F.ws + WS_Z); const float* g3 = F.in[18]; const float* b3 = F.in[19];
    const int lane = F.lane, wave = F.wave;
    for (int unit = F.vcu; unit < TOK / 16; unit += F.G) {
        const int t0 = unit * 16;
        __syncthreads();
#pragma unroll 1
        for (int gi = 0; gi < 2; ++gi) { const int g = 2 * wave + gi;
            s16x8 a[4];
#pragma unroll
            for (int ks = 0; ks < 4; ++ks) a[ks] = *(const GAS s16x8*)(PQ + (size_t)(t0 + (lane & 15)) * DM + g * 128 + ks * 32 + 8 * (lane >> 4));
#pragma unroll 2
            for (int nt = 0; nt < 8; ++nt) { f32x4 acc = {0.f, 0.f, 0.f, 0.f};
#pragma unroll
                for (int ks = 0; ks < 4; ++ks) { const s16x8 bfr = *(const GAS s16x8*)(SUBK + (size_t)(g * 128 + nt * 16 + (lane & 15)) * 128 + ks * 32 + 8 * (lane >> 4));
                    acc = __builtin_amdgcn_mfma_f32_16x16x32_bf16(a[ks], bfr, acc, 0, 0, 0); }
#pragma unroll
                for (int r = 0; r < 4; ++r) sc[(4 * (lane >> 4) + r) * 2048 + g * 128 + nt * 16 + (lane & 15)] = acc[r]; } }
        __syncthreads();
#pragma unroll 1
        for (int ti = 0; ti < 2; ++ti) { const int tl = 2 * wave + ti; const size_t t = (size_t)t0 + tl;
            int E0 = 0, E1 = 0; float G0 = 0.f, G1 = 0.f;
#pragma unroll 1
            for (int hh = 0; hh < 8; ++hh) {
                float sA, sB; int iA, iB;
                top16_128(sc[tl * 2048 + (2 * hh) * 128 + lane], sc[tl * 2048 + (2 * hh) * 128 + 64 + lane], lane, sA, iA);
                top16_128(sc[tl * 2048 + (2 * hh + 1) * 128 + lane], sc[tl * 2048 + (2 * hh + 1) * 128 + 64 + lane], lane, sB, iB);
                int ca, cb; const int c = lane;
                if (c < 16) { ca = 0; cb = c; } else if (c < 24) { ca = 1; cb = c - 16; } else if (c < 29) { ca = 2; cb = c - 24; } else if (c < 33) { ca = 3; cb = c - 29; }
                else if (c < 36) { ca = 4; cb = c - 33; } else if (c < 38) { ca = 5; cb = c - 36; } else if (c < 40) { ca = 6; cb = c - 38; } else if (c < 42) { ca = 7; cb = c - 40; }
                else { ca = 8 + ((c - 42) & 7); cb = 0; }
                float cv = __shfl(sA, ca) + __shfl(sB, cb); const int ce = __shfl(iA, ca) * 128 + __shfl(iB, cb);
                if (c >= 50) cv = -INFINITY;
                float bv = -INFINITY; int be = 0;
#pragma unroll 1
                for (int r = 0; r < 16; ++r) { const float wm = wave_max(cv); const unsigned long long bal = __ballot(cv == wm); const int idx = (int)__builtin_ctzll(bal);
                    const int ee = __shfl(ce, idx); if (lane == idx) cv = -INFINITY; if (lane == r) { bv = wm; be = ee; } }
                const float mx = __shfl(bv, 0); const float p = (lane < 16) ? __expf(bv - mx) : 0.f; const float gt = p / wave_sum(p);
                const int src = lane & 15; const int e_s = __shfl(be, src); const float g_s = __shfl(gt, src);
                if ((lane >> 4) == (hh & 3)) { if (hh < 4) { E0 = e_s; G0 = g_s; } else { E1 = e_s; G1 = g_s; } }
            }
            float xr[32];
#pragma unroll
            for (int i = 0; i < 4; ++i) { const f32x4 p0 = *(const GAS f32x4*)(Z + t * DM + 512 * i + 8 * lane), p1 = *(const GAS f32x4*)(Z + t * DM + 512 * i + 8 * lane + 4);
                xr[8 * i] = p0.x; xr[8 * i + 1] = p0.y; xr[8 * i + 2] = p0.z; xr[8 * i + 3] = p0.w; xr[8 * i + 4] = p1.x; xr[8 * i + 5] = p1.y; xr[8 * i + 6] = p1.z; xr[8 * i + 7] = p1.w; }
            float H0 = 0.f, H1 = 0.f;
#pragma unroll 1
            for (int half = 0; half < 2; ++half) {
#pragma unroll 4
                for (int kk = 0; kk < 64; ++kk) { const int e = __builtin_amdgcn_readlane(half ? E1 : E0, kk);
                    const bf16* ur = PU + (size_t)e * DM + 8 * lane; float d = 0.f;
#pragma unroll
                    for (int i = 0; i < 4; ++i) { const us8 w = *(const GAS us8*)(ur + 512 * i);
#pragma unroll
                        for (int j = 0; j < 8; ++j) d += xr[8 * i + j] * bf2f(w[j]); }
                    d = wave_sum(d);
                    if (lane == kk) { if (half) H1 = d; else H0 = d; } } }
            const float C0 = G0 * gelu_erf(H0), C1 = G1 * gelu_erf(H1);
            float acc[32];
#pragma unroll
            for (int j = 0; j < 32; ++j) acc[j] = 0.f;
#pragma unroll 1
            for (int half = 0; half < 2; ++half) {
#pragma unroll 4
                for (int kk = 0; kk < 64; ++kk) { const int e = __builtin_amdgcn_readlane(half ? E1 : E0, kk);
                    const float cf = __uint_as_float((unsigned)__builtin_amdgcn_readlane((int)__float_as_uint(half ? C1 : C0), kk));
                    const bf16* vr = PV + (size_t)e * DM + 8 * lane;
#pragma unroll
                    for (int i = 0; i < 4; ++i) { const us8 w = *(const GAS us8*)(vr + 512 * i);
#pragma unroll
                        for (int j = 0; j < 8; ++j) acc[8 * i + j] += cf * bf2f(w[j]); } } }
            float s = 0.f;
#pragma unroll
            for (int j = 0; j < 32; ++j) { acc[j] = DN_ALPHA * xr[j] + acc[j]; s += acc[j]; }
            const float mean = wave_sum(s) * (1.f / DM); float s2 = 0.f;
#pragma unroll
            for (int j = 0; j < 32; ++j) { acc[j] -= mean; s2 += acc[j] * acc[j]; }
            const float rstd = 1.f / sqrtf(wave_sum(s2) * (1.f / DM) + LN_EPS);
#pragma unroll
            for (int i = 0; i < 4; ++i) { const int c0 = 512 * i + 8 * lane;
                const f32x4 ga = *(const GAS f32x4*)(g3 + c0), gb = *(const GAS f32x4*)(g3 + c0 + 4), ba = *(const GAS f32x4*)(b3 + c0), bb = *(const GAS f32x4*)(b3 + c0 + 4);
                f32x4 ya, yb;
                ya.x = acc[8 * i] * rstd * ga.x + ba.x; ya.y = acc[8 * i + 1] * rstd * ga.y + ba.y; ya.z = acc[8 * i + 2] * rstd * ga.z + ba.z; ya.w = acc[8 * i + 3] * rstd * ga.w + ba.w;
                yb.x = acc[8 * i + 4] * rstd * gb.x + bb.x; yb.y = acc[8 * i + 5] * rstd * gb.y + bb.y; yb.z = acc[8 * i + 6] * rstd * gb.z + bb.z; yb.w = acc[8 * i + 7] * rstd * gb.w + bb.w;
                *(GAS f32x4*)(F.out + t * DM + c0) = ya; *(GAS f32x4*)(F.out + t * DM + c0 + 4) = yb; }
        }
    }
}

struct Args { const float* in[20]; float* out; unsigned char* ws; int ph_lo, ph_hi, li, pad; };
__global__ void __launch_bounds__(NWAVES * 64, 2) mk_fwd(Args args) {
    extern __shared__ __attribute__((aligned(16))) unsigned char lds[];
    Frame F;
    F.lds = (LAS unsigned char*)lds;
    F.MISC = (volatile LAS unsigned*)(F.lds + MISC_OFF);
    F.tid = threadIdx.x; F.lane = F.tid & 63; F.wave = __builtin_amdgcn_readfirstlane(F.tid >> 6);
    F.G = gridDim.x; { const int bx = blockIdx.x; F.vcu = (F.G % 8 == 0) ? (bx % 8) * (F.G / 8) + bx / 8 : bx; }
#pragma unroll
    for (int i = 0; i < 20; ++i) F.in[i] = args.in[i];
    F.out = args.out; F.ws = args.ws;
    unsigned char* ws = args.ws;
    F.ctl = (gu32*)(ws + WS_CTL);
    for (int u = F.tid; u < (LDS_BYTES - LDSCTL_OFF) / 4; u += NWAVES * 64) ((LAS unsigned*)(F.lds + LDSCTL_OFF))[u] = 0u;
    __syncthreads();
    XcdBarrier bar; bar.bar = (unsigned*)(F.ctl + CW_BAR); bar.x = 0; bar.st = nullptr;
    if (N_LAUNCHES != PER_PHASE) bar = xcd_barrier_post((unsigned*)(F.ctl + CW_BAR), F.MISC + 8);
#define GRID_BAR() do { if (N_LAUNCHES != PER_PHASE) xcd_barrier(bar); } while (0)
    const int lo = args.ph_lo, hi = args.ph_hi;
#define IN(k) (lo <= (k) && (k) < hi)
#define BOTH(k) (IN(k) && IN((k) + 1))

    if (IN(0)) { p0_prologue(F); if (BOTH(0)) GRID_BAR(); }
    if (IN(1)) {
        { pg8::Gemm g{(const pg8::bf16_t*)(ws + WS_XB), (const pg8::bf16_t*)(ws + WS_WIN), TOK, NPROJ_PAD, DM}; pg8::StaticOrder S; S.init(TOK, NPROJ_PAD, F.G, (int)blockIdx.x);
          EpiProj E{(pg8::bf16_t*)(ws + WS_PROJ), (float*)(ws + WS_GATE)};
          pg8::gemm_phase<EpiProj, pg8::StaticOrder, PG8_ALIGN, PG8_SP2>(F.lds + RING_OFF, g, S, E); }
        { const int nu1 = (TOK / 256) * (NPROJ_PAD / 256); const int shift = nu1 % F.G; const int c2 = ((int)blockIdx.x - shift + F.G) % F.G;
          pg8::Gemm g{(const pg8::bf16_t*)(ws + WS_MEMB), (const pg8::bf16_t*)(ws + WS_WKV), BATCH * MEMLEN, 2 * DM, DM}; pg8::StaticOrder S; S.init(BATCH * MEMLEN, 2 * DM, F.G, c2);
          pg8::EpiBf16<0> E{(pg8::bf16_t*)(ws + WS_KV), 2 * DM, nullptr, 0, 0, 1.f};
          pg8::gemm_phase<pg8::EpiBf16<0>, pg8::StaticOrder, PG8_ALIGN, PG8_SP2>(F.lds + RING_OFF, g, S, E); }
        if (BOTH(1)) GRID_BAR();
    }
    if (IN(2)) { kmean_phase(F); if (BOTH(2)) GRID_BAR(); }
    if (IN(3)) {
        if (F.vcu < 32) naive_gla_unit(F, F.vcu);
        else for (int u = F.vcu - 32; u < BATCH * 8 * 32; u += F.G - 32) naive_attn_unit<128, 64, 0>(F, u);
        if (BOTH(3)) GRID_BAR();
    }
    if (IN(4)) {
        pg8::Gemm g{(const pg8::bf16_t*)(ws + WS_ATT), (const pg8::bf16_t*)(ws + WS_WOUT), TOK, DM, DM}; pg8::StaticOrder S; S.init(TOK, DM, F.G, (int)blockIdx.x);
        EpiRes E{F.in[0], (float*)(ws + WS_Z), DN_ALPHA};
        pg8::gemm_phase<EpiRes, pg8::StaticOrder, PG8_ALIGN, PG8_SP2>(F.lds + RING_OFF, g, S, E);
        if (BOTH(4)) GRID_BAR();
    }
    if (IN(5)) { ln_phase(F, F.in[7], F.in[8]); if (BOTH(5)) GRID_BAR(); }
    if (IN(6)) {
        pg8::Gemm g{(const pg8::bf16_t*)(ws + WS_HB), (const pg8::bf16_t*)(ws + WS_WQ), TOK, DM, DM}; pg8::StaticOrder S; S.init(TOK, DM, F.G, (int)blockIdx.x);
        pg8::EpiBf16<0> E{(pg8::bf16_t*)(ws + WS_Q), DM, nullptr, 0, 0, 1.f};
        pg8::gemm_phase<pg8::EpiBf16<0>, pg8::StaticOrder, PG8_ALIGN, PG8_SP2>(F.lds + RING_OFF, g, S, E);
        if (BOTH(6)) GRID_BAR();
    }
    if (IN(7)) { for (int u = F.vcu; u < BATCH * 4 * 32; u += F.G) naive_attn_unit<512, 32, 1>(F, u); if (BOTH(7)) GRID_BAR(); }
    if (IN(8)) {
        pg8::Gemm g{(const pg8::bf16_t*)(ws + WS_XO), (const pg8::bf16_t*)(ws + WS_WO), TOK, DM, DM}; pg8::StaticOrder S; S.init(TOK, DM, F.G, (int)blockIdx.x);
        EpiRes E{(const float*)(ws + WS_Z), (float*)(ws + WS_Z), DN_ALPHA};
        pg8::gemm_phase<EpiRes, pg8::StaticOrder, PG8_ALIGN, PG8_SP2>(F.lds + RING_OFF, g, S, E);
        if (BOTH(8)) GRID_BAR();
    }
    if (IN(9)) {
        ln_phase(F, F.in[12], F.in[13]);
        cvt_linear(F, F.in[16], (bf16*)(ws + WS_PU), (size_t)16384 * DM / 8);
        cvt_linear(F, F.in[17], (bf16*)(ws + WS_PV), (size_t)16384 * DM / 8);
        if (BOTH(9)) GRID_BAR();
    }
    if (IN(10)) {
        pg8::Gemm g{(const pg8::bf16_t*)(ws + WS_HB), (const pg8::bf16_t*)(ws + WS_WPQ), TOK, DM, DM}; pg8::StaticOrder S; S.init(TOK, DM, F.G, (int)blockIdx.x);
        pg8::EpiBf16<0> E{(pg8::bf16_t*)(ws + WS_Q), DM, nullptr, 0, 0, 1.f};
        pg8::gemm_phase<pg8::EpiBf16<0>, pg8::StaticOrder, PG8_ALIGN, PG8_SP2>(F.lds + RING_OFF, g, S, E);
        if (BOTH(10)) GRID_BAR();
    }
    if (IN(11)) { peer_phase(F); }
#undef IN
#undef BOTH
}

extern "C" void kernel_launch(void* const* d_in, const int* in_sizes, int n_in, void* d_out, int out_size, void* d_ws, size_t ws_size, hipStream_t stream) {
    static int grid = 0;
    if (grid == 0) {
        if (n_in != 20 || out_size != TOK * DM || ws_size < WS_END) { fprintf(stderr, "kernel_launch: unexpected shapes (n_in %d out %d ws %zu)\n", n_in, out_size, ws_size); grid = -1; return; }
        int dev = 0, cus = 0;
        if (hipGetDevice(&dev) != hipSuccess || hipDeviceGetAttribute(&cus, hipDeviceAttributeMultiprocessorCount, dev) != hipSuccess) { grid = -1; return; }
        if (hipFuncSetAttribute((const void*)mk_fwd, hipFuncAttributeMaxDynamicSharedMemorySize, LDS_BYTES) != hipSuccess) { fprintf(stderr, "kernel_launch: hipFuncSetAttribute failed\n"); grid = -1; return; }
        (void)hipGetLastError();
        grid = cus;
    }
    if (grid < 0) return;
    (void)hipMemsetAsync((char*)d_ws + WS_CTL, 0, CTL_ZERO_BYTES, stream);
    Args a{};
    for (int i = 0; i < 20; ++i) a.in[i] = (const float*)d_in[i];
    a.out = (float*)d_out; a.ws = (unsigned char*)d_ws;
    if (N_LAUNCHES == 1) { a.ph_lo = 0; a.ph_hi = PER_PHASE; a.li = 0; hipLaunchKernelGGL(mk_fwd, dim3(grid), dim3(NWAVES * 64), LDS_BYTES, stream, a); }
    else for (int li = 0; li < PER_PHASE; ++li) { a.ph_lo = li; a.ph_hi = li + 1; a.li = li; hipLaunchKernelGGL(mk_fwd, dim3(grid), dim3(NWAVES * 64), LDS_BYTES, stream, a); }
}
```

```cpp
#include <hip/hip_runtime.h>
#include <cstdio>
#include <cstdint>
namespace pg8 {
#define PG8_LAS __attribute__((address_space(3)))
typedef unsigned short bf16_t;
typedef short bf16x8 __attribute__((ext_vector_type(8)));
typedef float f32x4 __attribute__((ext_vector_type(4)));
typedef unsigned u32x4 __attribute__((ext_vector_type(4)));
constexpr int BM = 256, BK = 64, HALF = 128, HTB = HALF * BK * 2  , STAGE_BYTES = 8 * HTB, NXCD = 8, WGM = 8;

__host__ __device__ __forceinline__ int lds_byte(int r, int c) { const int st = (r >> 4) * 2 + (c >> 5), rr = r & 15, cc = c & 31, ob = rr * 64 + cc * 2; return st * 1024 + (ob ^ (((ob >> 9) & 1) << 5)); }
__host__ __device__ __forceinline__ void stage_rc(int b, int& R, int& C) { const int st = b / 1024, sb = b % 1024, swz = sb ^ (((sb >> 9) & 1) << 5); R = (st >> 1) * 16 + swz / 64; C = (st & 1) * 32 + (swz % 64) / 2; }
__host__ __device__ __forceinline__ int perm32(int rho) { const int n = rho >> 4, i = rho & 15; return 8 * (i >> 2) + 4 * n + (i & 3); }

struct Unit { int pm, pn; };
struct Gemm { const bf16_t* A; const bf16_t* Bt; int M, N, K; };

struct StaticOrder {
    int nM, nN, nwg, G, c;
    __host__ __device__ void init(int M, int N, int G_, int c_) { nM = M / BM; nN = N / BM; nwg = nM * nN; G = G_; c = c_; }
    __host__ __device__ bool next(int i, Unit& u) const {
        const long L = (long)i * G + c; if (L >= nwg) return false;
        int wgid = (int)L; { const int q = nwg / NXCD, r = nwg % NXCD, xcd = wgid % NXCD, off = wgid / NXCD; wgid = (xcd < r ? xcd * (q + 1) : r * (q + 1) + (xcd - r) * q) + off; }
        const int nig = WGM * nN, gid = wgid / nig, fm = gid * WGM, gsz = (nM - fm) < WGM ? (nM - fm) : WGM;
        u.pm = fm + ((wgid % nig) % gsz); u.pn = (wgid % nig) / gsz; return true;
    }
    __device__ __forceinline__ void a_ready(const Unit&) const {}
    __device__ __forceinline__ void done(const Unit&) const {}
};

__device__ __forceinline__ unsigned cvt_pk_bf16(float lo, float hi) { unsigned r; asm volatile("v_cvt_pk_bf16_f32 %0, %1, %2" : "=v"(r) : "v"(lo), "v"(hi)); return r; }
typedef float f32x2 __attribute__((ext_vector_type(2)));
__device__ __forceinline__ f32x2 gelu_pk(f32x2 v) {
    const f32x2 av = __builtin_elementwise_abs(v), d = av * 0.2316418882f + 1.0f;
    f32x2 t; t.x = __builtin_amdgcn_rcpf(d.x); t.y = __builtin_amdgcn_rcpf(d.y);
    f32x2 q = t * 0.5307027145f + (-0.7265760135f); q = q * t + 0.7107068705f; q = q * t + (-0.142248368f); q = q * t + 0.127414796f; q = q * t;
    const f32x2 s = (v * v) * (-0.72134752044f);
    f32x2 e; e.x = __builtin_amdgcn_exp2f(s.x); e.y = __builtin_amdgcn_exp2f(s.y);
    const f32x2 m = v * (q * e), r = v - m;
    f32x2 o; o.x = v.x < 0.f ? m.x : r.x; o.y = v.y < 0.f ? m.y : r.y; return o;
}

template <int ACT  > struct EpiBf16 {
    static constexpr bool PERM = true, AFTER_DRAIN = false; static_assert(ACT == 0 || ACT == 1, "EpiBf16: ACT is 0 (none) or 1 (gelu_pk)");
    bf16_t* O; int ldc; const float* bias; int split_cols; size_t split_stride; float scale0;
    __device__ __forceinline__ void operator()(const f32x4 (&acc)[2][2][4][2], const Unit& u, int wr, int wc, int fr, int fq) const {
        const int row0 = u.pm * BM + wr * 64 + fr; int colt = u.pn * BM; bf16_t* base = O;
        float sc = 1.f; if (split_cols) { const int t = colt / split_cols; base += (size_t)t * split_stride; colt -= t * split_cols; if (t == 0) sc = scale0; }
        const int col0 = colt + wc * 32 + 8 * fq, bcol0 = u.pn * BM + wc * 32 + 8 * fq;
        f32x4 bv[2][2];
#pragma unroll
        for (int bj = 0; bj < 2; ++bj)
#pragma unroll
            for (int n = 0; n < 2; ++n) bv[bj][n] = bias ? *(const f32x4*)(bias + bcol0 + bj * HALF + 4 * n) : (f32x4){0.f, 0.f, 0.f, 0.f};
#pragma unroll
        for (int ai = 0; ai < 2; ++ai)
#pragma unroll
            for (int m = 0; m < 4; ++m) { bf16_t* rowp = base + (size_t)(row0 + ai * HALF + m * 16) * ldc + col0;
#pragma unroll
                for (int bj = 0; bj < 2; ++bj) { f32x4 v0 = acc[ai][bj][m][0] + bv[bj][0], v1 = acc[ai][bj][m][1] + bv[bj][1];
                    if (ACT == 1) { f32x2 a = gelu_pk((f32x2){v0[0], v0[1]}), b = gelu_pk((f32x2){v0[2], v0[3]}), c = gelu_pk((f32x2){v1[0], v1[1]}), d = gelu_pk((f32x2){v1[2], v1[3]});
                        v0 = (f32x4){a.x, a.y, b.x, b.y}; v1 = (f32x4){c.x, c.y, d.x, d.y}; }
                    v0 = v0 * sc; v1 = v1 * sc; u32x4 w; w.x = cvt_pk_bf16(v0[0], v0[1]); w.y = cvt_pk_bf16(v0[2], v0[3]); w.z = cvt_pk_bf16(v1[0], v1[1]); w.w = cvt_pk_bf16(v1[2], v1[3]);
                    *(u32x4*)(rowp + bj * HALF) = w; } }
    }
};

struct PanelStats {
    unsigned* xbuf;
    unsigned* cnt;
    unsigned* tmo;
    int ntn; float eps;
    unsigned code;
    __device__ __forceinline__ bool run(const f32x4 (&v)[2][2][4][2], const Unit& u, int wr, int wc, int fr, int fq, PG8_LAS unsigned char* lds, int wid, int lane) const {
        typedef float f32x2v __attribute__((ext_vector_type(2)));
        PG8_LAS f32x2v* P = (PG8_LAS f32x2v*)lds;
        PG8_LAS f32x2v* S = (PG8_LAS f32x2v*)(lds + 8192);
        PG8_LAS unsigned* flag = (PG8_LAS unsigned*)(lds + 8192 + 2048);
#pragma unroll
        for (int ai = 0; ai < 2; ++ai)
#pragma unroll
            for (int m = 0; m < 4; ++m) {
                float s = 0.f;
#pragma unroll
                for (int bj = 0; bj < 2; ++bj)
#pragma unroll
                    for (int n = 0; n < 2; ++n) { const f32x4 x = v[ai][bj][m][n]; s += (x[0] + x[1]) + (x[2] + x[3]); }
                s += __shfl_xor(s, 16); s += __shfl_xor(s, 32);
                const float mw = s * (1.0f / 64.0f); float q = 0.f;
#pragma unroll
                for (int bj = 0; bj < 2; ++bj)
#pragma unroll
                    for (int n = 0; n < 2; ++n) { const f32x4 d = v[ai][bj][m][n] - mw; q += (d[0] * d[0] + d[1] * d[1]) + (d[2] * d[2] + d[3] * d[3]); }
                q += __shfl_xor(q, 16); q += __shfl_xor(q, 32);
                if (fq == 0) P[(ai * HALF + wr * 64 + m * 16 + fr) * 4 + wc] = (f32x2v){mw, q};
            }
        asm volatile("s_waitcnt lgkmcnt(0)" ::: "memory"); __builtin_amdgcn_s_barrier(); asm volatile("" ::: "memory");
#if defined(BROKEN_EXCHANGE_NO_WAIT)
#warning BROKEN CONTROL BUILD: the row-statistics exchange does not wait; results are wrong by design
        if (blockIdx.x >= 64) { const long long t0_ = clock64(); while (clock64() - t0_ < 60000) __builtin_amdgcn_s_sleep(8); }
#endif
        const int row = wid * 32 + (lane & 31);
        if (lane < 32) {
            const f32x2v a = P[row * 4 + 0], b = P[row * 4 + 1], c = P[row * 4 + 2], d = P[row * 4 + 3];
            const float mt = (a.x + b.x + c.x + d.x) * 0.25f;
            const float da = a.x - mt, db = b.x - mt, dc = c.x - mt, dd = d.x - mt;
            const float m2 = (a.y + b.y) + (c.y + d.y) + 64.0f * ((da * da + db * db) + (dc * dc + dd * dd));
            unsigned long long* slot = (unsigned long long*)xbuf + ((size_t)(u.pm * BM + row) * 4 + u.pn);
            __hip_atomic_store(slot, ((unsigned long long)__float_as_uint(m2) << 32) | __float_as_uint(mt), __ATOMIC_RELAXED, __HIP_MEMORY_SCOPE_AGENT);
        }
        asm volatile("s_waitcnt vmcnt(0)" ::: "memory");
        if (lane == 0) __hip_atomic_fetch_add(cnt + 64 * u.pm, 1u, __ATOMIC_RELAXED, __HIP_MEMORY_SCOPE_AGENT);
        if (wid == 0) {
            bool dead = false; const unsigned long long t0 = __builtin_amdgcn_s_memrealtime(); const unsigned want = 8u * (unsigned)ntn;
            for (;;) {
#if defined(BROKEN_EXCHANGE_NO_WAIT)
                break;
#endif
                if ((unsigned)__builtin_amdgcn_readfirstlane(__hip_atomic_load(cnt + 64 * u.pm, __ATOMIC_RELAXED, __HIP_MEMORY_SCOPE_AGENT)) >= want) break;
                if (__builtin_amdgcn_s_memrealtime() - t0 > 2000000ull) {
                    if (lane == 0) { unsigned expect = 0u; __hip_atomic_compare_exchange_strong(tmo + 1, &expect, code | (unsigned)(u.pm & 0xff), __ATOMIC_RELAXED, __ATOMIC_RELAXED, __HIP_MEMORY_SCOPE_AGENT);
                                     __hip_atomic_store(tmo, 1u, __ATOMIC_RELAXED, __HIP_MEMORY_SCOPE_AGENT); }
                    dead = true; break; }
                __builtin_amdgcn_s_sleep(2);
            }
            __builtin_amdgcn_fence(__ATOMIC_ACQUIRE, "agent");
            if (lane == 0) flag[0] = dead ? 1u : 0u;
        }
        asm volatile("s_waitcnt vmcnt(0) lgkmcnt(0)" ::: "memory"); __builtin_amdgcn_s_barrier(); asm volatile("" ::: "memory");
        const bool bad = flag[0] != 0u;
        if (lane < 32) {
            const unsigned long long* slot = (const unsigned long long*)xbuf + (size_t)(u.pm * BM + row) * 4; float mt[4], m2[4]; float ms = 0.f;
#pragma unroll
            for (int t = 0; t < 4; ++t) { if (t < ntn) { const unsigned long long w = __hip_atomic_load(slot + t, __ATOMIC_RELAXED, __HIP_MEMORY_SCOPE_AGENT); mt[t] = __uint_as_float((unsigned)w); m2[t] = __uint_as_float((unsigned)(w >> 32)); } else { mt[t] = 0.f; m2[t] = 0.f; } ms += mt[t]; }
            const float mean = ms / (float)ntn; float q = 0.f;
#pragma unroll
            for (int t = 0; t < 4; ++t) if (t < ntn) { const float dm = mt[t] - mean; q += m2[t] + 256.0f * dm * dm; }
            S[row] = (f32x2v){mean, 1.0f / sqrtf(q / (256.0f * (float)ntn) + eps)};
        }
        asm volatile("s_waitcnt lgkmcnt(0)" ::: "memory"); __builtin_amdgcn_s_barrier(); asm volatile("" ::: "memory");
        return bad;
    }
};
struct EpiLnRes {
    static constexpr bool PERM = false, AFTER_DRAIN = true;
    const float* base; float* out; int ldc; const float* bias; PanelStats st; unsigned poison;
    __device__ __forceinline__ void fused(f32x4 (&acc)[2][2][4][2], const Unit& u, int wr, int wc, int fr, int fq, PG8_LAS unsigned char* lds, int wid, int lane) const {
        typedef float f32x2v __attribute__((ext_vector_type(2)));
        const PG8_LAS f32x2v* S = (const PG8_LAS f32x2v*)(lds + 8192);
        const int col0 = u.pn * BM + wc * 32 + 4 * fq;
#pragma unroll
        for (int bj = 0; bj < 2; ++bj)
#pragma unroll
            for (int n = 0; n < 2; ++n) { const f32x4 bv = bias ? *(const f32x4*)(bias + col0 + bj * HALF + n * 16) : (f32x4){0.f, 0.f, 0.f, 0.f};
#pragma unroll
                for (int ai = 0; ai < 2; ++ai)
#pragma unroll
                    for (int m = 0; m < 4; ++m) acc[ai][bj][m][n] += bv; }
        f32x4 pre[4][2][2];
#pragma unroll
        for (int m = 0; m < 4; ++m) { const size_t off = (size_t)(u.pm * BM + wr * 64 + m * 16 + fr) * ldc + col0;
#pragma unroll
            for (int bj = 0; bj < 2; ++bj)
#pragma unroll
                for (int n = 0; n < 2; ++n) pre[m][bj][n] = *(const f32x4*)(base + off + bj * HALF + n * 16); }
        const bool bad = st.run(acc, u, wr, wc, fr, fq, lds, wid, lane) || poison != 0u;
        const float qnan = __builtin_nanf("");
#pragma unroll
        for (int ai = 0; ai < 2; ++ai)
#pragma unroll
            for (int m = 0; m < 4; ++m) { const int r = ai * HALF + wr * 64 + m * 16 + fr; const f32x2v sr = S[r]; const size_t off = (size_t)(u.pm * BM + r) * ldc + col0;
#pragma unroll
                for (int bj = 0; bj < 2; ++bj)
#pragma unroll
                    for (int n = 0; n < 2; ++n) { const f32x4 bs = ai == 0 ? pre[m][bj][n] : *(const f32x4*)(base + off + bj * HALF + n * 16); f32x4 o = bs + (acc[ai][bj][m][n] - sr.x) * sr.y;
                        if (bad) o = (f32x4){qnan, qnan, qnan, qnan}; *(f32x4*)(out + off + bj * HALF + n * 16) = o; }
                if (m & 1) asm volatile("" ::: "memory"); }
    }
};
struct EpiLnResLn {
    static constexpr bool PERM = false, AFTER_DRAIN = true;
    const float* base; float* out; bf16_t* xn; int ldc; const float* bias; PanelStats st1, st2; unsigned poison;
    __device__ __forceinline__ void fused(f32x4 (&acc)[2][2][4][2], const Unit& u, int wr, int wc, int fr, int fq, PG8_LAS unsigned char* lds, int wid, int lane) const {
        typedef float f32x2v __attribute__((ext_vector_type(2))); typedef unsigned u32x2v __attribute__((ext_vector_type(2)));
        const PG8_LAS f32x2v* S = (const PG8_LAS f32x2v*)(lds + 8192);
        const int col0 = u.pn * BM + wc * 32 + 4 * fq;
#pragma unroll
        for (int bj = 0; bj < 2; ++bj)
#pragma unroll
            for (int n = 0; n < 2; ++n) { const f32x4 bv = bias ? *(const f32x4*)(bias + col0 + bj * HALF + n * 16) : (f32x4){0.f, 0.f, 0.f, 0.f};
#pragma unroll
                for (int ai = 0; ai < 2; ++ai)
#pragma unroll
                    for (int m = 0; m < 4; ++m) acc[ai][bj][m][n] += bv; }
        bool bad = st1.run(acc, u, wr, wc, fr, fq, lds, wid, lane) || poison != 0u;
        const float qnan = __builtin_nanf("");
#pragma unroll
        for (int ai = 0; ai < 2; ++ai)
#pragma unroll
            for (int m = 0; m < 4; ++m) { const int r = ai * HALF + wr * 64 + m * 16 + fr; const f32x2v sr = S[r]; const size_t off = (size_t)(u.pm * BM + r) * ldc + col0;
#pragma unroll
                for (int bj = 0; bj < 2; ++bj)
#pragma unroll
                    for (int n = 0; n < 2; ++n) { const f32x4 bs = *(const f32x4*)(base + off + bj * HALF + n * 16); acc[ai][bj][m][n] = bs + (acc[ai][bj][m][n] - sr.x) * sr.y; }
                asm volatile("" : "+v"(acc[ai][0][m][0]), "+v"(acc[ai][0][m][1]), "+v"(acc[ai][1][m][0]), "+v"(acc[ai][1][m][1]));
                if (m & 1) asm volatile("" ::: "memory"); }
        const bool bad1 = bad;
        bad = st2.run(acc, u, wr, wc, fr, fq, lds, wid, lane) || bad;
#pragma unroll
        for (int ai = 0; ai < 2; ++ai)
#pragma unroll
            for (int m = 0; m < 4; ++m) { const int r = ai * HALF + wr * 64 + m * 16 + fr; const f32x2v sr = S[r]; const size_t off = (size_t)(u.pm * BM + r) * ldc + col0;
#pragma unroll
                for (int bj = 0; bj < 2; ++bj)
#pragma unroll
                    for (int n = 0; n < 2; ++n) { const f32x4 x1 = acc[ai][bj][m][n]; *(f32x4*)(out + off + bj * HALF + n * 16) = bad1 ? (f32x4){qnan, qnan, qnan, qnan} : x1;
                        const f32x4 o = (x1 - sr.x) * sr.y; u32x2v w; w.x = cvt_pk_bf16(o[0], o[1]); w.y = cvt_pk_bf16(o[2], o[3]);
                        if (bad) { w.x = 0x7fc07fc0u; w.y = 0x7fc07fc0u; } *(u32x2v*)(xn + off + bj * HALF + n * 16) = w; }
                asm volatile("" ::: "memory"); }
    }
};

template <class Epi, class Sched, bool ALIGN_EPI = false, bool SP2 = false>
__device__ __forceinline__ void gemm_phase(PG8_LAS unsigned char* lds, const Gemm g, const Sched& S, const Epi& E) {
    const int tid = threadIdx.x, wid = __builtin_amdgcn_readfirstlane(tid >> 6), lane = tid & 63, wr = wid >> 2, wc = wid & 3, fr = lane & 15, fq = lane >> 4;
    const int K = g.K, nt = K / BK;
    unsigned voffA[2], voffB[2];
#pragma unroll
    for (int i = 0; i < 2; ++i) { int R, C; stage_rc(tid * 16 + i * 8192, R, C); const int Rb = Epi::PERM ? ((R & ~31) + perm32(R & 31)) : R;
        voffA[i] = (unsigned)(R * K + C) * 2u; voffB[i] = (unsigned)(Rb * K + C) * 2u; }
    const size_t kstep = (size_t)(BK * 2);
    const size_t hstep = (size_t)HALF * K * 2;
    const size_t tstep = 2 * hstep;
    const unsigned ldsw = (unsigned)wid * 1024u;
    const int aoff = lds_byte(wr * 64 + fr, fq * 8), boff = lds_byte(wc * 32 + fr, fq * 8);
#define PG8_SA(b, h) (((b) * 2 + (h)) * HTB)
#define PG8_SB(b, h) ((4 + (b) * 2 + (h)) * HTB)
#define PG8_STAGE(bufoff, gbase, voff) do { _Pragma("unroll") for (int _i = 0; _i < 2; ++_i) \
        __builtin_amdgcn_global_load_lds((const unsigned*)((const char*)(gbase) + (voff)[_i]), (PG8_LAS unsigned*)(lds + (bufoff) + ldsw + _i * 8192), 16, 0, 0); } while (0)
#define PG8_LDA(dst, b, h) do { _Pragma("unroll") for (int m = 0; m < 4; ++m) _Pragma("unroll") for (int k = 0; k < 2; ++k) dst[m][k] = *(const PG8_LAS bf16x8*)(lds + PG8_SA(b, h) + aoff + m * 2048 + k * 1024); } while (0)
#define PG8_LDB(dst, b, h) do { _Pragma("unroll") for (int n = 0; n < 2; ++n) _Pragma("unroll") for (int k = 0; k < 2; ++k) dst[n][k] = *(const PG8_LAS bf16x8*)(lds + PG8_SB(b, h) + boff + n * 2048 + k * 1024); } while (0)
#define PG8_MMA(ai, bj, At, Bt) do { __builtin_amdgcn_s_setprio(1); _Pragma("unroll") for (int m = 0; m < 4; ++m) _Pragma("unroll") for (int n = 0; n < 2; ++n) _Pragma("unroll") for (int k = 0; k < 2; ++k) \
        acc[ai][bj][m][n] = __builtin_amdgcn_mfma_f32_16x16x32_bf16(Bt[n][k], At[m][k], acc[ai][bj][m][n], 0, 0, 0); __builtin_amdgcn_s_setprio(0); } while (0)
#define PG8_WAIT_V(n) asm volatile("s_waitcnt vmcnt(" #n ")" ::: "memory")
#define PG8_WAIT_L(n) asm volatile("s_waitcnt lgkmcnt(" #n ")" ::: "memory")
#define PG8_BAR __builtin_amdgcn_s_barrier()
#define PG8_SCHED __builtin_amdgcn_sched_barrier(0)
    Unit cur, nxt; int ui = 0;
    if (!S.next(0, cur)) return;
    f32x4 acc[2][2][4][2];
#pragma unroll
    for (int a = 0; a < 2; ++a)
#pragma unroll
        for (int b = 0; b < 2; ++b)
#pragma unroll
            for (int m = 0; m < 4; ++m)
#pragma unroll
                for (int n = 0; n < 2; ++n) acc[a][b][m][n] = (f32x4){0.f, 0.f, 0.f, 0.f};
    bf16x8 At[4][2], B0[2][2], B1[2][2];
    const char* cA = (const char*)g.A + (size_t)cur.pm * tstep; const char* cB = (const char*)g.Bt + (size_t)cur.pn * tstep;
    S.a_ready(cur);
    if constexpr (SP2) {
        PG8_STAGE(PG8_SB(0, 0), cB, voffB); PG8_STAGE(PG8_SB(0, 1), cB + hstep, voffB); PG8_STAGE(PG8_SA(0, 0), cA, voffA); PG8_STAGE(PG8_SA(0, 1), cA + hstep, voffA);
        if (wr == 1) PG8_BAR;
        PG8_WAIT_V(2); PG8_BAR;
        PG8_STAGE(PG8_SB(1, 0), cB + kstep, voffB); PG8_STAGE(PG8_SA(1, 0), cA + kstep, voffA); PG8_STAGE(PG8_SB(1, 1), cB + hstep + kstep, voffB);
        PG8_WAIT_V(6); PG8_BAR;
    } else {
        PG8_STAGE(PG8_SB(0, 0), cB, voffB); PG8_STAGE(PG8_SA(0, 0), cA, voffA); PG8_STAGE(PG8_SB(0, 1), cB + hstep, voffB); PG8_STAGE(PG8_SA(0, 1), cA + hstep, voffA);
        if (wr == 1) PG8_BAR;
        PG8_WAIT_V(4); PG8_BAR;
        PG8_STAGE(PG8_SB(1, 0), cB + kstep, voffB); PG8_STAGE(PG8_SA(1, 0), cA + kstep, voffA); PG8_STAGE(PG8_SB(1, 1), cB + hstep + kstep, voffB);
        PG8_WAIT_V(6); PG8_BAR;
    }
    for (;;) {
        const bool has_next = S.next(ui + 1, nxt);
        const char* nA = has_next ? (const char*)g.A + (size_t)nxt.pm * tstep : cA; const char* nB = has_next ? (const char*)g.Bt + (size_t)nxt.pn * tstep : cB;
        for (int t = 0; t < nt; t += 2) {
            const bool last = (t == nt - 2);
            const char* a1 = cA + (size_t)(t + 1) * kstep;
            const char* a2 = last ? nA : cA + (size_t)(t + 2) * kstep; const char* b2 = last ? nB : cB + (size_t)(t + 2) * kstep;
            const char* a3 = a2 + kstep; const char* b3 = b2 + kstep;
            if (last && has_next) S.a_ready(nxt);
            if constexpr (SP2) {
            PG8_LDB(B0, 0, 0); PG8_LDB(B1, 0, 1); PG8_SCHED; PG8_LDA(At, 0, 0); PG8_STAGE(PG8_SA(1, 1), a1 + hstep, voffA);
            PG8_WAIT_V(8); PG8_WAIT_L(0); PG8_BAR; PG8_MMA(0, 0, At, B0); PG8_MMA(0, 1, At, B1); PG8_BAR; PG8_SCHED;
            PG8_LDA(At, 0, 1); PG8_STAGE(PG8_SB(0, 0), b2, voffB); PG8_STAGE(PG8_SB(0, 1), b2 + hstep, voffB); PG8_STAGE(PG8_SA(0, 0), a2, voffA);
            PG8_WAIT_V(8); PG8_WAIT_L(0); PG8_BAR; PG8_MMA(1, 0, At, B0); PG8_MMA(1, 1, At, B1); PG8_BAR; PG8_SCHED;
            PG8_LDB(B0, 1, 0); PG8_LDB(B1, 1, 1); PG8_SCHED; PG8_LDA(At, 1, 0); PG8_STAGE(PG8_SA(0, 1), a2 + hstep, voffA);
            PG8_WAIT_V(8); PG8_WAIT_L(0); PG8_BAR; PG8_MMA(0, 0, At, B0); PG8_MMA(0, 1, At, B1); PG8_BAR; PG8_SCHED;
            PG8_LDA(At, 1, 1); PG8_STAGE(PG8_SB(1, 0), b3, voffB); PG8_STAGE(PG8_SB(1, 1), b3 + hstep, voffB); PG8_STAGE(PG8_SA(1, 0), a3, voffA);
            PG8_WAIT_V(8); PG8_WAIT_L(0); PG8_BAR; PG8_MMA(1, 0, At, B0); PG8_MMA(1, 1, At, B1); PG8_BAR; PG8_SCHED;
            } else {
            PG8_LDB(B0, 0, 0); PG8_SCHED; PG8_LDA(At, 0, 0); PG8_STAGE(PG8_SA(1, 1), a1 + hstep, voffA);
            PG8_WAIT_L(8); PG8_BAR; PG8_WAIT_L(0); PG8_MMA(0, 0, At, B0); PG8_BAR; PG8_SCHED;
            PG8_LDB(B1, 0, 1); PG8_STAGE(PG8_SB(0, 0), b2, voffB);
            PG8_BAR; PG8_WAIT_L(0); PG8_MMA(0, 1, At, B1); PG8_BAR;
            PG8_LDA(At, 0, 1); PG8_STAGE(PG8_SA(0, 0), a2, voffA);
            PG8_BAR; PG8_WAIT_L(0); PG8_MMA(1, 0, At, B0); PG8_BAR; PG8_SCHED;
            PG8_STAGE(PG8_SB(0, 1), b2 + hstep, voffB);
            PG8_WAIT_V(6); PG8_BAR; PG8_MMA(1, 1, At, B1); PG8_BAR;
            PG8_LDB(B0, 1, 0); PG8_SCHED; PG8_LDA(At, 1, 0); PG8_STAGE(PG8_SA(0, 1), a2 + hstep, voffA);
            PG8_WAIT_L(8); PG8_BAR; PG8_WAIT_L(0); PG8_MMA(0, 0, At, B0); PG8_BAR; PG8_SCHED;
            PG8_LDB(B1, 1, 1); PG8_STAGE(PG8_SB(1, 0), b3, voffB);
            PG8_BAR; PG8_WAIT_L(0); PG8_MMA(0, 1, At, B1); PG8_BAR;
            PG8_LDA(At, 1, 1); PG8_STAGE(PG8_SA(1, 0), a3, voffA);
            PG8_BAR; PG8_WAIT_L(0); PG8_MMA(1, 0, At, B0); PG8_BAR; PG8_SCHED;
            PG8_STAGE(PG8_SB(1, 1), b3 + hstep, voffB);
            PG8_WAIT_V(6); PG8_BAR; PG8_MMA(1, 1, At, B1); PG8_BAR;
            }
        }
        if constexpr (ALIGN_EPI) { if (wr == 0) PG8_BAR; }
        if constexpr (!Epi::AFTER_DRAIN) { E(acc, cur, wr, wc, fr, fq); S.done(cur); }
        if (!has_next) break;
#pragma unroll
        for (int a = 0; a < 2; ++a)
#pragma unroll
            for (int b = 0; b < 2; ++b)
#pragma unroll
                for (int m = 0; m < 4; ++m)
#pragma unroll
                    for (int n = 0; n < 2; ++n) acc[a][b][m][n] = (f32x4){0.f, 0.f, 0.f, 0.f};
        cur = nxt; cA = nA; cB = nB; ++ui;
        if constexpr (ALIGN_EPI) { if (wr == 1) PG8_BAR; }
    }
    PG8_WAIT_V(0);
    if constexpr (!ALIGN_EPI) { if (wr == 0) PG8_BAR; }
    PG8_BAR;
    if constexpr (Epi::AFTER_DRAIN) { E.fused(acc, cur, wr, wc, fr, fq, lds, wid, lane); S.done(cur); }
#undef PG8_SA
#undef PG8_SB
#undef PG8_STAGE
#undef PG8_LDA
#undef PG8_LDB
#undef PG8_MMA
#undef PG8_WAIT_V
#undef PG8_WAIT_L
#undef PG8_BAR
#undef PG8_SCHED
}
}
#ifndef PG8_SP2
#define PG8_SP2 true
#endif
#ifndef PG8_ALIGN
#define PG8_ALIGN true
#endif
#include <cmath>
constexpr int NWAVES = 8;
#ifndef MK_N_LAUNCHES
#define MK_N_LAUNCHES 1
#endif
constexpr int PER_PHASE = 12;
constexpr int N_LAUNCHES = MK_N_LAUNCHES;

constexpr int BATCH = 8, SEQ = 2048, DM = 2048, TOK = BATCH * SEQ, MEMLEN = 256;
constexpr int NPROJ = 6144, NPROJ_PAD = 6400, WIN_COLS = 6160;
constexpr int C_QM = 0, C_KM = 1024, C_VM = 2048, C_QG = 3072, C_KG = 3584, C_VG = 4096, C_RG = 5120;
constexpr float DN_ALPHA = 1.189207115002721f;
constexpr float LN_EPS = 1e-5f, RMS_EPS = 1e-6f;

constexpr size_t MiB = 1u << 20;
constexpr size_t WS_CTL = 0, CTL_ZERO_BYTES = 1 * MiB;
constexpr size_t WS_SUBK = 1 * MiB, WS_KMEAN = 1 * MiB + 512 * 1024;
constexpr size_t WS_WOUT = 2 * MiB, WS_WQ = 10 * MiB, WS_WO = 18 * MiB, WS_WPQ = 26 * MiB;
constexpr size_t WS_KV = 34 * MiB, WS_GATE = 50 * MiB;
constexpr size_t WS_PROJ = 52 * MiB, WS_HB = 52 * MiB, WS_Q = 116 * MiB, WS_XO = 180 * MiB, WS_PU = 180 * MiB;
constexpr size_t WS_ATT = 244 * MiB, WS_PV = 244 * MiB;
constexpr size_t WS_Z = 308 * MiB, WS_XB = 308 * MiB, WS_WIN = 372 * MiB, WS_WKV = 397 * MiB, WS_MEMB = 413 * MiB;
constexpr size_t WS_END = 436 * MiB;
constexpr int CW_BAR = 4096, CW_CHK = 8192, CW_Q = 8256;
#ifndef CHECK_GLA
#define CHECK_GLA 0
#endif
#ifndef CHECK_MOBA
#define CHECK_MOBA 0
#endif
#ifndef CHECK_XATT
#define CHECK_XATT 0
#endif
#ifndef PROBE_PEER2
#define PROBE_PEER2 0
#endif
#ifndef PROBE_MIX2
#define PROBE_MIX2 0
#endif
#define CHECK_ANY (CHECK_GLA || CHECK_MOBA || CHECK_XATT)

constexpr int RING_OFF = 0, RING_BYTES = 131072;
constexpr int LDSCTL_OFF = RING_BYTES, MISC_OFF = LDSCTL_OFF + 320;
constexpr int LDS_BYTES = 147456;
#define GAS __attribute__((address_space(1)))
#define LAS __attribute__((address_space(3)))
typedef unsigned short bf16;
typedef unsigned v4u __attribute__((ext_vector_type(4)));
typedef float f32x4 __attribute__((ext_vector_type(4)));
typedef short bf16x8 __attribute__((ext_vector_type(8)));
typedef GAS unsigned gu32;
typedef GAS unsigned long long gu64;
#define RLX_AGENT __ATOMIC_RELAXED, __HIP_MEMORY_SCOPE_AGENT
#define LDS_WAIT() asm volatile("s_waitcnt lgkmcnt(0)" ::: "memory")
#define VM_WAIT() asm volatile("s_waitcnt vmcnt(0)" ::: "memory")
__device__ __forceinline__ unsigned long long rt() { return __builtin_amdgcn_s_memrealtime(); }
__device__ __forceinline__ unsigned f2bf(float f) { unsigned u = __builtin_bit_cast(unsigned, f); return (u + 0x7fffu + ((u >> 16) & 1u)) >> 16; }
__device__ __forceinline__ unsigned pk2(float lo, float hi) { return f2bf(lo) | (f2bf(hi) << 16); }

#define XB_TMO      128
#define XB_XCNT(j)  (256  + 64 * (j))
#define XB_XSUB(j)  (1280 + 64 * (j))
#define XB_XGEN(j)  (2304 + 64 * (j))
#define XB_TOP      3328
#define XB_TOPGEN   3392
#define XCD_BAR_WORDS 3456
#define XB_SPIN_CAP (1u << 18)

__device__ __forceinline__ unsigned xb_ld(unsigned* p)              { return __hip_atomic_load(p, __ATOMIC_RELAXED, __HIP_MEMORY_SCOPE_AGENT); }
__device__ __forceinline__ unsigned xb_add(unsigned* p, unsigned v) { return __hip_atomic_fetch_add(p, v, __ATOMIC_RELAXED, __HIP_MEMORY_SCOPE_AGENT); }
__device__ __forceinline__ unsigned xb_xcc_id() { return (unsigned)__builtin_amdgcn_s_getreg((3 << 11) | 20) & 0xFu; }
#define XB_SPIN(cond, bar) do { unsigned _sp = 0; while (cond) { __builtin_amdgcn_s_sleep(1); \
    if ((++_sp & 255u) == 0u) { if (xb_ld(&(bar)[XB_TMO])) break; if (_sp > XB_SPIN_CAP) { atomicAdd(&(bar)[XB_TMO], 1u); break; } } } } while (0)

struct XcdBarrier {
    unsigned* bar; unsigned x;
    volatile LAS unsigned* st;
};

__device__ __forceinline__ XcdBarrier xcd_barrier_post(unsigned* bar, volatile LAS unsigned* st) {
    XcdBarrier b; b.bar = bar; b.x = xb_xcc_id(); b.st = st;
    if (threadIdx.x == 0) (void)xb_add(&bar[XB_XCNT(b.x)], 1u);
    return b;
}
__device__ __forceinline__ void xcd_barrier_complete(unsigned* bar, unsigned x, unsigned& nloc, unsigned& nx) {
    const unsigned G = gridDim.x * gridDim.y * gridDim.z;
    unsigned sum, cnt, mine, sp = 0u;
    for (;;) {
        sum = 0u; cnt = 0u; mine = 0u;
#pragma unroll
        for (unsigned j = 0; j < 16; ++j) { const unsigned c = xb_ld(&bar[XB_XCNT(j)]); sum += c; cnt += (c > 0u) ? 1u : 0u; mine = (j == x) ? c : mine; }
        if (sum == G) break;
        __builtin_amdgcn_s_sleep(1);
        if ((++sp & 255u) == 0u) { if (xb_ld(&bar[XB_TMO])) break; if (sp > XB_SPIN_CAP) { atomicAdd(&bar[XB_TMO], 1u); break; } }
    }
    nloc = mine > 0u ? mine : 1u; nx = cnt > 0u ? cnt : 1u;
}

__device__ __forceinline__ void xcd_barrier(const XcdBarrier& b) {
    asm volatile("s_waitcnt vmcnt(0)" ::: "memory");
    __syncthreads();
    if (threadIdx.x == 0) {
        unsigned* bar = b.bar;
        __builtin_amdgcn_s_waitcnt(0);
        unsigned nloc = b.st[0], nx = b.st[1];
        if (nloc == 0u) { xcd_barrier_complete(bar, b.x, nloc, nx); b.st[0] = nloc; b.st[1] = nx; }
        const unsigned old = xb_add(&bar[XB_XSUB(b.x)], 1u);
        const unsigned gen = old / nloc;
        if (old + 1u == (gen + 1u) * nloc) {
            __builtin_amdgcn_fence(__ATOMIC_RELEASE, "agent");
            asm volatile("s_waitcnt vmcnt(0)" ::: "memory");
            const unsigned og = xb_add(&bar[XB_TOP], 1u);
            const unsigned tg = og / nx;
            if (og + 1u == (tg + 1u) * nx) xb_add(&bar[XB_TOPGEN], 1u);
            else XB_SPIN(xb_ld(&bar[XB_TOPGEN]) == tg, bar);
            __builtin_amdgcn_fence(__ATOMIC_ACQUIRE, "agent");
            xb_add(&bar[XB_XGEN(b.x)], 1u);
            asm volatile("s_waitcnt vmcnt(0)" ::: "memory");
        } else {
            XB_SPIN(xb_ld(&bar[XB_XGEN(b.x)]) == gen, bar);
            __builtin_amdgcn_fence(__ATOMIC_ACQUIRE, "agent");
            asm volatile("s_waitcnt vmcnt(0)" ::: "memory");
        }
    }
    __syncthreads();
}
struct Frame {
    LAS unsigned char* lds;
    volatile LAS unsigned* MISC;
    gu32* ctl;
    int tid, lane, wave;
    int vcu, G;
    const float* in[20]; float* out; unsigned char* ws;
};
__device__ __forceinline__ float bf2f(unsigned short h) { return __uint_as_float(((unsigned)h) << 16); }
__device__ __forceinline__ float wave_sum(float v) {
#pragma unroll
    for (int o = 1; o < 64; o <<= 1) v += __shfl_xor(v, o);
    return v;
}
__device__ __forceinline__ float wave_max(float v) {
#pragma unroll
    for (int o = 1; o < 64; o <<= 1) v = fmaxf(v, __shfl_xor(v, o));
    return v;
}
typedef unsigned short us8 __attribute__((ext_vector_type(8)));

__device__ __forceinline__ void p0_transpose_item(const float* W, int K, int N, int Npad, bf16* WT, LAS float* scr, int item, int lane) {
    const int nblk = Npad / 32, kb = item / nblk, nb = item % nblk, k0 = 64 * kb, n0 = 32 * nb;
    const int nn = n0 + (lane & 31); const bool ok = nn < N;
#pragma unroll 8
    for (int i = 0; i < 32; ++i) { const int kk = 2 * i + (lane >> 5); scr[kk * 33 + (lane & 31)] = ok ? W[(size_t)(k0 + kk) * N + nn] : 0.f; }
    LDS_WAIT(); asm volatile("" ::: "memory");
    const int c = lane & 7;
#pragma unroll
    for (int j = 0; j < 4; ++j) { const int n = (lane >> 3) + 8 * j; const LAS float* s = scr + (8 * c) * 33 + n;
        v4u o; o.x = pk2(s[0 * 33], s[1 * 33]); o.y = pk2(s[2 * 33], s[3 * 33]); o.z = pk2(s[4 * 33], s[5 * 33]); o.w = pk2(s[6 * 33], s[7 * 33]);
        *(GAS v4u*)(WT + (size_t)(n0 + n) * K + k0 + 8 * c) = o; }
    LDS_WAIT(); asm volatile("" ::: "memory");
}
__device__ __forceinline__ void cvt_linear(Frame& F, const float* src, bf16* dst, size_t n8) {
    const size_t nth = (size_t)F.G * NWAVES * 64;
    for (size_t i = (size_t)F.vcu * NWAVES * 64 + F.tid; i < n8; i += nth) {
        const f32x4 a = *(const GAS f32x4*)(src + i * 8), b = *(const GAS f32x4*)(src + i * 8 + 4);
        v4u o; o.x = pk2(a.x, a.y); o.y = pk2(a.z, a.w); o.z = pk2(b.x, b.y); o.w = pk2(b.z, b.w);
        *(GAS v4u*)(dst + i * 8) = o;
    }
}
__device__ __forceinline__ void p0_prologue(Frame& F) {
    LAS float* scr = (LAS float*)(F.lds + RING_OFF + F.wave * 16384);
    const int gw = F.vcu * NWAVES + F.wave, NGW = F.G * NWAVES;
    constexpr int I_IN = (DM / 64) * (NPROJ_PAD / 32), I_SQ = (DM / 64) * (DM / 32), I_KV = (DM / 64) * (2 * DM / 32);
    constexpr int NITEMS = I_IN + 4 * I_SQ + I_KV;
    unsigned char* ws = F.ws;
    for (int it = gw; it < NITEMS; it += NGW) {
        int r = it;
        if (r < I_IN) { p0_transpose_item(F.in[2], DM, WIN_COLS, NPROJ_PAD, (bf16*)(ws + WS_WIN), scr, r, F.lane); continue; } r -= I_IN;
        if (r < I_KV) { p0_transpose_item(F.in[10], DM, 2 * DM, 2 * DM, (bf16*)(ws + WS_WKV), scr, r, F.lane); continue; } r -= I_KV;
        if (r < I_SQ) { p0_transpose_item(F.in[6], DM, DM, DM, (bf16*)(ws + WS_WOUT), scr, r, F.lane); continue; } r -= I_SQ;
        if (r < I_SQ) { p0_transpose_item(F.in[9], DM, DM, DM, (bf16*)(ws + WS_WQ), scr, r, F.lane); continue; } r -= I_SQ;
        if (r < I_SQ) { p0_transpose_item(F.in[11], DM, DM, DM, (bf16*)(ws + WS_WO), scr, r, F.lane); continue; } r -= I_SQ;
        p0_transpose_item(F.in[14], DM, DM, DM, (bf16*)(ws + WS_WPQ), scr, r, F.lane);
    }
    cvt_linear(F, F.in[0], (bf16*)(ws + WS_XB), (size_t)TOK * DM / 8);
    cvt_linear(F, F.in[1], (bf16*)(ws + WS_MEMB), (size_t)BATCH * MEMLEN * DM / 8);
    cvt_linear(F, F.in[15], (bf16*)(ws + WS_SUBK), (size_t)16 * 128 * 128 / 8);
}

struct EpiProj {
    static constexpr bool PERM = true, AFTER_DRAIN = false;
    pg8::bf16_t* O; float* gate;
    __device__ __forceinline__ void operator()(const pg8::f32x4 (&acc)[2][2][4][2], const pg8::Unit& u, int wr, int wc, int fr, int fq) const {
        const int row0 = u.pm * 256 + wr * 64 + fr;
        if (u.pn < 24) {
            const int col0 = u.pn * 256 + wc * 32 + 8 * fq;
#pragma unroll
            for (int ai = 0; ai < 2; ++ai)
#pragma unroll
                for (int m = 0; m < 4; ++m) { pg8::bf16_t* rowp = O + (size_t)(row0 + ai * 128 + m * 16) * NPROJ + col0;
#pragma unroll
                    for (int bj = 0; bj < 2; ++bj) { const pg8::f32x4 v0 = acc[ai][bj][m][0], v1 = acc[ai][bj][m][1];
                        pg8::u32x4 w; w.x = pg8::cvt_pk_bf16(v0[0], v0[1]); w.y = pg8::cvt_pk_bf16(v0[2], v0[3]); w.z = pg8::cvt_pk_bf16(v1[0], v1[1]); w.w = pg8::cvt_pk_bf16(v1[2], v1[3]);
                        *(pg8::u32x4*)(rowp + bj * 128) = w; } }
        } else if (wc == 0 && fq < 2) {
#pragma unroll
            for (int ai = 0; ai < 2; ++ai)
#pragma unroll
                for (int m = 0; m < 4; ++m) { float* gp = gate + (size_t)(row0 + ai * 128 + m * 16) * 16 + 8 * fq;
                    *(pg8::f32x4*)(gp) = acc[ai][0][m][0]; *(pg8::f32x4*)(gp + 4) = acc[ai][0][m][1]; }
        }
    }
};
struct EpiRes {
    static constexpr bool PERM = false, AFTER_DRAIN = false;
    const float* base; float* out; float alpha;
    __device__ __forceinline__ void operator()(const pg8::f32x4 (&acc)[2][2][4][2], const pg8::Unit& u, int wr, int wc, int fr, int fq) const {
        const int row0 = u.pm * 256 + wr * 64 + fr, col0 = u.pn * 256 + wc * 32 + 4 * fq;
#pragma unroll
        for (int ai = 0; ai < 2; ++ai)
#pragma unroll
            for (int m = 0; m < 4; ++m) { const size_t off = (size_t)(row0 + ai * 128 + m * 16) * DM + col0;
#pragma unroll
                for (int bj = 0; bj < 2; ++bj)
#pragma unroll
                    for (int n = 0; n < 2; ++n) { const pg8::f32x4 b = *(const pg8::f32x4*)(base + off + bj * 128 + n * 16);
                        *(pg8::f32x4*)(out + off + bj * 128 + n * 16) = b * alpha + acc[ai][bj][m][n]; } }
    }
};

__device__ __forceinline__ void kmean_phase(Frame& F) {
    const bf16* PROJ = (const bf16*)(F.ws + WS_PROJ); float* KMEAN = (float*)(F.ws + WS_KMEAN);
    const int gw = F.vcu * NWAVES + F.wave, NGW = F.G * NWAVES;
    for (int it = gw; it < BATCH * 8 * 16; it += NGW) {
        const int b = it >> 7, blk = (it >> 4) & 7, cc = it & 15;
        const bf16* p = PROJ + (size_t)(b * SEQ + blk * 256) * NPROJ + C_KM + cc * 64 + F.lane;
        float s = 0.f;
#pragma unroll 8
        for (int r = 0; r < 256; ++r) s += bf2f(p[(size_t)r * NPROJ]);
        KMEAN[(size_t)(b * 8 + blk) * 1024 + cc * 64 + F.lane] = s * (1.f / 256.f);
    }
}

template <int HD, int KC, int MODE>
__device__ __forceinline__ void naive_attn_unit(Frame& F, int unit) {
    constexpr int DPT = HD / 8, PIECES = KC * HD / 8;
    LAS bf16* Kc = (LAS bf16*)(F.lds + RING_OFF); LAS bf16* Vc = Kc + KC * HD;
    const int tid = F.tid, qi = tid >> 3, sub = tid & 7;
    int b, h, qt; const bf16 *Qp, *Kp, *Vp; bf16* Op; int ldq, ldk, ldo, nchunks, qb = 0, qpos = 0; float scale;
    if (MODE == 0) {
        b = unit >> 8; h = (unit >> 5) & 7; qt = unit & 31; qb = qt >> 2; qpos = qt * 64 + qi;
        const bf16* PROJ = (const bf16*)(F.ws + WS_PROJ);
        Qp = PROJ + (size_t)(b * SEQ + qt * 64 + qi) * NPROJ + C_QM + h * 128; ldq = NPROJ;
        Kp = PROJ + (size_t)(b * SEQ) * NPROJ + C_KM + h * 128; Vp = PROJ + (size_t)(b * SEQ) * NPROJ + C_VM + h * 128; ldk = NPROJ;
        Op = (bf16*)(F.ws + WS_ATT) + (size_t)(b * SEQ + qt * 64 + qi) * DM + h * 128; ldo = DM;
        nchunks = 4 * (qb + 1); scale = 0.08838834764831845f;
    } else {
        b = unit >> 7; h = (unit >> 5) & 3; qt = unit & 31;
        Qp = (const bf16*)(F.ws + WS_Q) + (size_t)(b * SEQ + qt * 64 + qi) * DM + h * 512; ldq = DM;
        const bf16* KV = (const bf16*)(F.ws + WS_KV);
        Kp = KV + (size_t)(b * MEMLEN) * (2 * DM) + h * 512; Vp = Kp + DM; ldk = 2 * DM;
        Op = (bf16*)(F.ws + WS_XO) + (size_t)(b * SEQ + qt * 64 + qi) * DM + h * 512; ldo = DM;
        nchunks = MEMLEN / KC; scale = 0.04419417382415922f;
    }
    (void)ldq; (void)ldo;
    float qv[DPT], o[DPT];
#pragma unroll
    for (int j = 0; j < DPT; j += 8) { const us8 w = *(const GAS us8*)(Qp + sub * DPT + j);
#pragma unroll
        for (int e = 0; e < 8; ++e) { qv[j + e] = bf2f(w[e]) * scale; o[j + e] = 0.f; } }
    unsigned sel = 0;
    if (MODE == 0) {
        const float* KM = (const float*)(F.ws + WS_KMEAN) + (size_t)(b * 8) * 1024 + h * 128 + sub * DPT;
        float g[8];
#pragma unroll
        for (int n = 0; n < 8; ++n) { float s = 0.f;
            if (n < qb) {
#pragma unroll
                for (int j = 0; j < DPT; ++j) s += qv[j] * KM[(size_t)n * 1024 + j]; }
            s += __shfl_xor(s, 1); s += __shfl_xor(s, 2); s += __shfl_xor(s, 4); g[n] = s; }
#pragma unroll
        for (int n = 0; n < 8; ++n) { int cnt = 0;
#pragma unroll
            for (int m = 0; m < 8; ++m) if (m != n && m < qb && (g[m] > g[n] || (g[m] == g[n] && m < n))) ++cnt;
            if (n < qb && cnt < 3) sel |= 1u << n; }
    }
    float mrun = -1e30f, lrun = 0.f;
    for (int c = 0; c < nchunks; ++c) {
        int key0; if (MODE == 0) key0 = (c < 4) ? qb * 256 + 64 * c : (c - 4) * 64; else key0 = c * KC;
        __syncthreads();
#pragma unroll
        for (int p = tid; p < PIECES; p += NWAVES * 64) { const int row = p / (HD / 8), c8 = p % (HD / 8);
            *(LAS v4u*)(Kc + row * HD + c8 * 8) = *(const GAS v4u*)(Kp + (size_t)(key0 + row) * ldk + c8 * 8);
            *(LAS v4u*)(Vc + row * HD + c8 * 8) = *(const GAS v4u*)(Vp + (size_t)(key0 + row) * ldk + c8 * 8); }
        __syncthreads();
        const bool blk_ok = (MODE == 1) || (c < 4) || ((sel >> ((c - 4) >> 2)) & 1u);
        for (int kk = 0; kk < KC; ++kk) {
            const LAS bf16* kr = Kc + kk * HD + sub * DPT; float part = 0.f;
#pragma unroll
            for (int j = 0; j < DPT; j += 8) { const us8 w = *(const LAS us8*)(kr + j);
#pragma unroll
                for (int e = 0; e < 8; ++e) part += qv[j + e] * bf2f(w[e]); }
            part += __shfl_xor(part, 1); part += __shfl_xor(part, 2); part += __shfl_xor(part, 4);
            bool ok = blk_ok; if (MODE == 0 && c < 4) ok = (key0 + kk) <= qpos;
            if (ok) {
                const float mn = fmaxf(mrun, part), al = __expf(mrun - mn), pp = __expf(part - mn);
                lrun = lrun * al + pp; mrun = mn;
                const LAS bf16* vr = Vc + kk * HD + sub * DPT;
#pragma unroll
                for (int j = 0; j < DPT; j += 8) { const us8 w = *(const LAS us8*)(vr + j);
#pragma unroll
                    for (int e = 0; e < 8; ++e) o[j + e] = o[j + e] * al + pp * bf2f(w[e]); }
            }
        }
    }
    const float inv = 1.f / lrun;
#pragma unroll
    for (int j = 0; j < DPT; j += 8) { v4u w; w.x = pk2(o[j] * inv, o[j + 1] * inv); w.y = pk2(o[j + 2] * inv, o[j + 3] * inv); w.z = pk2(o[j + 4] * inv, o[j + 5] * inv); w.w = pk2(o[j + 6] * inv, o[j + 7] * inv);
        *(GAS v4u*)(Op + sub * DPT + j) = w; }
}

__device__ __forceinline__ void naive_gla_unit(Frame& F, int unit) {
    const int b = unit >> 2, h = unit & 3, tid = F.tid, e = tid & 255, dh = tid >> 8;
    LAS float* GU = (LAS float*)(F.lds + RING_OFF);
    LAS float* GL = GU + 16 * 128;
    LAS float* As = GL + 32 * 16;
    LAS float* Ks = As + 32 * 128; LAS float* Qs = Ks + 32 * 128;
    LAS float* Op = Qs + 32 * 128;
    const bf16* PROJ = (const bf16*)(F.ws + WS_PROJ); const float* GATE = (const float*)(F.ws + WS_GATE);
    const float* gup = F.in[3]; const float* gbias = F.in[4]; const float* gnorm = F.in[5];
    bf16* ATT = (bf16*)(F.ws + WS_ATT);
    __syncthreads();
    for (int i = tid; i < 16 * 128; i += NWAVES * 64) GU[i] = gup[(size_t)(i >> 7) * 512 + h * 128 + (i & 127)];
    float st[64];
#pragma unroll
    for (int j = 0; j < 64; ++j) st[j] = 0.f;
    for (int ch = 0; ch < SEQ / 32; ++ch) {
        const size_t row0 = (size_t)b * SEQ + ch * 32;
        __syncthreads();
        GL[tid] = GATE[row0 * 16 + tid];
        __syncthreads();
        { const int tt = tid >> 4, dg = tid & 15;
          const us8 qw = *(const GAS us8*)(PROJ + (row0 + tt) * NPROJ + C_QG + h * 128 + dg * 8);
          const us8 kw = *(const GAS us8*)(PROJ + (row0 + tt) * NPROJ + C_KG + h * 128 + dg * 8);
#pragma unroll
          for (int j = 0; j < 8; ++j) { const int d = dg * 8 + j; float z = gbias[h * 128 + d];
#pragma unroll
              for (int r = 0; r < 16; ++r) z += GL[tt * 16 + r] * GU[r * 128 + d];
              const float ls = fminf(z, 0.f) - log1pf(__expf(-fabsf(z)));
              As[tt * 128 + d] = __expf(ls * (1.f / 16.f)); Ks[tt * 128 + d] = bf2f(kw[j]); Qs[tt * 128 + d] = bf2f(qw[j]) * 0.08838834764831845f; } }
        __syncthreads();
        for (int tt = 0; tt < 32; ++tt) {
            const float v = bf2f(PROJ[(row0 + tt) * NPROJ + C_VG + h * 256 + e]); float op = 0.f;
            const LAS float* ar = As + tt * 128 + dh * 64; const LAS float* kr = Ks + tt * 128 + dh * 64; const LAS float* qr = Qs + tt * 128 + dh * 64;
#pragma unroll
            for (int j = 0; j < 64; ++j) { st[j] = ar[j] * st[j] + kr[j] * v; op += qr[j] * st[j]; }
            Op[(dh * 32 + tt) * 256 + e] = op;
        }
        __syncthreads();
#pragma unroll
        for (int ti = 0; ti < 4; ++ti) { const int tt = F.wave * 4 + ti; float val[4], ss = 0.f;
#pragma unroll
            for (int i = 0; i < 4; ++i) { const int ee = F.lane + 64 * i; val[i] = Op[tt * 256 + ee] + Op[(32 + tt) * 256 + ee]; ss += val[i] * val[i]; }
            ss = wave_sum(ss); const float rs = 1.f / sqrtf(ss * (1.f / 256.f) + RMS_EPS);
#pragma unroll
            for (int i = 0; i < 4; ++i) { const int ee = F.lane + 64 * i; const float r = bf2f(PROJ[(row0 + tt) * NPROJ + C_RG + h * 256 + ee]);
                const float y = val[i] * rs * gnorm[ee] * (r / (1.f + __expf(-r)));
                ATT[(row0 + tt) * DM + 1024 + h * 256 + ee] = (bf16)f2bf(y); } }
    }
}

__device__ __forceinline__ void ln_phase(Frame& F, const float* g, const float* bb) {
    float* Z = (float*)(F.ws + WS_Z); bf16* HB = (bf16*)(F.ws + WS_HB);
    const int gw = F.vcu * NWAVES + F.wave, NGW = F.G * NWAVES;
    for (int m = gw; m < TOK; m += NGW) {
        GAS f32x4* zr = (GAS f32x4*)(Z + (size_t)m * DM) + F.lane;
        f32x4 v[8]; float s = 0.f;
#pragma unroll
        for (int j = 0; j < 8; ++j) { v[j] = zr[64 * j]; s += (v[j].x + v[j].y) + (v[j].z + v[j].w); }
        const float mean = wave_sum(s) * (1.f / DM); float s2 = 0.f;
#pragma unroll
        for (int j = 0; j < 8; ++j) { v[j] = v[j] - mean; s2 += (v[j].x * v[j].x + v[j].y * v[j].y) + (v[j].z * v[j].z + v[j].w * v[j].w); }
        const float rstd = 1.f / sqrtf(wave_sum(s2) * (1.f / DM) + LN_EPS);
        GAS unsigned long long* o8 = (GAS unsigned long long*)(HB + (size_t)m * DM) + F.lane;
#pragma unroll
        for (int j = 0; j < 8; ++j) { const f32x4 gg = *((const GAS f32x4*)g + F.lane + 64 * j), b4 = *((const GAS f32x4*)bb + F.lane + 64 * j);
            const f32x4 y = v[j] * rstd * gg + b4; zr[64 * j] = y;
            o8[64 * j] = (unsigned long long)pk2(y.x, y.y) | ((unsigned long long)pk2(y.z, y.w) << 32); }
    }
}

typedef short s16x8 __attribute__((ext_vector_type(8)));
__device__ __forceinline__ void top16_128(float v0, float v1, int lane, float& outv, int& outi) {
    outv = -INFINITY; outi = 0;
#pragma unroll 1
    for (int r = 0; r < 16; ++r) {
        const float wm = wave_max(fmaxf(v0, v1));
        const unsigned long long b0 = __ballot(v0 == wm), b1 = __ballot(v1 == wm);
        const int idx = b0 ? (int)__builtin_ctzll(b0) : 64 + (int)__builtin_ctzll(b1);
        if (lane == idx) v0 = -INFINITY;
        if (lane + 64 == idx) v1 = -INFINITY;
        if (lane == r) { outv = wm; outi = idx; }
    }
}
__device__ __forceinline__ float gelu_erf(float x) { return 0.5f * x * (1.f + erff(x * 0.7071067811865476f)); }
__device__ __forceinline__ void peer_phase(Frame& F) {
    LAS float* sc = (LAS float*)(F.lds + RING_OFF);
    const bf16* PQ = (const bf16*)(F.ws + WS_Q); const bf16* SUBK = (const bf16*)(F.ws + WS_SUBK);
    const bf16* PU = (const bf16*)(F.ws + WS_PU); const bf16* PV = (const bf16*)(F.ws + WS_PV);
    const float* Z = (const float*)(F.ws + WS_Z); const float* g3 = F.in[18]; const float* b3 = F.in[19];
    const int lane = F.lane, wave = F.wave;
    for (int unit = F.vcu; unit < TOK / 16; unit += F.G) {
        const int t0 = unit * 16;
        __syncthreads();
#pragma unroll 1
        for (int gi = 0; gi < 2; ++gi) { const int g = 2 * wave + gi;
            s16x8 a[4];
#pragma unroll
            for (int ks = 0; ks < 4; ++ks) a[ks] = *(const GAS s16x8*)(PQ + (size_t)(t0 + (lane & 15)) * DM + g * 128 + ks * 32 + 8 * (lane >> 4));
#pragma unroll 2
            for (int nt = 0; nt < 8; ++nt) { f32x4 acc = {0.f, 0.f, 0.f, 0.f};
#pragma unroll
                for (int ks = 0; ks < 4; ++ks) { const s16x8 bfr = *(const GAS s16x8*)(SUBK + (size_t)(g * 128 + nt * 16 + (lane & 15)) * 128 + ks * 32 + 8 * (lane >> 4));
                    acc = __builtin_amdgcn_mfma_f32_16x16x32_bf16(a[ks], bfr, acc, 0, 0, 0); }
#pragma unroll
                for (int r = 0; r < 4; ++r) sc[(4 * (lane >> 4) + r) * 2048 + g * 128 + nt * 16 + (lane & 15)] = acc[r]; } }
        __syncthreads();
#pragma unroll 1
        for (int ti = 0; ti < 2; ++ti) { const int tl = 2 * wave + ti; const size_t t = (size_t)t0 + tl;
            int E0 = 0, E1 = 0; float G0 = 0.f, G1 = 0.f;
#pragma unroll 1
            for (int hh = 0; hh < 8; ++hh) {
                float sA, sB; int iA, iB;
                top16_128(sc[tl * 2048 + (2 * hh) * 128 + lane], sc[tl * 2048 + (2 * hh) * 128 + 64 + lane], lane, sA, iA);
                top16_128(sc[tl * 2048 + (2 * hh + 1) * 128 + lane], sc[tl * 2048 + (2 * hh + 1) * 128 + 64 + lane], lane, sB, iB);
                int ca, cb; const int c = lane;
                if (c < 16) { ca = 0; cb = c; } else if (c < 24) { ca = 1; cb = c - 16; } else if (c < 29) { ca = 2; cb = c - 24; } else if (c < 33) { ca = 3; cb = c - 29; }
                else if (c < 36) { ca = 4; cb = c - 33; } else if (c < 38) { ca = 5; cb = c - 36; } else if (c < 40) { ca = 6; cb = c - 38; } else if (c < 42) { ca = 7; cb = c - 40; }
                else { ca = 8 + ((c - 42) & 7); cb = 0; }
                float cv = __shfl(sA, ca) + __shfl(sB, cb); const int ce = __shfl(iA, ca) * 128 + __shfl(iB, cb);
                if (c >= 50) cv = -INFINITY;
                float bv = -INFINITY; int be = 0;
#pragma unroll 1
                for (int r = 0; r < 16; ++r) { const float wm = wave_max(cv); const unsigned long long bal = __ballot(cv == wm); const int idx = (int)__builtin_ctzll(bal);
                    const int ee = __shfl(ce, idx); if (lane == idx) cv = -INFINITY; if (lane == r) { bv = wm; be = ee; } }
                const float mx = __shfl(bv, 0); const float p = (lane < 16) ? __expf(bv - mx) : 0.f; const float gt = p / wave_sum(p);
                const int src = lane & 15; const int e_s = __shfl(be, src); const float g_s = __shfl(gt, src);
                if ((lane >> 4) == (hh & 3)) { if (hh < 4) { E0 = e_s; G0 = g_s; } else { E1 = e_s; G1 = g_s; } }
            }
            float xr[32];
#pragma unroll
            for (int i = 0; i < 4; ++i) { const f32x4 p0 = *(const GAS f32x4*)(Z + t * DM + 512 * i + 8 * lane), p1 = *(const GAS f32x4*)(Z + t * DM + 512 * i + 8 * lane + 4);
                xr[8 * i] = p0.x; xr[8 * i + 1] = p0.y; xr[8 * i + 2] = p0.z; xr[8 * i + 3] = p0.w; xr[8 * i + 4] = p1.x; xr[8 * i + 5] = p1.y; xr[8 * i + 6] = p1.z; xr[8 * i + 7] = p1.w; }
            float H0 = 0.f, H1 = 0.f;
#pragma unroll 1
            for (int half = 0; half < 2; ++half) {
#pragma unroll 4
                for (int kk = 0; kk < 64; ++kk) { const int e = __builtin_amdgcn_readlane(half ? E1 : E0, kk);
                    const bf16* ur = PU + (size_t)e * DM + 8 * lane; float d = 0.f;
#pragma unroll
                    for (int i = 0; i < 4; ++i) { const us8 w = *(const GAS us8*)(ur + 512 * i);
#pragma unroll
                        for (int j = 0; j < 8; ++j) d += xr[8 * i + j] * bf2f(w[j]); }
                    d = wave_sum(d);
                    if (lane == kk) { if (half) H1 = d; else H0 = d; } } }
            const float C0 = G0 * gelu_erf(H0), C1 = G1 * gelu_erf(H1);
            float acc[32];
#pragma unroll
            for (int j = 0; j < 32; ++j) acc[j] = 0.f;
#pragma unroll 1
            for (int half = 0; half < 2; ++half) {
#pragma unroll 4
                for (int kk = 0; kk < 64; ++kk) { const int e = __builtin_amdgcn_readlane(half ? E1 : E0, kk);
                    const float cf = __uint_as_float((unsigned)__builtin_amdgcn_readlane((int)__float_as_uint(half ? C1 : C0), kk));
                    const bf16* vr = PV + (size_t)e * DM + 8 * lane;
#pragma unroll
                    for (int i = 0; i < 4; ++i) { const us8 w = *(const GAS us8*)(vr + 512 * i);
#pragma unroll
                        for (int j = 0; j < 8; ++j) acc[8 * i + j] += cf * bf2f(w[j]); } } }
            float s = 0.f;
#pragma unroll
            for (int j = 0; j < 32; ++j) { acc[j] = DN_ALPHA * xr[j] + acc[j]; s += acc[j]; }
            const float mean = wave_sum(s) * (1.f / DM); float s2 = 0.f;
#pragma unroll
            for (int j = 0; j < 32; ++j) { acc[j] -= mean; s2 += acc[j] * acc[j]; }
            const float rstd = 1.f / sqrtf(wave_sum(s2) * (1.f / DM) + LN_EPS);
#pragma unroll
            for (int i = 0; i < 4; ++i) { const int c0 = 512 * i + 8 * lane;
                const f32x4 ga = *(const GAS f32x4*)(g3 + c0), gb = *(const GAS f32x4*)(g3 + c0 + 4), ba = *(const GAS f32x4*)(b3 + c0), bb = *(const GAS f32x4*)(b3 + c0 + 4);
                f32x4 ya, yb;
                ya.x = acc[8 * i] * rstd * ga.x + ba.x; ya.y = acc[8 * i + 1] * rstd * ga.y + ba.y; ya.z = acc[8 * i + 2] * rstd * ga.z + ba.z; ya.w = acc[8 * i + 3] * rstd * ga.w + ba.w;
                yb.x = acc[8 * i + 4] * rstd * gb.x + bb.x; yb.y = acc[8 * i + 5] * rstd * gb.y + bb.y; yb.z = acc[8 * i + 6] * rstd * gb.z + bb.z; yb.w = acc[8 * i + 7] * rstd * gb.w + bb.w;
                *(GAS f32x4*)(F.out + t * DM + c0) = ya; *(GAS f32x4*)(F.out + t * DM + c0 + 4) = yb; }
        }
    }
}
typedef float f32x16 __attribute__((ext_vector_type(16)));
typedef float f32x2_t __attribute__((ext_vector_type(2))); typedef __bf16 bf16x2_t __attribute__((ext_vector_type(2)));
__device__ __forceinline__ unsigned cvtpk_s(float lo, float hi) { f32x2_t v = {lo, hi}; bf16x2_t b = __builtin_convertvector(v, bf16x2_t); return __builtin_bit_cast(unsigned, b); }
__device__ __forceinline__ unsigned short bf1(float x) { return (unsigned short)(cvtpk_s(x, 0.f) & 0xffffu); }
__device__ __forceinline__ int crow(int r, int hi) { return (r & 3) + 8 * (r >> 2) + 4 * hi; }
#define MFMA32(a, b, c) __builtin_amdgcn_mfma_f32_32x32x16_bf16((a), (b), (c), 0, 0, 0)
template <int S> __device__ __forceinline__ bf16x8 pack8(const f32x16& x) {
    v4u p; p.x = cvtpk_s(x[8 * S], x[8 * S + 1]); p.y = cvtpk_s(x[8 * S + 2], x[8 * S + 3]); p.z = cvtpk_s(x[8 * S + 4], x[8 * S + 5]); p.w = cvtpk_s(x[8 * S + 6], x[8 * S + 7]);
    return __builtin_bit_cast(bf16x8, p);
}
__device__ __forceinline__ void gla_unit(Frame& F, int unit, bf16* ATTo) {
    const int b = unit >> 2, h = unit & 3, tid = F.tid, lane = F.lane, wave = F.wave, r32 = lane & 31, hi = lane >> 5;
    LAS float* GU = (LAS float*)(F.lds + RING_OFF);
    LAS float* GL = GU + 2048;
    LAS float* TOT = GL + 1024;
    LAS float* DEC = TOT + 512;
    LAS float* SS = DEC + 128;
    LAS float* RS = SS + 512;
    LAS bf16* QD = (LAS bf16*)(RS + 64);
    LAS bf16* KD = QD + 64 * 136;
    LAS bf16* KST = KD + 64 * 136;
    LAS bf16* VT = KST + 128 * 72;
    LAS bf16* AL = VT + 256 * 72;
    const bf16* PROJ = (const bf16*)(F.ws + WS_PROJ); const float* GATE = (const float*)(F.ws + WS_GATE);
    const float* gup = F.in[3]; const float* gbias = F.in[4]; const float* gnorm = F.in[5];
    const int d = tid & 127, g = tid >> 7;
    const int ev = tid & 255, jg = tid >> 8;
    float gu[16];
#pragma unroll
    for (int r = 0; r < 16; ++r) gu[r] = gup[(size_t)r * 512 + h * 128 + d];
    const float bias_d = gbias[h * 128 + d];
    const float gn = gnorm[32 * wave + r32];
    f32x16 st[4];
#pragma unroll
    for (int i = 0; i < 4; ++i)
#pragma unroll
        for (int r = 0; r < 16; ++r) st[i][r] = 0.f;
    __syncthreads();
#pragma unroll 1
    for (int ch = 0; ch < SEQ / 64; ++ch) {
        const size_t row0 = (size_t)b * SEQ + ch * 64;
        if (tid < 256) *(LAS f32x4*)(GL + tid * 4) = *(const GAS f32x4*)(GATE + row0 * 16 + tid * 4);
        __syncthreads();
        float cum[16];
        { float run = 0.f;
#pragma unroll
          for (int tt = 0; tt < 16; ++tt) { const LAS float* gl = GL + (16 * g + tt) * 16; float z = bias_d;
#pragma unroll
              for (int r = 0; r < 16; ++r) z += gl[r] * gu[r];
              const float ls = fminf(z, 0.f) - log1pf(__expf(-fabsf(z)));
              run += ls * (1.f / 16.f); cum[tt] = run; }
          TOT[g * 128 + d] = run; }
        __syncthreads();
        { float off = 0.f, total = 0.f;
#pragma unroll
          for (int gg = 0; gg < 4; ++gg) { const float t = TOT[gg * 128 + d]; total += t; if (gg < g) off += t; }
          unsigned short ks[16];
#pragma unroll
          for (int tt = 0; tt < 16; ++tt) { const int t = 16 * g + tt; const float c = off + cum[tt];
              const float q = bf2f(PROJ[(row0 + t) * NPROJ + C_QG + h * 128 + d]), k = bf2f(PROJ[(row0 + t) * NPROJ + C_KG + h * 128 + d]);
              QD[t * 136 + d] = bf1(q * 0.08838834764831845f * __expf(c)); KD[t * 136 + d] = bf1(k * __expf(-c)); ks[tt] = bf1(k * __expf(total - c)); }
          v4u w0, w1; w0.x = ks[0] | ((unsigned)ks[1] << 16); w0.y = ks[2] | ((unsigned)ks[3] << 16); w0.z = ks[4] | ((unsigned)ks[5] << 16); w0.w = ks[6] | ((unsigned)ks[7] << 16);
          w1.x = ks[8] | ((unsigned)ks[9] << 16); w1.y = ks[10] | ((unsigned)ks[11] << 16); w1.z = ks[12] | ((unsigned)ks[13] << 16); w1.w = ks[14] | ((unsigned)ks[15] << 16);
          *(LAS v4u*)(KST + d * 72 + 16 * g) = w0; *(LAS v4u*)(KST + d * 72 + 16 * g + 8) = w1;
          if (g == 0) DEC[d] = __expf(total); }
        { unsigned short vv[32];
#pragma unroll
          for (int jj = 0; jj < 32; ++jj) vv[jj] = PROJ[(row0 + 32 * jg + jj) * NPROJ + C_VG + h * 256 + ev];
#pragma unroll
          for (int q4 = 0; q4 < 4; ++q4) { v4u w; w.x = vv[8 * q4] | ((unsigned)vv[8 * q4 + 1] << 16); w.y = vv[8 * q4 + 2] | ((unsigned)vv[8 * q4 + 3] << 16);
              w.z = vv[8 * q4 + 4] | ((unsigned)vv[8 * q4 + 5] << 16); w.w = vv[8 * q4 + 6] | ((unsigned)vv[8 * q4 + 7] << 16);
              *(LAS v4u*)(VT + ev * 72 + 32 * jg + 8 * q4) = w; } }
        __syncthreads();
        if (wave < 3) { const int ib = wave > 0, jb = wave > 1; f32x16 acc;
#pragma unroll
            for (int r = 0; r < 16; ++r) acc[r] = 0.f;
#pragma unroll
            for (int s8 = 0; s8 < 8; ++s8) { const bf16x8 a = *(const LAS bf16x8*)(QD + (ib * 32 + r32) * 136 + 16 * s8 + 8 * hi), bb = *(const LAS bf16x8*)(KD + (jb * 32 + r32) * 136 + 16 * s8 + 8 * hi);
                acc = MFMA32(a, bb, acc); }
#pragma unroll
            for (int r = 0; r < 16; ++r) { const int i = ib * 32 + crow(r, hi), j = jb * 32 + r32; AL[i * 72 + j] = bf1(j <= i ? acc[r] : 0.f); } }
        f32x16 o0, o1;
#pragma unroll
        for (int r = 0; r < 16; ++r) { o0[r] = 0.f; o1[r] = 0.f; }
#define GLA_B(DB, S) do { const bf16x8 sb = pack8<S>(st[DB]); \
            const LAS bf16* p0 = QD + r32 * 136 + 32 * (DB) + 16 * (S) + 4 * hi; const LAS bf16* p1 = p0 + 32 * 136; \
            typedef unsigned long long u64; \
            const u64 a0 = *(const LAS u64*)p0, a1 = *(const LAS u64*)(p0 + 8), c0 = *(const LAS u64*)p1, c1 = *(const LAS u64*)(p1 + 8); \
            v4u fa, fc; fa.x = (unsigned)a0; fa.y = (unsigned)(a0 >> 32); fa.z = (unsigned)a1; fa.w = (unsigned)(a1 >> 32); fc.x = (unsigned)c0; fc.y = (unsigned)(c0 >> 32); fc.z = (unsigned)c1; fc.w = (unsigned)(c1 >> 32); \
            o0 = MFMA32(__builtin_bit_cast(bf16x8, fa), sb, o0); o1 = MFMA32(__builtin_bit_cast(bf16x8, fc), sb, o1); } while (0)
        GLA_B(0, 0); GLA_B(0, 1); GLA_B(1, 0); GLA_B(1, 1); GLA_B(2, 0); GLA_B(2, 1); GLA_B(3, 0); GLA_B(3, 1);
#undef GLA_B
        __syncthreads();
        bf16x8 vf[4];
#pragma unroll
        for (int s = 0; s < 4; ++s) vf[s] = *(const LAS bf16x8*)(VT + (32 * wave + r32) * 72 + 16 * s + 8 * hi);
#pragma unroll
        for (int s = 0; s < 2; ++s) o0 = MFMA32(*(const LAS bf16x8*)(AL + r32 * 72 + 16 * s + 8 * hi), vf[s], o0);
#pragma unroll
        for (int s = 0; s < 4; ++s) o1 = MFMA32(*(const LAS bf16x8*)(AL + (32 + r32) * 72 + 16 * s + 8 * hi), vf[s], o1);
#pragma unroll
        for (int db = 0; db < 4; ++db) {
#pragma unroll
            for (int r4 = 0; r4 < 4; ++r4) { const f32x4 dc = *(const LAS f32x4*)(DEC + 32 * db + 8 * r4 + 4 * hi);
                st[db][4 * r4] *= dc.x; st[db][4 * r4 + 1] *= dc.y; st[db][4 * r4 + 2] *= dc.z; st[db][4 * r4 + 3] *= dc.w; }
#pragma unroll
            for (int s = 0; s < 4; ++s) st[db] = MFMA32(*(const LAS bf16x8*)(KST + (32 * db + r32) * 72 + 16 * s + 8 * hi), vf[s], st[db]); }
#pragma unroll
        for (int r = 0; r < 16; ++r) { float a = o0[r] * o0[r], c = o1[r] * o1[r];
#pragma unroll
            for (int m = 1; m < 32; m <<= 1) { a += __shfl_xor(a, m); c += __shfl_xor(c, m); }
            if (r32 == 0) { SS[wave * 64 + crow(r, hi)] = a; SS[wave * 64 + 32 + crow(r, hi)] = c; } }
        __syncthreads();
        if (tid < 64) { float t = 0.f;
#pragma unroll
            for (int w = 0; w < 8; ++w) t += SS[w * 64 + tid];
            RS[tid] = 1.f / sqrtf(t * (1.f / 256.f) + RMS_EPS); }
        __syncthreads();
#pragma unroll
        for (int r = 0; r < 16; ++r) { const int i0 = crow(r, hi), i1 = 32 + i0;
            const float ra = bf2f(PROJ[(row0 + i0) * NPROJ + C_RG + h * 256 + 32 * wave + r32]), rb = bf2f(PROJ[(row0 + i1) * NPROJ + C_RG + h * 256 + 32 * wave + r32]);
            const float ya = o0[r] * RS[i0] * gn * (ra / (1.f + __expf(-ra))), yb = o1[r] * RS[i1] * gn * (rb / (1.f + __expf(-rb)));
            ATTo[(row0 + i0) * DM + 1024 + h * 256 + 32 * wave + r32] = bf1(ya); ATTo[(row0 + i1) * DM + 1024 + h * 256 + 32 * wave + r32] = bf1(yb); }
    }
    __syncthreads();
}
__device__ __forceinline__ void check_diff_bf16(Frame& F, const bf16* A, const bf16* B, int c0, int c1, gu32* word) {
    const size_t nth = (size_t)F.G * NWAVES * 64; const int w8 = (c1 - c0) / 8; float mx = 0.f;
    for (size_t i = (size_t)F.vcu * NWAVES * 64 + F.tid; i < (size_t)TOK * w8; i += nth) { const size_t row = i / w8; const int c = c0 + (int)(i % w8) * 8;
        const us8 a = *(const GAS us8*)(A + row * DM + c), bq = *(const GAS us8*)(B + row * DM + c);
#pragma unroll
        for (int j = 0; j < 8; ++j) { float dv = fabsf(bf2f(a[j]) - bf2f(bq[j])); if (!(dv == dv)) dv = 1e6f; mx = fmaxf(mx, dv); } }
    mx = wave_max(mx);
    if (F.lane == 0) __hip_atomic_fetch_max((unsigned*)word, __float_as_uint(mx), __ATOMIC_RELAXED, __HIP_MEMORY_SCOPE_AGENT);
}
namespace mb {
constexpr int D = 128, NW = 8, QBLK = 32, KVBLK = 64;
constexpr float SCALE = 0.088388347648318440f, THR = 8.f;
constexpr int SHM_V = KVBLK * D * 2, SHM_K = KVBLK * D * 2;
#define KSWZ(row, colB) ((row) * 256 + ((colB) ^ (((row) & 7) << 4)))
#define SBAR() __builtin_amdgcn_sched_barrier(0)
typedef short s16x4 __attribute__((ext_vector_type(4)));
__device__ __forceinline__ unsigned cvtpk(float lo, float hi) { unsigned r; asm volatile("v_cvt_pk_bf16_f32 %0, %1, %2" : "=v"(r) : "v"(lo), "v"(hi)); return r; }
__device__ __forceinline__ void partialSM(f32x16& p0, f32x16& p1, float& m_reg, float& mn, float& alpha) {
    constexpr float C = SCALE * 1.4426950408889634f;
    float pmax = p0[0];
#pragma unroll
    for (int r = 1; r < 16; ++r) pmax = fmaxf(pmax, p0[r]);
#pragma unroll
    for (int r = 0; r < 16; ++r) pmax = fmaxf(pmax, p1[r]);
    { auto rr = __builtin_amdgcn_permlane32_swap(__float_as_uint(pmax), __float_as_uint(pmax), false, false); pmax = fmaxf(__uint_as_float(rr[0]), __uint_as_float(rr[1])); }
    if (__builtin_expect(__all(pmax - m_reg <= THR / SCALE), 1)) { mn = m_reg; alpha = 1.f; }
    else { mn = fmaxf(m_reg, pmax); alpha = __builtin_amdgcn_exp2f((m_reg - mn) * C); m_reg = mn; }
    const float mnC = -mn * C;
#pragma unroll
    for (int r = 0; r < 16; ++r) p0[r] = fmaf(p0[r], C, mnC);
#pragma unroll
    for (int r = 0; r < 16; ++r) p1[r] = fmaf(p1[r], C, mnC);
#pragma unroll
    for (int r = 0; r < 16; ++r) p0[r] = __builtin_amdgcn_exp2f(p0[r]);
}
__device__ __forceinline__ void finishSM(f32x16& p0, f32x16& p1, float alpha, float& l_reg, bf16x8& pa0, bf16x8& pa1, bf16x8& pa2, bf16x8& pa3) {
#pragma unroll
    for (int r = 0; r < 16; ++r) p1[r] = __builtin_amdgcn_exp2f(p1[r]);
    float ps = 0;
#pragma unroll
    for (int r = 0; r < 16; ++r) ps += p0[r];
#pragma unroll
    for (int r = 0; r < 16; ++r) ps += p1[r];
    { auto rr = __builtin_amdgcn_permlane32_swap(__float_as_uint(ps), __float_as_uint(ps), false, false); ps = __uint_as_float(rr[0]) + __uint_as_float(rr[1]); }
    l_reg = l_reg * alpha + ps;
#define PK4(P, BASE, OUT) do { unsigned a0 = cvtpk(P[BASE + 0], P[BASE + 1]), a1 = cvtpk(P[BASE + 2], P[BASE + 3]);   \
    unsigned b0 = cvtpk(P[BASE + 4], P[BASE + 5]), b1 = cvtpk(P[BASE + 6], P[BASE + 7]);                              \
    auto r0 = __builtin_amdgcn_permlane32_swap(a0, b0, false, false); auto r1 = __builtin_amdgcn_permlane32_swap(a1, b1, false, false); \
    v4u w = {r0[0], r1[0], r0[1], r1[1]}; OUT = __builtin_bit_cast(bf16x8, w); } while (0)
    PK4(p0, 0, pa0); PK4(p0, 8, pa1); PK4(p1, 0, pa2); PK4(p1, 8, pa3);
#undef PK4
}
__device__ __forceinline__ void qkt(f32x16& p0, f32x16& p1, const LAS unsigned char* Ks, const bf16x8* qr, int r32, int hi) {
#pragma unroll
    for (int r = 0; r < 16; ++r) { p0[r] = 0.f; p1[r] = 0.f; }
#pragma unroll
    for (int d0 = 0; d0 < 8; ++d0) { const int cb = (d0 * 16 + hi * 8) * 2;
        const bf16x8 b0 = *(const LAS bf16x8*)(Ks + KSWZ(r32, cb)), b1 = *(const LAS bf16x8*)(Ks + KSWZ(32 + r32, cb));
        p0 = MFMA32(b0, qr[d0], p0); p1 = MFMA32(b1, qr[d0], p1); }
}
__device__ __forceinline__ int v_st(int k, int c) { const int kk = (k & ~0xC) | ((k & 4) << 1) | ((k & 8) >> 1); return ((kk >> 3) * 4 + (c >> 5)) * 512 + ((kk & 7) * 32 + (c & 31)) * 2; }
__device__ __forceinline__ int v_rd_base(int lane) { return ((lane & 3) << 3) | (((lane >> 2) & 3) << 6) | (((lane >> 4) & 1) << 5) | (((lane >> 5) & 1) << 8); }
constexpr int v_rd_off(int d0, int ks, int half) { return d0 * 512 + ks * 4096 + half * 2048; }
template <int OFF> __device__ __forceinline__ s16x4 tr_read(int vb) { s16x4 r; asm volatile("ds_read_b64_tr_b16 %0, %1 offset:%2" : "=&v"(r) : "v"(vb), "i"(OFF) : "memory"); return r; }
template <int D0> __device__ __forceinline__ void pv_one(f32x16& od, int vb, bf16x8 pa0, bf16x8 pa1, bf16x8 pa2, bf16x8 pa3) {
    const s16x4 l0 = tr_read<v_rd_off(D0, 0, 0)>(vb), h0 = tr_read<v_rd_off(D0, 0, 1)>(vb), l1 = tr_read<v_rd_off(D0, 1, 0)>(vb), h1 = tr_read<v_rd_off(D0, 1, 1)>(vb);
    const s16x4 l2 = tr_read<v_rd_off(D0, 2, 0)>(vb), h2 = tr_read<v_rd_off(D0, 2, 1)>(vb), l3 = tr_read<v_rd_off(D0, 3, 0)>(vb), h3 = tr_read<v_rd_off(D0, 3, 1)>(vb);
    asm volatile("s_waitcnt lgkmcnt(0)" ::: "memory"); SBAR();
#define PK(L, H) (bf16x8){L[0], L[1], L[2], L[3], H[0], H[1], H[2], H[3]}
    od = MFMA32(pa0, PK(l0, h0), od); od = MFMA32(pa1, PK(l1, h1), od); od = MFMA32(pa2, PK(l2, h2), od); od = MFMA32(pa3, PK(l3, h3), od);
#undef PK
}
__device__ __forceinline__ void pv_d0(f32x16* o, int vb, bf16x8 pa0, bf16x8 pa1, bf16x8 pa2, bf16x8 pa3) {
    pv_one<0>(o[0], vb, pa0, pa1, pa2, pa3); pv_one<1>(o[1], vb, pa0, pa1, pa2, pa3); pv_one<2>(o[2], vb, pa0, pa1, pa2, pa3); pv_one<3>(o[3], vb, pa0, pa1, pa2, pa3);
}
__device__ __forceinline__ void mask_tile(f32x16& p0, f32x16& p1, int j, int qrel, int hi, unsigned sel) {
    if (j < 4) {
        const int kb = 64 * j + 4 * hi;
#pragma unroll
        for (int r = 0; r < 16; ++r) { const int kv = kb + (r & 3) + 8 * (r >> 2); if (kv > qrel) p0[r] = -INFINITY; if (kv + 32 > qrel) p1[r] = -INFINITY; }
    } else if (!((sel >> ((j - 4) >> 2)) & 1u)) {
#pragma unroll
        for (int r = 0; r < 16; ++r) { p0[r] = -INFINITY; p1[r] = -INFINITY; }
    }
}
__device__ __forceinline__ void moba_unit(Frame& F, int unit, bf16* ATTo) {
    const int qb = 7 - (unit >> 6), bh = unit & 63, b = bh >> 3, h = bh & 7;
    const int tid = F.tid, wid = F.wave, lane = F.lane, r32 = lane & 31, hi = lane >> 5;
    LAS unsigned char* lds = F.lds + RING_OFF;
    LAS unsigned char* V_lds = lds; LAS unsigned char* K_lds = lds + 2 * SHM_V;
    LAS float* ws = (LAS float*)(lds + 2 * SHM_V + 2 * SHM_K) + wid * 64; LAS float* li_l = ws; LAS float* al_l = ws + 32;
    const bf16* PROJ = (const bf16*)(F.ws + WS_PROJ);
    const size_t rowb = (size_t)b * SEQ;
    const bf16* Kh = PROJ + rowb * NPROJ + C_KM + h * 128; const bf16* Vh = PROJ + rowb * NPROJ + C_VM + h * 128;
    constexpr int LDK = NPROJ;
    float m_reg = -1e30f, l_reg = 0; f32x16 o[4]; bf16x8 qr[8];
#pragma unroll
    for (int i = 0; i < 4; ++i)
#pragma unroll
        for (int r = 0; r < 16; ++r) o[i][r] = 0.f;
    { const bf16* Qw = PROJ + (rowb + qb * 256 + wid * QBLK + r32) * NPROJ + C_QM + h * 128 + hi * 8;
#pragma unroll
      for (int d0 = 0; d0 < 8; ++d0) qr[d0] = *(const GAS bf16x8*)(Qw + d0 * 16); }
    const int sr = tid >> 4, sc = (tid & 15) * 8, vst0 = v_st(sr, sc), vst1 = v_st(32 + sr, sc);
    const int vb0 = (int)(uintptr_t)V_lds + v_rd_base(lane);
    const int qrel = wid * QBLK + r32;
    __syncthreads();
    unsigned sel = 0;
    {
        float g[7];
#pragma unroll
        for (int n = 0; n < 7; ++n) { g[n] = 0.f;
            if (n < qb) { float gs = 0.f;
#pragma unroll 1
                for (int t = 0; t < 4; ++t) { const int k0 = n * 256 + 64 * t; const int bsel = t & 1;
                    const bf16x8 ka = *(const GAS bf16x8*)(Kh + (size_t)(k0 + sr) * LDK + sc), kb2 = *(const GAS bf16x8*)(Kh + (size_t)(k0 + 32 + sr) * LDK + sc);
                    *(LAS bf16x8*)(K_lds + bsel * SHM_K + KSWZ(sr, sc * 2)) = ka; *(LAS bf16x8*)(K_lds + bsel * SHM_K + KSWZ(32 + sr, sc * 2)) = kb2;
                    __syncthreads();
                    f32x16 p0, p1; qkt(p0, p1, K_lds + bsel * SHM_K, qr, r32, hi);
#pragma unroll
                    for (int r = 0; r < 16; ++r) gs += p0[r] + p1[r]; }
                { auto rr = __builtin_amdgcn_permlane32_swap(__float_as_uint(gs), __float_as_uint(gs), false, false); gs = __uint_as_float(rr[0]) + __uint_as_float(rr[1]); }
                g[n] = gs; } }
#pragma unroll
        for (int n = 0; n < 7; ++n) { int cnt = 0;
#pragma unroll
            for (int m = 0; m < 7; ++m) if (m != n && m < qb && (g[m] > g[n] || (g[m] == g[n] && m < n))) ++cnt;
            if (n < qb && cnt < 3) sel |= 1u << n; }
    }
    __syncthreads();
    const int NT = 4 * (qb + 1);
#define KSTART(j) (((j) < 4) ? (qb * 256 + 64 * (j)) : (((j) - 4) * 64))
    bf16x8 vs0, vs1, ks0, ks1;
#define SLOAD(k0) do { vs0 = *(const GAS bf16x8*)(&Vh[(size_t)((k0) + sr) * LDK + sc]); vs1 = *(const GAS bf16x8*)(&Vh[(size_t)((k0) + 32 + sr) * LDK + sc]); \
    ks0 = *(const GAS bf16x8*)(&Kh[(size_t)((k0) + sr) * LDK + sc]); ks1 = *(const GAS bf16x8*)(&Kh[(size_t)((k0) + 32 + sr) * LDK + sc]); } while (0)
#define SWRITE(bb) do { *(LAS bf16x8*)(V_lds + (bb) * SHM_V + vst0) = vs0; *(LAS bf16x8*)(V_lds + (bb) * SHM_V + vst1) = vs1; const int kc = sc * 2; \
    *(LAS bf16x8*)(K_lds + (bb) * SHM_K + KSWZ(sr, kc)) = ks0; *(LAS bf16x8*)(K_lds + (bb) * SHM_K + KSWZ(32 + sr, kc)) = ks1; } while (0)
    SLOAD(KSTART(0)); SWRITE(0); SLOAD(KSTART(1));
    __syncthreads();
#pragma unroll 1
    for (int j = 0; j < NT; ++j) {
        const int bsel = j & 1;
        if (j + 1 < NT) { SWRITE(bsel ^ 1); }
        if (j + 2 < NT) { const int k2 = KSTART(j + 2); SLOAD(k2); }
        f32x16 p0, p1; float mn, al; bf16x8 pa0, pa1, pa2, pa3;
        qkt(p0, p1, K_lds + bsel * SHM_K, qr, r32, hi); mask_tile(p0, p1, j, qrel, hi, sel);
        partialSM(p0, p1, m_reg, mn, al);
        if (__any(al < 1.f)) { if (hi == 0) al_l[r32] = al; asm volatile("s_waitcnt lgkmcnt(0)" ::: "memory");
#pragma unroll
            for (int d_ = 0; d_ < 4; ++d_)
#pragma unroll
                for (int r = 0; r < 16; ++r) o[d_][r] *= al_l[crow(r, hi)]; }
        finishSM(p0, p1, al, l_reg, pa0, pa1, pa2, pa3); SBAR();
        pv_d0(o, vb0 + bsel * SHM_V, pa0, pa1, pa2, pa3);
        __syncthreads();
    }
    if (hi == 0) li_l[r32] = l_reg; asm volatile("s_waitcnt lgkmcnt(0)" ::: "memory");
    float rli[16];
#pragma unroll
    for (int r = 0; r < 16; ++r) rli[r] = __builtin_amdgcn_rcpf(li_l[crow(r, hi)]);
    bf16* Ow = ATTo + (rowb + qb * 256 + wid * QBLK) * DM + h * 128;
#pragma unroll
    for (int r = 0; r < 16; ++r) { const int orow = crow(r, hi);
#pragma unroll
        for (int d0 = 0; d0 < 4; ++d0) Ow[(size_t)orow * DM + d0 * 32 + r32] = bf1(o[d0][r] * rli[r]); }
    __syncthreads();
#undef SLOAD
#undef SWRITE
#undef KSTART
}
#undef KSWZ
#undef SBAR
}
namespace mb {
__device__ __forceinline__ void qkt_acc(f32x16& p0, f32x16& p1, const LAS unsigned char* Ks, const bf16x8* qr, int r32, int hi) {
#define KSWZ(row, colB) ((row) * 256 + ((colB) ^ (((row) & 7) << 4)))
#pragma unroll
    for (int d0 = 0; d0 < 8; ++d0) { const int cb = (d0 * 16 + hi * 8) * 2;
        const bf16x8 b0 = *(const LAS bf16x8*)(Ks + KSWZ(r32, cb)), b1 = *(const LAS bf16x8*)(Ks + KSWZ(32 + r32, cb));
        p0 = MFMA32(b0, qr[d0], p0); p1 = MFMA32(b1, qr[d0], p1); }
}
__device__ __forceinline__ void xattn_unit(Frame& F, int unit, bf16* XOo) {
    const int b = unit >> 5, h = (unit >> 3) & 3, qt = unit & 7;
    const int tid = F.tid, wid = F.wave, lane = F.lane, r32 = lane & 31, hi = lane >> 5;
    LAS unsigned char* lds = F.lds + RING_OFF;
    LAS unsigned char* V_lds = lds; LAS unsigned char* K_lds = lds + 2 * SHM_V;
    LAS float* wsl = (LAS float*)(lds + 2 * SHM_V + 2 * SHM_K) + wid * 64;
    const bf16* KV = (const bf16*)(F.ws + WS_KV) + (size_t)(b * MEMLEN) * (2 * DM) + h * 512;
    const bf16* Qw = (const bf16*)(F.ws + WS_Q) + ((size_t)b * SEQ + qt * 256 + wid * QBLK + r32) * DM + h * 512 + hi * 8;
    constexpr int LDK = 2 * DM;
    const int sr = tid >> 4, sc = (tid & 15) * 8, vst0 = v_st(sr, sc), vst1 = v_st(32 + sr, sc);
    const int vb0 = (int)(uintptr_t)V_lds + v_rd_base(lane);
    f32x16 s0[4], s1[4];
#pragma unroll
    for (int t = 0; t < 4; ++t)
#pragma unroll
        for (int r = 0; r < 16; ++r) { s0[t][r] = 0.f; s1[t][r] = 0.f; }
    bf16x8 g0, g1;
#define XSRC(s, voff) (KV + (size_t)(64 * ((s) & 3)) * LDK + 128 * ((s) >> 2) + (voff))
#define XLOAD(s, voff) do { const bf16* src_ = XSRC(s, voff); g0 = *(const GAS bf16x8*)(src_ + (size_t)sr * LDK + sc); g1 = *(const GAS bf16x8*)(src_ + (size_t)(32 + sr) * LDK + sc); } while (0)
#define XWRITE_K(bb) do { *(LAS bf16x8*)(K_lds + (bb) * SHM_K + KSWZ(sr, sc * 2)) = g0; *(LAS bf16x8*)(K_lds + (bb) * SHM_K + KSWZ(32 + sr, sc * 2)) = g1; } while (0)
#define XWRITE_V(bb) do { *(LAS bf16x8*)(V_lds + (bb) * SHM_V + vst0) = g0; *(LAS bf16x8*)(V_lds + (bb) * SHM_V + vst1) = g1; } while (0)
    __syncthreads();
    XLOAD(0, 0); XWRITE_K(0); XLOAD(1, 0);
    __syncthreads();
#pragma unroll 1
    for (int dc = 0; dc < 4; ++dc) {
        bf16x8 qr[8];
#pragma unroll
        for (int d0 = 0; d0 < 8; ++d0) qr[d0] = *(const GAS bf16x8*)(Qw + dc * 128 + d0 * 16);
#pragma unroll
        for (int t = 0; t < 4; ++t) { const int step = dc * 4 + t;
            if (step + 1 < 16) XWRITE_K((t & 1) ^ 1);
            if (step + 2 < 16) XLOAD(step + 2, 0);
            qkt_acc(s0[t], s1[t], K_lds + (t & 1) * SHM_K, qr, r32, hi);
            __syncthreads(); }
    }
    constexpr float C = 0.04419417382415922f * 1.4426950408889634f;
    float pmax = s0[0][0];
#pragma unroll
    for (int t = 0; t < 4; ++t)
#pragma unroll
        for (int r = 0; r < 16; ++r) pmax = fmaxf(pmax, fmaxf(s0[t][r], s1[t][r]));
    { auto rr = __builtin_amdgcn_permlane32_swap(__float_as_uint(pmax), __float_as_uint(pmax), false, false); pmax = fmaxf(__uint_as_float(rr[0]), __uint_as_float(rr[1])); }
    const float mC = -pmax * C; float ps = 0.f;
#pragma unroll
    for (int t = 0; t < 4; ++t)
#pragma unroll
        for (int r = 0; r < 16; ++r) { s0[t][r] = __builtin_amdgcn_exp2f(fmaf(s0[t][r], C, mC)); s1[t][r] = __builtin_amdgcn_exp2f(fmaf(s1[t][r], C, mC)); ps += s0[t][r] + s1[t][r]; }
    { auto rr = __builtin_amdgcn_permlane32_swap(__float_as_uint(ps), __float_as_uint(ps), false, false); ps = __uint_as_float(rr[0]) + __uint_as_float(rr[1]); }
    bf16x8 pa[4][4];
#define PK4(P, BASE, OUT) do { unsigned a0 = cvtpk(P[BASE + 0], P[BASE + 1]), a1 = cvtpk(P[BASE + 2], P[BASE + 3]);   \
    unsigned b0 = cvtpk(P[BASE + 4], P[BASE + 5]), b1 = cvtpk(P[BASE + 6], P[BASE + 7]);                              \
    auto r0 = __builtin_amdgcn_permlane32_swap(a0, b0, false, false); auto r1 = __builtin_amdgcn_permlane32_swap(a1, b1, false, false); \
    v4u w = {r0[0], r1[0], r0[1], r1[1]}; OUT = __builtin_bit_cast(bf16x8, w); } while (0)
#pragma unroll
    for (int t = 0; t < 4; ++t) { PK4(s0[t], 0, pa[t][0]); PK4(s0[t], 8, pa[t][1]); PK4(s1[t], 0, pa[t][2]); PK4(s1[t], 8, pa[t][3]); }
#undef PK4
    if (hi == 0) wsl[r32] = ps; asm volatile("s_waitcnt lgkmcnt(0)" ::: "memory");
    float rli[16];
#pragma unroll
    for (int r = 0; r < 16; ++r) rli[r] = __builtin_amdgcn_rcpf(wsl[crow(r, hi)]);
    XLOAD(0, DM); XWRITE_V(0); XLOAD(1, DM);
    __syncthreads();
    bf16* Ow = XOo + ((size_t)b * SEQ + qt * 256 + wid * QBLK) * DM + h * 512;
#pragma unroll 1
    for (int dc = 0; dc < 4; ++dc) {
        f32x16 o[4];
#pragma unroll
        for (int i = 0; i < 4; ++i)
#pragma unroll
            for (int r = 0; r < 16; ++r) o[i][r] = 0.f;
#pragma unroll
        for (int t = 0; t < 4; ++t) { const int step = dc * 4 + t;
            if (step + 1 < 16) XWRITE_V((t & 1) ^ 1);
            if (step + 2 < 16) XLOAD(step + 2, DM);
            pv_d0(o, vb0 + (t & 1) * SHM_V, pa[t][0], pa[t][1], pa[t][2], pa[t][3]);
            __syncthreads(); }
#pragma unroll
        for (int r = 0; r < 16; ++r) { const int orow = crow(r, hi);
#pragma unroll
            for (int d0 = 0; d0 < 4; ++d0) Ow[(size_t)orow * DM + dc * 128 + d0 * 32 + r32] = bf1(o[d0][r] * rli[r]); }
    }
#undef XSRC
#undef XLOAD
#undef XWRITE_K
#undef XWRITE_V
#undef KSWZ
}
}

struct Args { const float* in[20]; float* out; unsigned char* ws; int ph_lo, ph_hi, li, pad; };
__global__ void __launch_bounds__(NWAVES * 64, 2) mk_fwd(Args args) {
    extern __shared__ __attribute__((aligned(16))) unsigned char lds[];
    Frame F;
    F.lds = (LAS unsigned char*)lds;
    F.MISC = (volatile LAS unsigned*)(F.lds + MISC_OFF);
    F.tid = threadIdx.x; F.lane = F.tid & 63; F.wave = __builtin_amdgcn_readfirstlane(F.tid >> 6);
    F.G = gridDim.x; { const int bx = blockIdx.x; F.vcu = (F.G % 8 == 0) ? (bx % 8) * (F.G / 8) + bx / 8 : bx; }
#pragma unroll
    for (int i = 0; i < 20; ++i) F.in[i] = args.in[i];
    F.out = args.out; F.ws = args.ws;
    unsigned char* ws = args.ws;
    F.ctl = (gu32*)(ws + WS_CTL);
    for (int u = F.tid; u < (LDS_BYTES - LDSCTL_OFF) / 4; u += NWAVES * 64) ((LAS unsigned*)(F.lds + LDSCTL_OFF))[u] = 0u;
    __syncthreads();
    XcdBarrier bar; bar.bar = (unsigned*)(F.ctl + CW_BAR); bar.x = 0; bar.st = nullptr;
    if (N_LAUNCHES != PER_PHASE) bar = xcd_barrier_post((unsigned*)(F.ctl + CW_BAR), F.MISC + 8);
#define GRID_BAR() do { if (N_LAUNCHES != PER_PHASE) xcd_barrier(bar); } while (0)
    const int lo = args.ph_lo, hi = args.ph_hi;
#define IN(k) (lo <= (k) && (k) < hi)
#define BOTH(k) (IN(k) && IN((k) + 1))

    if (IN(0)) { p0_prologue(F); if (BOTH(0)) GRID_BAR(); }
    if (IN(1)) {
        { pg8::Gemm g{(const pg8::bf16_t*)(ws + WS_XB), (const pg8::bf16_t*)(ws + WS_WIN), TOK, NPROJ_PAD, DM}; pg8::StaticOrder S; S.init(TOK, NPROJ_PAD, F.G, (int)blockIdx.x);
          EpiProj E{(pg8::bf16_t*)(ws + WS_PROJ), (float*)(ws + WS_GATE)};
          pg8::gemm_phase<EpiProj, pg8::StaticOrder, PG8_ALIGN, PG8_SP2>(F.lds + RING_OFF, g, S, E); }
        { const int nu1 = (TOK / 256) * (NPROJ_PAD / 256); const int shift = nu1 % F.G; const int c2 = ((int)blockIdx.x - shift + F.G) % F.G;
          pg8::Gemm g{(const pg8::bf16_t*)(ws + WS_MEMB), (const pg8::bf16_t*)(ws + WS_WKV), BATCH * MEMLEN, 2 * DM, DM}; pg8::StaticOrder S; S.init(BATCH * MEMLEN, 2 * DM, F.G, c2);
          pg8::EpiBf16<0> E{(pg8::bf16_t*)(ws + WS_KV), 2 * DM, nullptr, 0, 0, 1.f};
          pg8::gemm_phase<pg8::EpiBf16<0>, pg8::StaticOrder, PG8_ALIGN, PG8_SP2>(F.lds + RING_OFF, g, S, E); }
        if (BOTH(1)) GRID_BAR();
    }
#if CHECK_GLA || CHECK_MOBA
    if (IN(2)) { kmean_phase(F); if (BOTH(2)) GRID_BAR(); }
#endif
    if (IN(3)) {
#if CHECK_GLA
        if (F.vcu < 32) { naive_gla_unit(F, F.vcu); gla_unit(F, F.vcu, (bf16*)(ws + WS_Z)); }
        else for (int u = F.vcu - 32; u < BATCH * 8 * 32; u += F.G - 32) naive_attn_unit<128, 64, 0>(F, u);
#elif CHECK_MOBA
        if (F.vcu < 32) gla_unit(F, F.vcu, (bf16*)(ws + WS_ATT));
        else for (int u = F.vcu - 32; u < BATCH * 8 * 32; u += F.G - 32) naive_attn_unit<128, 64, 0>(F, u);
        for (;;) { __syncthreads(); if (F.tid == 0) F.MISC[0] = __hip_atomic_fetch_add((unsigned*)(F.ctl + CW_Q), 1u, __ATOMIC_RELAXED, __HIP_MEMORY_SCOPE_AGENT); __syncthreads();
            const int u = (int)F.MISC[0]; if (u >= BATCH * 8 * 8) break; mb::moba_unit(F, u, (bf16*)(ws + WS_Z)); }
#else
        if (F.vcu < 32) gla_unit(F, F.vcu, (bf16*)(ws + WS_ATT));
        for (;;) { __syncthreads(); if (F.tid == 0) F.MISC[0] = __hip_atomic_fetch_add((unsigned*)(F.ctl + CW_Q), 1u, __ATOMIC_RELAXED, __HIP_MEMORY_SCOPE_AGENT); __syncthreads();
            const int u = (int)F.MISC[0]; if (u >= BATCH * 8 * 8) break; mb::moba_unit(F, u, (bf16*)(ws + WS_ATT)); }
#endif
        if (BOTH(3)) GRID_BAR();
#if CHECK_GLA
        check_diff_bf16(F, (const bf16*)(ws + WS_ATT), (const bf16*)(ws + WS_Z), 1024, 2048, F.ctl + CW_CHK); GRID_BAR();
#elif CHECK_MOBA
        check_diff_bf16(F, (const bf16*)(ws + WS_ATT), (const bf16*)(ws + WS_Z), 0, 1024, F.ctl + CW_CHK); GRID_BAR();
#endif
    }
    if (IN(4)) {
        pg8::Gemm g{(const pg8::bf16_t*)(ws + WS_ATT), (const pg8::bf16_t*)(ws + WS_WOUT), TOK, DM, DM}; pg8::StaticOrder S; S.init(TOK, DM, F.G, (int)blockIdx.x);
        EpiRes E{F.in[0], (float*)(ws + WS_Z), DN_ALPHA};
        pg8::gemm_phase<EpiRes, pg8::StaticOrder, PG8_ALIGN, PG8_SP2>(F.lds + RING_OFF, g, S, E);
        if (BOTH(4)) GRID_BAR();
    }
    if (IN(5)) { ln_phase(F, F.in[7], F.in[8]); if (BOTH(5)) GRID_BAR(); }
    if (IN(6)) {
        pg8::Gemm g{(const pg8::bf16_t*)(ws + WS_HB), (const pg8::bf16_t*)(ws + WS_WQ), TOK, DM, DM}; pg8::StaticOrder S; S.init(TOK, DM, F.G, (int)blockIdx.x);
        pg8::EpiBf16<0> E{(pg8::bf16_t*)(ws + WS_Q), DM, nullptr, 0, 0, 1.f};
        pg8::gemm_phase<pg8::EpiBf16<0>, pg8::StaticOrder, PG8_ALIGN, PG8_SP2>(F.lds + RING_OFF, g, S, E);
        if (BOTH(6)) GRID_BAR();
    }
    if (IN(7)) {
#if CHECK_XATT
        for (int u = F.vcu; u < BATCH * 4 * 32; u += F.G) naive_attn_unit<512, 32, 1>(F, u);
        for (int u = F.vcu; u < BATCH * 4 * 8; u += F.G) mb::xattn_unit(F, u, (bf16*)(ws + WS_ATT));
        GRID_BAR(); check_diff_bf16(F, (const bf16*)(ws + WS_XO), (const bf16*)(ws + WS_ATT), 0, 2048, F.ctl + CW_CHK);
#else
        for (int u = F.vcu; u < BATCH * 4 * 8; u += F.G) mb::xattn_unit(F, u, (bf16*)(ws + WS_XO));
#endif
        if (BOTH(7)) GRID_BAR(); }
    if (IN(8)) {
        pg8::Gemm g{(const pg8::bf16_t*)(ws + WS_XO), (const pg8::bf16_t*)(ws + WS_WO), TOK, DM, DM}; pg8::StaticOrder S; S.init(TOK, DM, F.G, (int)blockIdx.x);
        EpiRes E{(const float*)(ws + WS_Z), (float*)(ws + WS_Z), DN_ALPHA};
        pg8::gemm_phase<EpiRes, pg8::StaticOrder, PG8_ALIGN, PG8_SP2>(F.lds + RING_OFF, g, S, E);
        if (BOTH(8)) GRID_BAR();
    }
    if (IN(9)) {
        ln_phase(F, F.in[12], F.in[13]);
        cvt_linear(F, F.in[16], (bf16*)(ws + WS_PU), (size_t)16384 * DM / 8);
        cvt_linear(F, F.in[17], (bf16*)(ws + WS_PV), (size_t)16384 * DM / 8);
        if (BOTH(9)) GRID_BAR();
    }
    if (IN(10)) {
        pg8::Gemm g{(const pg8::bf16_t*)(ws + WS_HB), (const pg8::bf16_t*)(ws + WS_WPQ), TOK, DM, DM}; pg8::StaticOrder S; S.init(TOK, DM, F.G, (int)blockIdx.x);
        pg8::EpiBf16<0> E{(pg8::bf16_t*)(ws + WS_Q), DM, nullptr, 0, 0, 1.f};
        pg8::gemm_phase<pg8::EpiBf16<0>, pg8::StaticOrder, PG8_ALIGN, PG8_SP2>(F.lds + RING_OFF, g, S, E);
        if (BOTH(10)) GRID_BAR();
    }
    if (IN(11)) { peer_phase(F);
#if PROBE_PEER2
        peer_phase(F);
#endif
#if CHECK_ANY
        if (blockIdx.x == 0 && F.tid == 0) { const float md = __uint_as_float(__hip_atomic_load((unsigned*)(F.ctl + CW_CHK), __ATOMIC_RELAXED, __HIP_MEMORY_SCOPE_AGENT)); F.out[0] += 1000.f * md; }
#endif
    }
#undef IN
#undef BOTH
}

extern "C" void kernel_launch(void* const* d_in, const int* in_sizes, int n_in, void* d_out, int out_size, void* d_ws, size_t ws_size, hipStream_t stream) {
    static int grid = 0;
    if (grid == 0) {
        if (n_in != 20 || out_size != TOK * DM || ws_size < WS_END) { fprintf(stderr, "kernel_launch: unexpected shapes (n_in %d out %d ws %zu)\n", n_in, out_size, ws_size); grid = -1; return; }
        int dev = 0, cus = 0;
        if (hipGetDevice(&dev) != hipSuccess || hipDeviceGetAttribute(&cus, hipDeviceAttributeMultiprocessorCount, dev) != hipSuccess) { grid = -1; return; }
        if (hipFuncSetAttribute((const void*)mk_fwd, hipFuncAttributeMaxDynamicSharedMemorySize, LDS_BYTES) != hipSuccess) { fprintf(stderr, "kernel_launch: hipFuncSetAttribute failed\n"); grid = -1; return; }
        (void)hipGetLastError();
        grid = cus;
    }
    if (grid < 0) return;
    (void)hipMemsetAsync((char*)d_ws + WS_CTL, 0, CTL_ZERO_BYTES, stream);
    Args a{};
    for (int i = 0; i < 20; ++i) a.in[i] = (const float*)d_in[i];
    a.out = (float*)d_out; a.ws = (unsigned char*)d_ws;
    if (N_LAUNCHES == 1) { a.ph_lo = 0; a.ph_hi = PER_PHASE; a.li = 0; hipLaunchKernelGGL(mk_fwd, dim3(grid), dim3(NWAVES * 64), LDS_BYTES, stream, a); }
    else for (int li = 0; li < PER_PHASE; ++li) { a.ph_lo = li; a.ph_hi = li + 1; a.li = li; hipLaunchKernelGGL(mk_fwd, dim3(grid), dim3(NWAVES * 64), LDS_BYTES, stream, a); }
}
```

```cpp
#include <hip/hip_runtime.h>
#include <cstdio>
#include <cstdint>
namespace pg8 {
#define PG8_LAS __attribute__((address_space(3)))
typedef unsigned short bf16_t;
typedef short bf16x8 __attribute__((ext_vector_type(8)));
typedef float f32x4 __attribute__((ext_vector_type(4)));
typedef unsigned u32x4 __attribute__((ext_vector_type(4)));
constexpr int BM = 256, BK = 64, HALF = 128, HTB = HALF * BK * 2  , STAGE_BYTES = 8 * HTB, NXCD = 8, WGM = 8;

__host__ __device__ __forceinline__ int lds_byte(int r, int c) { const int st = (r >> 4) * 2 + (c >> 5), rr = r & 15, cc = c & 31, ob = rr * 64 + cc * 2; return st * 1024 + (ob ^ (((ob >> 9) & 1) << 5)); }
__host__ __device__ __forceinline__ void stage_rc(int b, int& R, int& C) { const int st = b / 1024, sb = b % 1024, swz = sb ^ (((sb >> 9) & 1) << 5); R = (st >> 1) * 16 + swz / 64; C = (st & 1) * 32 + (swz % 64) / 2; }
__host__ __device__ __forceinline__ int perm32(int rho) { const int n = rho >> 4, i = rho & 15; return 8 * (i >> 2) + 4 * n + (i & 3); }

struct Unit { int pm, pn; };
struct Gemm { const bf16_t* A; const bf16_t* Bt; int M, N, K; };

struct StaticOrder {
    int nM, nN, nwg, G, c;
    __host__ __device__ void init(int M, int N, int G_, int c_) { nM = M / BM; nN = N / BM; nwg = nM * nN; G = G_; c = c_; }
    __host__ __device__ bool next(int i, Unit& u) const {
        const long L = (long)i * G + c; if (L >= nwg) return false;
        int wgid = (int)L; { const int q = nwg / NXCD, r = nwg % NXCD, xcd = wgid % NXCD, off = wgid / NXCD; wgid = (xcd < r ? xcd * (q + 1) : r * (q + 1) + (xcd - r) * q) + off; }
        const int nig = WGM * nN, gid = wgid / nig, fm = gid * WGM, gsz = (nM - fm) < WGM ? (nM - fm) : WGM;
        u.pm = fm + ((wgid % nig) % gsz); u.pn = (wgid % nig) / gsz; return true;
    }
    __device__ __forceinline__ void a_ready(const Unit&) const {}
    __device__ __forceinline__ void done(const Unit&) const {}
};

__device__ __forceinline__ unsigned cvt_pk_bf16(float lo, float hi) { unsigned r; asm volatile("v_cvt_pk_bf16_f32 %0, %1, %2" : "=v"(r) : "v"(lo), "v"(hi)); return r; }
typedef float f32x2 __attribute__((ext_vector_type(2)));
__device__ __forceinline__ f32x2 gelu_pk(f32x2 v) {
    const f32x2 av = __builtin_elementwise_abs(v), d = av * 0.2316418882f + 1.0f;
    f32x2 t; t.x = __builtin_amdgcn_rcpf(d.x); t.y = __builtin_amdgcn_rcpf(d.y);
    f32x2 q = t * 0.5307027145f + (-0.7265760135f); q = q * t + 0.7107068705f; q = q * t + (-0.142248368f); q = q * t + 0.127414796f; q = q * t;
    const f32x2 s = (v * v) * (-0.72134752044f);
    f32x2 e; e.x = __builtin_amdgcn_exp2f(s.x); e.y = __builtin_amdgcn_exp2f(s.y);
    const f32x2 m = v * (q * e), r = v - m;
    f32x2 o; o.x = v.x < 0.f ? m.x : r.x; o.y = v.y < 0.f ? m.y : r.y; return o;
}

template <int ACT  > struct EpiBf16 {
    static constexpr bool PERM = true, AFTER_DRAIN = false; static_assert(ACT == 0 || ACT == 1, "EpiBf16: ACT is 0 (none) or 1 (gelu_pk)");
    bf16_t* O; int ldc; const float* bias; int split_cols; size_t split_stride; float scale0;
    __device__ __forceinline__ void operator()(const f32x4 (&acc)[2][2][4][2], const Unit& u, int wr, int wc, int fr, int fq) const {
        const int row0 = u.pm * BM + wr * 64 + fr; int colt = u.pn * BM; bf16_t* base = O;
        float sc = 1.f; if (split_cols) { const int t = colt / split_cols; base += (size_t)t * split_stride; colt -= t * split_cols; if (t == 0) sc = scale0; }
        const int col0 = colt + wc * 32 + 8 * fq, bcol0 = u.pn * BM + wc * 32 + 8 * fq;
        f32x4 bv[2][2];
#pragma unroll
        for (int bj = 0; bj < 2; ++bj)
#pragma unroll
            for (int n = 0; n < 2; ++n) bv[bj][n] = bias ? *(const f32x4*)(bias + bcol0 + bj * HALF + 4 * n) : (f32x4){0.f, 0.f, 0.f, 0.f};
#pragma unroll
        for (int ai = 0; ai < 2; ++ai)
#pragma unroll
            for (int m = 0; m < 4; ++m) { bf16_t* rowp = base + (size_t)(row0 + ai * HALF + m * 16) * ldc + col0;
#pragma unroll
                for (int bj = 0; bj < 2; ++bj) { f32x4 v0 = acc[ai][bj][m][0] + bv[bj][0], v1 = acc[ai][bj][m][1] + bv[bj][1];
                    if (ACT == 1) { f32x2 a = gelu_pk((f32x2){v0[0], v0[1]}), b = gelu_pk((f32x2){v0[2], v0[3]}), c = gelu_pk((f32x2){v1[0], v1[1]}), d = gelu_pk((f32x2){v1[2], v1[3]});
                        v0 = (f32x4){a.x, a.y, b.x, b.y}; v1 = (f32x4){c.x, c.y, d.x, d.y}; }
                    v0 = v0 * sc; v1 = v1 * sc; u32x4 w; w.x = cvt_pk_bf16(v0[0], v0[1]); w.y = cvt_pk_bf16(v0[2], v0[3]); w.z = cvt_pk_bf16(v1[0], v1[1]); w.w = cvt_pk_bf16(v1[2], v1[3]);
                    *(u32x4*)(rowp + bj * HALF) = w; } }
    }
};

struct PanelStats {
    unsigned* xbuf;
    unsigned* cnt;
    unsigned* tmo;
    int ntn; float eps;
    unsigned code;
    __device__ __forceinline__ bool run(const f32x4 (&v)[2][2][4][2], const Unit& u, int wr, int wc, int fr, int fq, PG8_LAS unsigned char* lds, int wid, int lane) const {
        typedef float f32x2v __attribute__((ext_vector_type(2)));
        PG8_LAS f32x2v* P = (PG8_LAS f32x2v*)lds;
        PG8_LAS f32x2v* S = (PG8_LAS f32x2v*)(lds + 8192);
        PG8_LAS unsigned* flag = (PG8_LAS unsigned*)(lds + 8192 + 2048);
#pragma unroll
        for (int ai = 0; ai < 2; ++ai)
#pragma unroll
            for (int m = 0; m < 4; ++m) {
                float s = 0.f;
#pragma unroll
                for (int bj = 0; bj < 2; ++bj)
#pragma unroll
                    for (int n = 0; n < 2; ++n) { const f32x4 x = v[ai][bj][m][n]; s += (x[0] + x[1]) + (x[2] + x[3]); }
                s += __shfl_xor(s, 16); s += __shfl_xor(s, 32);
                const float mw = s * (1.0f / 64.0f); float q = 0.f;
#pragma unroll
                for (int bj = 0; bj < 2; ++bj)
#pragma unroll
                    for (int n = 0; n < 2; ++n) { const f32x4 d = v[ai][bj][m][n] - mw; q += (d[0] * d[0] + d[1] * d[1]) + (d[2] * d[2] + d[3] * d[3]); }
                q += __shfl_xor(q, 16); q += __shfl_xor(q, 32);
                if (fq == 0) P[(ai * HALF + wr * 64 + m * 16 + fr) * 4 + wc] = (f32x2v){mw, q};
            }
        asm volatile("s_waitcnt lgkmcnt(0)" ::: "memory"); __builtin_amdgcn_s_barrier(); asm volatile("" ::: "memory");
#if defined(BROKEN_EXCHANGE_NO_WAIT)
#warning BROKEN CONTROL BUILD: the row-statistics exchange does not wait; results are wrong by design
        if (blockIdx.x >= 64) { const long long t0_ = clock64(); while (clock64() - t0_ < 60000) __builtin_amdgcn_s_sleep(8); }
#endif
        const int row = wid * 32 + (lane & 31);
        if (lane < 32) {
            const f32x2v a = P[row * 4 + 0], b = P[row * 4 + 1], c = P[row * 4 + 2], d = P[row * 4 + 3];
            const float mt = (a.x + b.x + c.x + d.x) * 0.25f;
            const float da = a.x - mt, db = b.x - mt, dc = c.x - mt, dd = d.x - mt;
            const float m2 = (a.y + b.y) + (c.y + d.y) + 64.0f * ((da * da + db * db) + (dc * dc + dd * dd));
            unsigned long long* slot = (unsigned long long*)xbuf + ((size_t)(u.pm * BM + row) * 4 + u.pn);
            __hip_atomic_store(slot, ((unsigned long long)__float_as_uint(m2) << 32) | __float_as_uint(mt), __ATOMIC_RELAXED, __HIP_MEMORY_SCOPE_AGENT);
        }
        asm volatile("s_waitcnt vmcnt(0)" ::: "memory");
        if (lane == 0) __hip_atomic_fetch_add(cnt + 64 * u.pm, 1u, __ATOMIC_RELAXED, __HIP_MEMORY_SCOPE_AGENT);
        if (wid == 0) {
            bool dead = false; const unsigned long long t0 = __builtin_amdgcn_s_memrealtime(); const unsigned want = 8u * (unsigned)ntn;
            for (;;) {
#if defined(BROKEN_EXCHANGE_NO_WAIT)
                break;
#endif
                if ((unsigned)__builtin_amdgcn_readfirstlane(__hip_atomic_load(cnt + 64 * u.pm, __ATOMIC_RELAXED, __HIP_MEMORY_SCOPE_AGENT)) >= want) break;
                if (__builtin_amdgcn_s_memrealtime() - t0 > 2000000ull) {
                    if (lane == 0) { unsigned expect = 0u; __hip_atomic_compare_exchange_strong(tmo + 1, &expect, code | (unsigned)(u.pm & 0xff), __ATOMIC_RELAXED, __ATOMIC_RELAXED, __HIP_MEMORY_SCOPE_AGENT);
                                     __hip_atomic_store(tmo, 1u, __ATOMIC_RELAXED, __HIP_MEMORY_SCOPE_AGENT); }
                    dead = true; break; }
                __builtin_amdgcn_s_sleep(2);
            }
            __builtin_amdgcn_fence(__ATOMIC_ACQUIRE, "agent");
            if (lane == 0) flag[0] = dead ? 1u : 0u;
        }
        asm volatile("s_waitcnt vmcnt(0) lgkmcnt(0)" ::: "memory"); __builtin_amdgcn_s_barrier(); asm volatile("" ::: "memory");
        const bool bad = flag[0] != 0u;
        if (lane < 32) {
            const unsigned long long* slot = (const unsigned long long*)xbuf + (size_t)(u.pm * BM + row) * 4; float mt[4], m2[4]; float ms = 0.f;
#pragma unroll
            for (int t = 0; t < 4; ++t) { if (t < ntn) { const unsigned long long w = __hip_atomic_load(slot + t, __ATOMIC_RELAXED, __HIP_MEMORY_SCOPE_AGENT); mt[t] = __uint_as_float((unsigned)w); m2[t] = __uint_as_float((unsigned)(w >> 32)); } else { mt[t] = 0.f; m2[t] = 0.f; } ms += mt[t]; }
            const float mean = ms / (float)ntn; float q = 0.f;
#pragma unroll
            for (int t = 0; t < 4; ++t) if (t < ntn) { const float dm = mt[t] - mean; q += m2[t] + 256.0f * dm * dm; }
            S[row] = (f32x2v){mean, 1.0f / sqrtf(q / (256.0f * (float)ntn) + eps)};
        }
        asm volatile("s_waitcnt lgkmcnt(0)" ::: "memory"); __builtin_amdgcn_s_barrier(); asm volatile("" ::: "memory");
        return bad;
    }
};
struct EpiLnRes {
    static constexpr bool PERM = false, AFTER_DRAIN = true;
    const float* base; float* out; int ldc; const float* bias; PanelStats st; unsigned poison;
    __device__ __forceinline__ void fused(f32x4 (&acc)[2][2][4][2], const Unit& u, int wr, int wc, int fr, int fq, PG8_LAS unsigned char* lds, int wid, int lane) const {
        typedef float f32x2v __attribute__((ext_vector_type(2)));
        const PG8_LAS f32x2v* S = (const PG8_LAS f32x2v*)(lds + 8192);
        const int col0 = u.pn * BM + wc * 32 + 4 * fq;
#pragma unroll
        for (int bj = 0; bj < 2; ++bj)
#pragma unroll
            for (int n = 0; n < 2; ++n) { const f32x4 bv = bias ? *(const f32x4*)(bias + col0 + bj * HALF + n * 16) : (f32x4){0.f, 0.f, 0.f, 0.f};
#pragma unroll
                for (int ai = 0; ai < 2; ++ai)
#pragma unroll
                    for (int m = 0; m < 4; ++m) acc[ai][bj][m][n] += bv; }
        f32x4 pre[4][2][2];
#pragma unroll
        for (int m = 0; m < 4; ++m) { const size_t off = (size_t)(u.pm * BM + wr * 64 + m * 16 + fr) * ldc + col0;
#pragma unroll
            for (int bj = 0; bj < 2; ++bj)
#pragma unroll
                for (int n = 0; n < 2; ++n) pre[m][bj][n] = *(const f32x4*)(base + off + bj * HALF + n * 16); }
        const bool bad = st.run(acc, u, wr, wc, fr, fq, lds, wid, lane) || poison != 0u;
        const float qnan = __builtin_nanf("");
#pragma unroll
        for (int ai = 0; ai < 2; ++ai)
#pragma unroll
            for (int m = 0; m < 4; ++m) { const int r = ai * HALF + wr * 64 + m * 16 + fr; const f32x2v sr = S[r]; const size_t off = (size_t)(u.pm * BM + r) * ldc + col0;
#pragma unroll
                for (int bj = 0; bj < 2; ++bj)
#pragma unroll
                    for (int n = 0; n < 2; ++n) { const f32x4 bs = ai == 0 ? pre[m][bj][n] : *(const f32x4*)(base + off + bj * HALF + n * 16); f32x4 o = bs + (acc[ai][bj][m][n] - sr.x) * sr.y;
                        if (bad) o = (f32x4){qnan, qnan, qnan, qnan}; *(f32x4*)(out + off + bj * HALF + n * 16) = o; }
                if (m & 1) asm volatile("" ::: "memory"); }
    }
};
struct EpiLnResLn {
    static constexpr bool PERM = false, AFTER_DRAIN = true;
    const float* base; float* out; bf16_t* xn; int ldc; const float* bias; PanelStats st1, st2; unsigned poison;
    __device__ __forceinline__ void fused(f32x4 (&acc)[2][2][4][2], const Unit& u, int wr, int wc, int fr, int fq, PG8_LAS unsigned char* lds, int wid, int lane) const {
        typedef float f32x2v __attribute__((ext_vector_type(2))); typedef unsigned u32x2v __attribute__((ext_vector_type(2)));
        const PG8_LAS f32x2v* S = (const PG8_LAS f32x2v*)(lds + 8192);
        const int col0 = u.pn * BM + wc * 32 + 4 * fq;
#pragma unroll
        for (int bj = 0; bj < 2; ++bj)
#pragma unroll
            for (int n = 0; n < 2; ++n) { const f32x4 bv = bias ? *(const f32x4*)(bias + col0 + bj * HALF + n * 16) : (f32x4){0.f, 0.f, 0.f, 0.f};
#pragma unroll
                for (int ai = 0; ai < 2; ++ai)
#pragma unroll
                    for (int m = 0; m < 4; ++m) acc[ai][bj][m][n] += bv; }
        bool bad = st1.run(acc, u, wr, wc, fr, fq, lds, wid, lane) || poison != 0u;
        const float qnan = __builtin_nanf("");
#pragma unroll
        for (int ai = 0; ai < 2; ++ai)
#pragma unroll
            for (int m = 0; m < 4; ++m) { const int r = ai * HALF + wr * 64 + m * 16 + fr; const f32x2v sr = S[r]; const size_t off = (size_t)(u.pm * BM + r) * ldc + col0;
#pragma unroll
                for (int bj = 0; bj < 2; ++bj)
#pragma unroll
                    for (int n = 0; n < 2; ++n) { const f32x4 bs = *(const f32x4*)(base + off + bj * HALF + n * 16); acc[ai][bj][m][n] = bs + (acc[ai][bj][m][n] - sr.x) * sr.y; }
                asm volatile("" : "+v"(acc[ai][0][m][0]), "+v"(acc[ai][0][m][1]), "+v"(acc[ai][1][m][0]), "+v"(acc[ai][1][m][1]));
                if (m & 1) asm volatile("" ::: "memory"); }
        const bool bad1 = bad;
        bad = st2.run(acc, u, wr, wc, fr, fq, lds, wid, lane) || bad;
#pragma unroll
        for (int ai = 0; ai < 2; ++ai)
#pragma unroll
            for (int m = 0; m < 4; ++m) { const int r = ai * HALF + wr * 64 + m * 16 + fr; const f32x2v sr = S[r]; const size_t off = (size_t)(u.pm * BM + r) * ldc + col0;
#pragma unroll
                for (int bj = 0; bj < 2; ++bj)
#pragma unroll
                    for (int n = 0; n < 2; ++n) { const f32x4 x1 = acc[ai][bj][m][n]; *(f32x4*)(out + off + bj * HALF + n * 16) = bad1 ? (f32x4){qnan, qnan, qnan, qnan} : x1;
                        const f32x4 o = (x1 - sr.x) * sr.y; u32x2v w; w.x = cvt_pk_bf16(o[0], o[1]); w.y = cvt_pk_bf16(o[2], o[3]);
                        if (bad) { w.x = 0x7fc07fc0u; w.y = 0x7fc07fc0u; } *(u32x2v*)(xn + off + bj * HALF + n * 16) = w; }
                asm volatile("" ::: "memory"); }
    }
};

template <class Epi, class Sched, bool ALIGN_EPI = false, bool SP2 = false>
__device__ __forceinline__ void gemm_phase(PG8_LAS unsigned char* lds, const Gemm g, const Sched& S, const Epi& E) {
    const int tid = threadIdx.x, wid = __builtin_amdgcn_readfirstlane(tid >> 6), lane = tid & 63, wr = wid >> 2, wc = wid & 3, fr = lane & 15, fq = lane >> 4;
    const int K = g.K, nt = K / BK;
    unsigned voffA[2], voffB[2];
#pragma unroll
    for (int i = 0; i < 2; ++i) { int R, C; stage_rc(tid * 16 + i * 8192, R, C); const int Rb = Epi::PERM ? ((R & ~31) + perm32(R & 31)) : R;
        voffA[i] = (unsigned)(R * K + C) * 2u; voffB[i] = (unsigned)(Rb * K + C) * 2u; }
    const size_t kstep = (size_t)(BK * 2);
    const size_t hstep = (size_t)HALF * K * 2;
    const size_t tstep = 2 * hstep;
    const unsigned ldsw = (unsigned)wid * 1024u;
    const int aoff = lds_byte(wr * 64 + fr, fq * 8), boff = lds_byte(wc * 32 + fr, fq * 8);
#define PG8_SA(b, h) (((b) * 2 + (h)) * HTB)
#define PG8_SB(b, h) ((4 + (b) * 2 + (h)) * HTB)
#define PG8_STAGE(bufoff, gbase, voff) do { _Pragma("unroll") for (int _i = 0; _i < 2; ++_i) \
        __builtin_amdgcn_global_load_lds((const unsigned*)((const char*)(gbase) + (voff)[_i]), (PG8_LAS unsigned*)(lds + (bufoff) + ldsw + _i * 8192), 16, 0, 0); } while (0)
#define PG8_LDA(dst, b, h) do { _Pragma("unroll") for (int m = 0; m < 4; ++m) _Pragma("unroll") for (int k = 0; k < 2; ++k) dst[m][k] = *(const PG8_LAS bf16x8*)(lds + PG8_SA(b, h) + aoff + m * 2048 + k * 1024); } while (0)
#define PG8_LDB(dst, b, h) do { _Pragma("unroll") for (int n = 0; n < 2; ++n) _Pragma("unroll") for (int k = 0; k < 2; ++k) dst[n][k] = *(const PG8_LAS bf16x8*)(lds + PG8_SB(b, h) + boff + n * 2048 + k * 1024); } while (0)
#define PG8_MMA(ai, bj, At, Bt) do { __builtin_amdgcn_s_setprio(1); _Pragma("unroll") for (int m = 0; m < 4; ++m) _Pragma("unroll") for (int n = 0; n < 2; ++n) _Pragma("unroll") for (int k = 0; k < 2; ++k) \
        acc[ai][bj][m][n] = __builtin_amdgcn_mfma_f32_16x16x32_bf16(Bt[n][k], At[m][k], acc[ai][bj][m][n], 0, 0, 0); __builtin_amdgcn_s_setprio(0); } while (0)
#define PG8_WAIT_V(n) asm volatile("s_waitcnt vmcnt(" #n ")" ::: "memory")
#define PG8_WAIT_L(n) asm volatile("s_waitcnt lgkmcnt(" #n ")" ::: "memory")
#define PG8_BAR __builtin_amdgcn_s_barrier()
#define PG8_SCHED __builtin_amdgcn_sched_barrier(0)
    Unit cur, nxt; int ui = 0;
    if (!S.next(0, cur)) return;
    f32x4 acc[2][2][4][2];
#pragma unroll
    for (int a = 0; a < 2; ++a)
#pragma unroll
        for (int b = 0; b < 2; ++b)
#pragma unroll
            for (int m = 0; m < 4; ++m)
#pragma unroll
                for (int n = 0; n < 2; ++n) acc[a][b][m][n] = (f32x4){0.f, 0.f, 0.f, 0.f};
    bf16x8 At[4][2], B0[2][2], B1[2][2];
    const char* cA = (const char*)g.A + (size_t)cur.pm * tstep; const char* cB = (const char*)g.Bt + (size_t)cur.pn * tstep;
    S.a_ready(cur);
    if constexpr (SP2) {
        PG8_STAGE(PG8_SB(0, 0), cB, voffB); PG8_STAGE(PG8_SB(0, 1), cB + hstep, voffB); PG8_STAGE(PG8_SA(0, 0), cA, voffA); PG8_STAGE(PG8_SA(0, 1), cA + hstep, voffA);
        if (wr == 1) PG8_BAR;
        PG8_WAIT_V(2); PG8_BAR;
        PG8_STAGE(PG8_SB(1, 0), cB + kstep, voffB); PG8_STAGE(PG8_SA(1, 0), cA + kstep, voffA); PG8_STAGE(PG8_SB(1, 1), cB + hstep + kstep, voffB);
        PG8_WAIT_V(6); PG8_BAR;
    } else {
        PG8_STAGE(PG8_SB(0, 0), cB, voffB); PG8_STAGE(PG8_SA(0, 0), cA, voffA); PG8_STAGE(PG8_SB(0, 1), cB + hstep, voffB); PG8_STAGE(PG8_SA(0, 1), cA + hstep, voffA);
        if (wr == 1) PG8_BAR;
        PG8_WAIT_V(4); PG8_BAR;
        PG8_STAGE(PG8_SB(1, 0), cB + kstep, voffB); PG8_STAGE(PG8_SA(1, 0), cA + kstep, voffA); PG8_STAGE(PG8_SB(1, 1), cB + hstep + kstep, voffB);
        PG8_WAIT_V(6); PG8_BAR;
    }
    for (;;) {
        const bool has_next = S.next(ui + 1, nxt);
        const char* nA = has_next ? (const char*)g.A + (size_t)nxt.pm * tstep : cA; const char* nB = has_next ? (const char*)g.Bt + (size_t)nxt.pn * tstep : cB;
        for (int t = 0; t < nt; t += 2) {
            const bool last = (t == nt - 2);
            const char* a1 = cA + (size_t)(t + 1) * kstep;
            const char* a2 = last ? nA : cA + (size_t)(t + 2) * kstep; const char* b2 = last ? nB : cB + (size_t)(t + 2) * kstep;
            const char* a3 = a2 + kstep; const char* b3 = b2 + kstep;
            if (last && has_next) S.a_ready(nxt);
            if constexpr (SP2) {
            PG8_LDB(B0, 0, 0); PG8_LDB(B1, 0, 1); PG8_SCHED; PG8_LDA(At, 0, 0); PG8_STAGE(PG8_SA(1, 1), a1 + hstep, voffA);
            PG8_WAIT_V(8); PG8_WAIT_L(0); PG8_BAR; PG8_MMA(0, 0, At, B0); PG8_MMA(0, 1, At, B1); PG8_BAR; PG8_SCHED;
            PG8_LDA(At, 0, 1); PG8_STAGE(PG8_SB(0, 0), b2, voffB); PG8_STAGE(PG8_SB(0, 1), b2 + hstep, voffB); PG8_STAGE(PG8_SA(0, 0), a2, voffA);
            PG8_WAIT_V(8); PG8_WAIT_L(0); PG8_BAR; PG8_MMA(1, 0, At, B0); PG8_MMA(1, 1, At, B1); PG8_BAR; PG8_SCHED;
            PG8_LDB(B0, 1, 0); PG8_LDB(B1, 1, 1); PG8_SCHED; PG8_LDA(At, 1, 0); PG8_STAGE(PG8_SA(0, 1), a2 + hstep, voffA);
            PG8_WAIT_V(8); PG8_WAIT_L(0); PG8_BAR; PG8_MMA(0, 0, At, B0); PG8_MMA(0, 1, At, B1); PG8_BAR; PG8_SCHED;
            PG8_LDA(At, 1, 1); PG8_STAGE(PG8_SB(1, 0), b3, voffB); PG8_STAGE(PG8_SB(1, 1), b3 + hstep, voffB); PG8_STAGE(PG8_SA(1, 0), a3, voffA);
            PG8_WAIT_V(8); PG8_WAIT_L(0); PG8_BAR; PG8_MMA(1, 0, At, B0); PG8_MMA(1, 1, At, B1); PG8_BAR; PG8_SCHED;
            } else {
            PG8_LDB(B0, 0, 0); PG8_SCHED; PG8_LDA(At, 0, 0); PG8_STAGE(PG8_SA(1, 1), a1 + hstep, voffA);
            PG8_WAIT_L(8); PG8_BAR; PG8_WAIT_L(0); PG8_MMA(0, 0, At, B0); PG8_BAR; PG8_SCHED;
            PG8_LDB(B1, 0, 1); PG8_STAGE(PG8_SB(0, 0), b2, voffB);
            PG8_BAR; PG8_WAIT_L(0); PG8_MMA(0, 1, At, B1); PG8_BAR;
            PG8_LDA(At, 0, 1); PG8_STAGE(PG8_SA(0, 0), a2, voffA);
            PG8_BAR; PG8_WAIT_L(0); PG8_MMA(1, 0, At, B0); PG8_BAR; PG8_SCHED;
            PG8_STAGE(PG8_SB(0, 1), b2 + hstep, voffB);
            PG8_WAIT_V(6); PG8_BAR; PG8_MMA(1, 1, At, B1); PG8_BAR;
            PG8_LDB(B0, 1, 0); PG8_SCHED; PG8_LDA(At, 1, 0); PG8_STAGE(PG8_SA(0, 1), a2 + hstep, voffA);
            PG8_WAIT_L(8); PG8_BAR; PG8_WAIT_L(0); PG8_MMA(0, 0, At, B0); PG8_BAR; PG8_SCHED;
            PG8_LDB(B1, 1, 1); PG8_STAGE(PG8_SB(1, 0), b3, voffB);
            PG8_BAR; PG8_WAIT_L(0); PG8_MMA(0, 1, At, B1); PG8_BAR;
            PG8_LDA(At, 1, 1); PG8_STAGE(PG8_SA(1, 0), a3, voffA);
            PG8_BAR; PG8_WAIT_L(0); PG8_MMA(1, 0, At, B0); PG8_BAR; PG8_SCHED;
            PG8_STAGE(PG8_SB(1, 1), b3 + hstep, voffB);
            PG8_WAIT_V(6); PG8_BAR; PG8_MMA(1, 1, At, B1); PG8_BAR;
            }
        }
        if constexpr (ALIGN_EPI) { if (wr == 0) PG8_BAR; }
        if constexpr (!Epi::AFTER_DRAIN) { E(acc, cur, wr, wc, fr, fq); S.done(cur); }
        if (!has_next) break;
#pragma unroll
        for (int a = 0; a < 2; ++a)
#pragma unroll
            for (int b = 0; b < 2; ++b)
#pragma unroll
                for (int m = 0; m < 4; ++m)
#pragma unroll
                    for (int n = 0; n < 2; ++n) acc[a][b][m][n] = (f32x4){0.f, 0.f, 0.f, 0.f};
        cur = nxt; cA = nA; cB = nB; ++ui;
        if constexpr (ALIGN_EPI) { if (wr == 1) PG8_BAR; }
    }
    PG8_WAIT_V(0);
    if constexpr (!ALIGN_EPI) { if (wr == 0) PG8_BAR; }
    PG8_BAR;
    if constexpr (Epi::AFTER_DRAIN) { E.fused(acc, cur, wr, wc, fr, fq, lds, wid, lane); S.done(cur); }
#undef PG8_SA
#undef PG8_SB
#undef PG8_STAGE
#undef PG8_LDA
#undef PG8_LDB
#undef PG8_MMA
#undef PG8_WAIT_V
#undef PG8_WAIT_L
#undef PG8_BAR
#undef PG8_SCHED
}
}
#ifndef PG8_SP2
#define PG8_SP2 true
#endif
#ifndef PG8_ALIGN
#define PG8_ALIGN true
#endif
#include <cmath>
constexpr int NWAVES = 8;
#ifndef MK_N_LAUNCHES
#define MK_N_LAUNCHES 1
#endif
constexpr int PER_PHASE = 12;
constexpr int N_LAUNCHES = MK_N_LAUNCHES;

constexpr int BATCH = 8, SEQ = 2048, DM = 2048, TOK = BATCH * SEQ, MEMLEN = 256;
constexpr int NPROJ = 6144, NPROJ_PAD = 6400, WIN_COLS = 6160;
constexpr int C_QM = 0, C_KM = 1024, C_VM = 2048, C_QG = 3072, C_KG = 3584, C_VG = 4096, C_RG = 5120;
constexpr float DN_ALPHA = 1.189207115002721f;
constexpr float LN_EPS = 1e-5f, RMS_EPS = 1e-6f;

constexpr size_t MiB = 1u << 20;
constexpr size_t WS_CTL = 0, CTL_ZERO_BYTES = 1 * MiB;
constexpr size_t WS_SUBK = 1 * MiB, WS_KMEAN = 1 * MiB + 512 * 1024;
constexpr size_t WS_WOUT = 2 * MiB, WS_WQ = 10 * MiB, WS_WO = 18 * MiB, WS_WPQ = 26 * MiB;
constexpr size_t WS_KV = 34 * MiB, WS_GATE = 50 * MiB;
constexpr size_t WS_PROJ = 52 * MiB, WS_HB = 52 * MiB, WS_Q = 116 * MiB, WS_XO = 180 * MiB, WS_PU = 180 * MiB;
constexpr size_t WS_ATT = 244 * MiB, WS_PV = 244 * MiB;
constexpr size_t WS_PU8 = 180 * MiB, WS_PV8 = 212 * MiB, WS_SU = 1 * MiB + 512 * 1024, WS_SV = 1 * MiB + 512 * 1024 + 65536;
constexpr size_t WS_Z = 308 * MiB, WS_XB = 308 * MiB, WS_WIN = 372 * MiB, WS_WKV = 397 * MiB, WS_MEMB = 413 * MiB;
constexpr size_t WS_END = 436 * MiB;
constexpr int CW_BAR = 4096, CW_CHK = 8192, CW_Q = 8256;
#ifndef CHECK_GLA
#define CHECK_GLA 0
#endif
#ifndef CHECK_MOBA
#define CHECK_MOBA 0
#endif
#ifndef CHECK_XATT
#define CHECK_XATT 0
#endif
#ifndef PROBE_PEER2
#define PROBE_PEER2 0
#endif
#ifndef PROBE_MIX2
#define PROBE_MIX2 0
#endif
#define CHECK_ANY (CHECK_GLA || CHECK_MOBA || CHECK_XATT)

constexpr int RING_OFF = 0, RING_BYTES = 131072;
constexpr int LDSCTL_OFF = RING_BYTES, MISC_OFF = LDSCTL_OFF + 320;
constexpr int LDS_BYTES = 147456;
#define GAS __attribute__((address_space(1)))
#define LAS __attribute__((address_space(3)))
typedef unsigned short bf16;
typedef unsigned v4u __attribute__((ext_vector_type(4)));
typedef float f32x4 __attribute__((ext_vector_type(4)));
typedef short bf16x8 __attribute__((ext_vector_type(8)));
typedef GAS unsigned gu32;
typedef GAS unsigned long long gu64;
#define RLX_AGENT __ATOMIC_RELAXED, __HIP_MEMORY_SCOPE_AGENT
#define LDS_WAIT() asm volatile("s_waitcnt lgkmcnt(0)" ::: "memory")
#define VM_WAIT() asm volatile("s_waitcnt vmcnt(0)" ::: "memory")
__device__ __forceinline__ unsigned long long rt() { return __builtin_amdgcn_s_memrealtime(); }
__device__ __forceinline__ unsigned f2bf(float f) { unsigned u = __builtin_bit_cast(unsigned, f); return (u + 0x7fffu + ((u >> 16) & 1u)) >> 16; }
__device__ __forceinline__ unsigned pk2(float lo, float hi) { return f2bf(lo) | (f2bf(hi) << 16); }

#define XB_TMO      128
#define XB_XCNT(j)  (256  + 64 * (j))
#define XB_XSUB(j)  (1280 + 64 * (j))
#define XB_XGEN(j)  (2304 + 64 * (j))
#define XB_TOP      3328
#define XB_TOPGEN   3392
#define XCD_BAR_WORDS 3456
#define XB_SPIN_CAP (1u << 18)

__device__ __forceinline__ unsigned xb_ld(unsigned* p)              { return __hip_atomic_load(p, __ATOMIC_RELAXED, __HIP_MEMORY_SCOPE_AGENT); }
__device__ __forceinline__ unsigned xb_add(unsigned* p, unsigned v) { return __hip_atomic_fetch_add(p, v, __ATOMIC_RELAXED, __HIP_MEMORY_SCOPE_AGENT); }
__device__ __forceinline__ unsigned xb_xcc_id() { return (unsigned)__builtin_amdgcn_s_getreg((3 << 11) | 20) & 0xFu; }
#define XB_SPIN(cond, bar) do { unsigned _sp = 0; while (cond) { __builtin_amdgcn_s_sleep(1); \
    if ((++_sp & 255u) == 0u) { if (xb_ld(&(bar)[XB_TMO])) break; if (_sp > XB_SPIN_CAP) { atomicAdd(&(bar)[XB_TMO], 1u); break; } } } } while (0)

struct XcdBarrier {
    unsigned* bar; unsigned x;
    volatile LAS unsigned* st;
};

__device__ __forceinline__ XcdBarrier xcd_barrier_post(unsigned* bar, volatile LAS unsigned* st) {
    XcdBarrier b; b.bar = bar; b.x = xb_xcc_id(); b.st = st;
    if (threadIdx.x == 0) (void)xb_add(&bar[XB_XCNT(b.x)], 1u);
    return b;
}
__device__ __forceinline__ void xcd_barrier_complete(unsigned* bar, unsigned x, unsigned& nloc, unsigned& nx) {
    const unsigned G = gridDim.x * gridDim.y * gridDim.z;
    unsigned sum, cnt, mine, sp = 0u;
    for (;;) {
        sum = 0u; cnt = 0u; mine = 0u;
#pragma unroll
        for (unsigned j = 0; j < 16; ++j) { const unsigned c = xb_ld(&bar[XB_XCNT(j)]); sum += c; cnt += (c > 0u) ? 1u : 0u; mine = (j == x) ? c : mine; }
        if (sum == G) break;
        __builtin_amdgcn_s_sleep(1);
        if ((++sp & 255u) == 0u) { if (xb_ld(&bar[XB_TMO])) break; if (sp > XB_SPIN_CAP) { atomicAdd(&bar[XB_TMO], 1u); break; } }
    }
    nloc = mine > 0u ? mine : 1u; nx = cnt > 0u ? cnt : 1u;
}

__device__ __forceinline__ void xcd_barrier(const XcdBarrier& b) {
    asm volatile("s_waitcnt vmcnt(0)" ::: "memory");
    __syncthreads();
    if (threadIdx.x == 0) {
        unsigned* bar = b.bar;
        __builtin_amdgcn_s_waitcnt(0);
        unsigned nloc = b.st[0], nx = b.st[1];
        if (nloc == 0u) { xcd_barrier_complete(bar, b.x, nloc, nx); b.st[0] = nloc; b.st[1] = nx; }
        const unsigned old = xb_add(&bar[XB_XSUB(b.x)], 1u);
        const unsigned gen = old / nloc;
        if (old + 1u == (gen + 1u) * nloc) {
            __builtin_amdgcn_fence(__ATOMIC_RELEASE, "agent");
            asm volatile("s_waitcnt vmcnt(0)" ::: "memory");
            const unsigned og = xb_add(&bar[XB_TOP], 1u);
            const unsigned tg = og / nx;
            if (og + 1u == (tg + 1u) * nx) xb_add(&bar[XB_TOPGEN], 1u);
            else XB_SPIN(xb_ld(&bar[XB_TOPGEN]) == tg, bar);
            __builtin_amdgcn_fence(__ATOMIC_ACQUIRE, "agent");
            xb_add(&bar[XB_XGEN(b.x)], 1u);
            asm volatile("s_waitcnt vmcnt(0)" ::: "memory");
        } else {
            XB_SPIN(xb_ld(&bar[XB_XGEN(b.x)]) == gen, bar);
            __builtin_amdgcn_fence(__ATOMIC_ACQUIRE, "agent");
            asm volatile("s_waitcnt vmcnt(0)" ::: "memory");
        }
    }
    __syncthreads();
}
struct Frame {
    LAS unsigned char* lds;
    volatile LAS unsigned* MISC;
    gu32* ctl;
    int tid, lane, wave;
    int vcu, G;
    const float* in[20]; float* out; unsigned char* ws;
};
__device__ __forceinline__ float bf2f(unsigned short h) { return __uint_as_float(((unsigned)h) << 16); }
__device__ __forceinline__ float wave_sum(float v) {
#pragma unroll
    for (int o = 1; o < 64; o <<= 1) v += __shfl_xor(v, o);
    return v;
}
__device__ __forceinline__ float wave_max(float v) {
#pragma unroll
    for (int o = 1; o < 64; o <<= 1) v = fmaxf(v, __shfl_xor(v, o));
    return v;
}
typedef unsigned short us8 __attribute__((ext_vector_type(8)));

__device__ __forceinline__ void p0_transpose_item(const float* W, int K, int N, int Npad, bf16* WT, LAS float* scr, int item, int lane) {
    const int nblk = Npad / 32, kb = item / nblk, nb = item % nblk, k0 = 64 * kb, n0 = 32 * nb;
    const int nn = n0 + (lane & 31); const bool ok = nn < N;
#pragma unroll 8
    for (int i = 0; i < 32; ++i) { const int kk = 2 * i + (lane >> 5); scr[kk * 33 + (lane & 31)] = ok ? W[(size_t)(k0 + kk) * N + nn] : 0.f; }
    LDS_WAIT(); asm volatile("" ::: "memory");
    const int c = lane & 7;
#pragma unroll
    for (int j = 0; j < 4; ++j) { const int n = (lane >> 3) + 8 * j; const LAS float* s = scr + (8 * c) * 33 + n;
        v4u o; o.x = pk2(s[0 * 33], s[1 * 33]); o.y = pk2(s[2 * 33], s[3 * 33]); o.z = pk2(s[4 * 33], s[5 * 33]); o.w = pk2(s[6 * 33], s[7 * 33]);
        *(GAS v4u*)(WT + (size_t)(n0 + n) * K + k0 + 8 * c) = o; }
    LDS_WAIT(); asm volatile("" ::: "memory");
}
__device__ __forceinline__ void cvt_linear(Frame& F, const float* src, bf16* dst, size_t n8) {
    const size_t nth = (size_t)F.G * NWAVES * 64;
    for (size_t i = (size_t)F.vcu * NWAVES * 64 + F.tid; i < n8; i += nth) {
        const f32x4 a = *(const GAS f32x4*)(src + i * 8), b = *(const GAS f32x4*)(src + i * 8 + 4);
        v4u o; o.x = pk2(a.x, a.y); o.y = pk2(a.z, a.w); o.z = pk2(b.x, b.y); o.w = pk2(b.z, b.w);
        *(GAS v4u*)(dst + i * 8) = o;
    }
}
__device__ __forceinline__ void p0_prologue(Frame& F) {
    LAS float* scr = (LAS float*)(F.lds + RING_OFF + F.wave * 16384);
    const int gw = F.vcu * NWAVES + F.wave, NGW = F.G * NWAVES;
    constexpr int I_IN = (DM / 64) * (NPROJ_PAD / 32), I_SQ = (DM / 64) * (DM / 32), I_KV = (DM / 64) * (2 * DM / 32);
    constexpr int NITEMS = I_IN + 4 * I_SQ + I_KV;
    unsigned char* ws = F.ws;
    for (int it = gw; it < NITEMS; it += NGW) {
        int r = it;
        if (r < I_IN) { p0_transpose_item(F.in[2], DM, WIN_COLS, NPROJ_PAD, (bf16*)(ws + WS_WIN), scr, r, F.lane); continue; } r -= I_IN;
        if (r < I_KV) { p0_transpose_item(F.in[10], DM, 2 * DM, 2 * DM, (bf16*)(ws + WS_WKV), scr, r, F.lane); continue; } r -= I_KV;
        if (r < I_SQ) { p0_transpose_item(F.in[6], DM, DM, DM, (bf16*)(ws + WS_WOUT), scr, r, F.lane); continue; } r -= I_SQ;
        if (r < I_SQ) { p0_transpose_item(F.in[9], DM, DM, DM, (bf16*)(ws + WS_WQ), scr, r, F.lane); continue; } r -= I_SQ;
        if (r < I_SQ) { p0_transpose_item(F.in[11], DM, DM, DM, (bf16*)(ws + WS_WO), scr, r, F.lane); continue; } r -= I_SQ;
        p0_transpose_item(F.in[14], DM, DM, DM, (bf16*)(ws + WS_WPQ), scr, r, F.lane);
    }
    cvt_linear(F, F.in[0], (bf16*)(ws + WS_XB), (size_t)TOK * DM / 8);
    cvt_linear(F, F.in[1], (bf16*)(ws + WS_MEMB), (size_t)BATCH * MEMLEN * DM / 8);
    cvt_linear(F, F.in[15], (bf16*)(ws + WS_SUBK), (size_t)16 * 128 * 128 / 8);
}

struct EpiProj {
    static constexpr bool PERM = true, AFTER_DRAIN = false;
    pg8::bf16_t* O; float* gate;
    __device__ __forceinline__ void operator()(const pg8::f32x4 (&acc)[2][2][4][2], const pg8::Unit& u, int wr, int wc, int fr, int fq) const {
        const int row0 = u.pm * 256 + wr * 64 + fr;
        if (u.pn < 24) {
            const int col0 = u.pn * 256 + wc * 32 + 8 * fq;
#pragma unroll
            for (int ai = 0; ai < 2; ++ai)
#pragma unroll
                for (int m = 0; m < 4; ++m) { pg8::bf16_t* rowp = O + (size_t)(row0 + ai * 128 + m * 16) * NPROJ + col0;
#pragma unroll
                    for (int bj = 0; bj < 2; ++bj) { const pg8::f32x4 v0 = acc[ai][bj][m][0], v1 = acc[ai][bj][m][1];
                        pg8::u32x4 w; w.x = pg8::cvt_pk_bf16(v0[0], v0[1]); w.y = pg8::cvt_pk_bf16(v0[2], v0[3]); w.z = pg8::cvt_pk_bf16(v1[0], v1[1]); w.w = pg8::cvt_pk_bf16(v1[2], v1[3]);
                        *(pg8::u32x4*)(rowp + bj * 128) = w; } }
        } else if (wc == 0 && fq < 2) {
#pragma unroll
            for (int ai = 0; ai < 2; ++ai)
#pragma unroll
                for (int m = 0; m < 4; ++m) { float* gp = gate + (size_t)(row0 + ai * 128 + m * 16) * 16 + 8 * fq;
                    *(pg8::f32x4*)(gp) = acc[ai][0][m][0]; *(pg8::f32x4*)(gp + 4) = acc[ai][0][m][1]; }
        }
    }
};
struct EpiRes {
    static constexpr bool PERM = false, AFTER_DRAIN = false;
    const float* base; float* out; float alpha;
    __device__ __forceinline__ void operator()(const pg8::f32x4 (&acc)[2][2][4][2], const pg8::Unit& u, int wr, int wc, int fr, int fq) const {
        const int row0 = u.pm * 256 + wr * 64 + fr, col0 = u.pn * 256 + wc * 32 + 4 * fq;
#pragma unroll
        for (int ai = 0; ai < 2; ++ai)
#pragma unroll
            for (int m = 0; m < 4; ++m) { const size_t off = (size_t)(row0 + ai * 128 + m * 16) * DM + col0;
#pragma unroll
                for (int bj = 0; bj < 2; ++bj)
#pragma unroll
                    for (int n = 0; n < 2; ++n) { const pg8::f32x4 b = *(const pg8::f32x4*)(base + off + bj * 128 + n * 16);
                        *(pg8::f32x4*)(out + off + bj * 128 + n * 16) = b * alpha + acc[ai][bj][m][n]; } }
    }
};

__device__ __forceinline__ void kmean_phase(Frame& F) {
    const bf16* PROJ = (const bf16*)(F.ws + WS_PROJ); float* KMEAN = (float*)(F.ws + WS_KMEAN);
    const int gw = F.vcu * NWAVES + F.wave, NGW = F.G * NWAVES;
    for (int it = gw; it < BATCH * 8 * 16; it += NGW) {
        const int b = it >> 7, blk = (it >> 4) & 7, cc = it & 15;
        const bf16* p = PROJ + (size_t)(b * SEQ + blk * 256) * NPROJ + C_KM + cc * 64 + F.lane;
        float s = 0.f;
#pragma unroll 8
        for (int r = 0; r < 256; ++r) s += bf2f(p[(size_t)r * NPROJ]);
        KMEAN[(size_t)(b * 8 + blk) * 1024 + cc * 64 + F.lane] = s * (1.f / 256.f);
    }
}

template <int HD, int KC, int MODE>
__device__ __forceinline__ void naive_attn_unit(Frame& F, int unit) {
    constexpr int DPT = HD / 8, PIECES = KC * HD / 8;
    LAS bf16* Kc = (LAS bf16*)(F.lds + RING_OFF); LAS bf16* Vc = Kc + KC * HD;
    const int tid = F.tid, qi = tid >> 3, sub = tid & 7;
    int b, h, qt; const bf16 *Qp, *Kp, *Vp; bf16* Op; int ldq, ldk, ldo, nchunks, qb = 0, qpos = 0; float scale;
    if (MODE == 0) {
        b = unit >> 8; h = (unit >> 5) & 7; qt = unit & 31; qb = qt >> 2; qpos = qt * 64 + qi;
        const bf16* PROJ = (const bf16*)(F.ws + WS_PROJ);
        Qp = PROJ + (size_t)(b * SEQ + qt * 64 + qi) * NPROJ + C_QM + h * 128; ldq = NPROJ;
        Kp = PROJ + (size_t)(b * SEQ) * NPROJ + C_KM + h * 128; Vp = PROJ + (size_t)(b * SEQ) * NPROJ + C_VM + h * 128; ldk = NPROJ;
        Op = (bf16*)(F.ws + WS_ATT) + (size_t)(b * SEQ + qt * 64 + qi) * DM + h * 128; ldo = DM;
        nchunks = 4 * (qb + 1); scale = 0.08838834764831845f;
    } else {
        b = unit >> 7; h = (unit >> 5) & 3; qt = unit & 31;
        Qp = (const bf16*)(F.ws + WS_Q) + (size_t)(b * SEQ + qt * 64 + qi) * DM + h * 512; ldq = DM;
        const bf16* KV = (const bf16*)(F.ws + WS_KV);
        Kp = KV + (size_t)(b * MEMLEN) * (2 * DM) + h * 512; Vp = Kp + DM; ldk = 2 * DM;
        Op = (bf16*)(F.ws + WS_XO) + (size_t)(b * SEQ + qt * 64 + qi) * DM + h * 512; ldo = DM;
        nchunks = MEMLEN / KC; scale = 0.04419417382415922f;
    }
    (void)ldq; (void)ldo;
    float qv[DPT], o[DPT];
#pragma unroll
    for (int j = 0; j < DPT; j += 8) { const us8 w = *(const GAS us8*)(Qp + sub * DPT + j);
#pragma unroll
        for (int e = 0; e < 8; ++e) { qv[j + e] = bf2f(w[e]) * scale; o[j + e] = 0.f; } }
    unsigned sel = 0;
    if (MODE == 0) {
        const float* KM = (const float*)(F.ws + WS_KMEAN) + (size_t)(b * 8) * 1024 + h * 128 + sub * DPT;
        float g[8];
#pragma unroll
        for (int n = 0; n < 8; ++n) { float s = 0.f;
            if (n < qb) {
#pragma unroll
                for (int j = 0; j < DPT; ++j) s += qv[j] * KM[(size_t)n * 1024 + j]; }
            s += __shfl_xor(s, 1); s += __shfl_xor(s, 2); s += __shfl_xor(s, 4); g[n] = s; }
#pragma unroll
        for (int n = 0; n < 8; ++n) { int cnt = 0;
#pragma unroll
            for (int m = 0; m < 8; ++m) if (m != n && m < qb && (g[m] > g[n] || (g[m] == g[n] && m < n))) ++cnt;
            if (n < qb && cnt < 3) sel |= 1u << n; }
    }
    float mrun = -1e30f, lrun = 0.f;
    for (int c = 0; c < nchunks; ++c) {
        int key0; if (MODE == 0) key0 = (c < 4) ? qb * 256 + 64 * c : (c - 4) * 64; else key0 = c * KC;
        __syncthreads();
#pragma unroll
        for (int p = tid; p < PIECES; p += NWAVES * 64) { const int row = p / (HD / 8), c8 = p % (HD / 8);
            *(LAS v4u*)(Kc + row * HD + c8 * 8) = *(const GAS v4u*)(Kp + (size_t)(key0 + row) * ldk + c8 * 8);
            *(LAS v4u*)(Vc + row * HD + c8 * 8) = *(const GAS v4u*)(Vp + (size_t)(key0 + row) * ldk + c8 * 8); }
        __syncthreads();
        const bool blk_ok = (MODE == 1) || (c < 4) || ((sel >> ((c - 4) >> 2)) & 1u);
        for (int kk = 0; kk < KC; ++kk) {
            const LAS bf16* kr = Kc + kk * HD + sub * DPT; float part = 0.f;
#pragma unroll
            for (int j = 0; j < DPT; j += 8) { const us8 w = *(const LAS us8*)(kr + j);
#pragma unroll
                for (int e = 0; e < 8; ++e) part += qv[j + e] * bf2f(w[e]); }
            part += __shfl_xor(part, 1); part += __shfl_xor(part, 2); part += __shfl_xor(part, 4);
            bool ok = blk_ok; if (MODE == 0 && c < 4) ok = (key0 + kk) <= qpos;
            if (ok) {
                const float mn = fmaxf(mrun, part), al = __expf(mrun - mn), pp = __expf(part - mn);
                lrun = lrun * al + pp; mrun = mn;
                const LAS bf16* vr = Vc + kk * HD + sub * DPT;
#pragma unroll
                for (int j = 0; j < DPT; j += 8) { const us8 w = *(const LAS us8*)(vr + j);
#pragma unroll
                    for (int e = 0; e < 8; ++e) o[j + e] = o[j + e] * al + pp * bf2f(w[e]); }
            }
        }
    }
    const float inv = 1.f / lrun;
#pragma unroll
    for (int j = 0; j < DPT; j += 8) { v4u w; w.x = pk2(o[j] * inv, o[j + 1] * inv); w.y = pk2(o[j + 2] * inv, o[j + 3] * inv); w.z = pk2(o[j + 4] * inv, o[j + 5] * inv); w.w = pk2(o[j + 6] * inv, o[j + 7] * inv);
        *(GAS v4u*)(Op + sub * DPT + j) = w; }
}

__device__ __forceinline__ void naive_gla_unit(Frame& F, int unit) {
    const int b = unit >> 2, h = unit & 3, tid = F.tid, e = tid & 255, dh = tid >> 8;
    LAS float* GU = (LAS float*)(F.lds + RING_OFF);
    LAS float* GL = GU + 16 * 128;
    LAS float* As = GL + 32 * 16;
    LAS float* Ks = As + 32 * 128; LAS float* Qs = Ks + 32 * 128;
    LAS float* Op = Qs + 32 * 128;
    const bf16* PROJ = (const bf16*)(F.ws + WS_PROJ); const float* GATE = (const float*)(F.ws + WS_GATE);
    const float* gup = F.in[3]; const float* gbias = F.in[4]; const float* gnorm = F.in[5];
    bf16* ATT = (bf16*)(F.ws + WS_ATT);
    __syncthreads();
    for (int i = tid; i < 16 * 128; i += NWAVES * 64) GU[i] = gup[(size_t)(i >> 7) * 512 + h * 128 + (i & 127)];
    float st[64];
#pragma unroll
    for (int j = 0; j < 64; ++j) st[j] = 0.f;
    for (int ch = 0; ch < SEQ / 32; ++ch) {
        const size_t row0 = (size_t)b * SEQ + ch * 32;
        __syncthreads();
        GL[tid] = GATE[row0 * 16 + tid];
        __syncthreads();
        { const int tt = tid >> 4, dg = tid & 15;
          const us8 qw = *(const GAS us8*)(PROJ + (row0 + tt) * NPROJ + C_QG + h * 128 + dg * 8);
          const us8 kw = *(const GAS us8*)(PROJ + (row0 + tt) * NPROJ + C_KG + h * 128 + dg * 8);
#pragma unroll
          for (int j = 0; j < 8; ++j) { const int d = dg * 8 + j; float z = gbias[h * 128 + d];
#pragma unroll
              for (int r = 0; r < 16; ++r) z += GL[tt * 16 + r] * GU[r * 128 + d];
              const float ls = fminf(z, 0.f) - log1pf(__expf(-fabsf(z)));
              As[tt * 128 + d] = __expf(ls * (1.f / 16.f)); Ks[tt * 128 + d] = bf2f(kw[j]); Qs[tt * 128 + d] = bf2f(qw[j]) * 0.08838834764831845f; } }
        __syncthreads();
        for (int tt = 0; tt < 32; ++tt) {
            const float v = bf2f(PROJ[(row0 + tt) * NPROJ + C_VG + h * 256 + e]); float op = 0.f;
            const LAS float* ar = As + tt * 128 + dh * 64; const LAS float* kr = Ks + tt * 128 + dh * 64; const LAS float* qr = Qs + tt * 128 + dh * 64;
#pragma unroll
            for (int j = 0; j < 64; ++j) { st[j] = ar[j] * st[j] + kr[j] * v; op += qr[j] * st[j]; }
            Op[(dh * 32 + tt) * 256 + e] = op;
        }
        __syncthreads();
#pragma unroll
        for (int ti = 0; ti < 4; ++ti) { const int tt = F.wave * 4 + ti; float val[4], ss = 0.f;
#pragma unroll
            for (int i = 0; i < 4; ++i) { const int ee = F.lane + 64 * i; val[i] = Op[tt * 256 + ee] + Op[(32 + tt) * 256 + ee]; ss += val[i] * val[i]; }
            ss = wave_sum(ss); const float rs = 1.f / sqrtf(ss * (1.f / 256.f) + RMS_EPS);
#pragma unroll
            for (int i = 0; i < 4; ++i) { const int ee = F.lane + 64 * i; const float r = bf2f(PROJ[(row0 + tt) * NPROJ + C_RG + h * 256 + ee]);
                const float y = val[i] * rs * gnorm[ee] * (r / (1.f + __expf(-r)));
                ATT[(row0 + tt) * DM + 1024 + h * 256 + ee] = (bf16)f2bf(y); } }
    }
}

__device__ __forceinline__ void ln_phase(Frame& F, const float* g, const float* bb) {
    float* Z = (float*)(F.ws + WS_Z); bf16* HB = (bf16*)(F.ws + WS_HB);
    const int gw = F.vcu * NWAVES + F.wave, NGW = F.G * NWAVES;
    for (int m = gw; m < TOK; m += NGW) {
        GAS f32x4* zr = (GAS f32x4*)(Z + (size_t)m * DM) + F.lane;
        f32x4 v[8]; float s = 0.f;
#pragma unroll
        for (int j = 0; j < 8; ++j) { v[j] = zr[64 * j]; s += (v[j].x + v[j].y) + (v[j].z + v[j].w); }
        const float mean = wave_sum(s) * (1.f / DM); float s2 = 0.f;
#pragma unroll
        for (int j = 0; j < 8; ++j) { v[j] = v[j] - mean; s2 += (v[j].x * v[j].x + v[j].y * v[j].y) + (v[j].z * v[j].z + v[j].w * v[j].w); }
        const float rstd = 1.f / sqrtf(wave_sum(s2) * (1.f / DM) + LN_EPS);
        GAS unsigned long long* o8 = (GAS unsigned long long*)(HB + (size_t)m * DM) + F.lane;
#pragma unroll
        for (int j = 0; j < 8; ++j) { const f32x4 gg = *((const GAS f32x4*)g + F.lane + 64 * j), b4 = *((const GAS f32x4*)bb + F.lane + 64 * j);
            const f32x4 y = v[j] * rstd * gg + b4; zr[64 * j] = y;
            o8[64 * j] = (unsigned long long)pk2(y.x, y.y) | ((unsigned long long)pk2(y.z, y.w) << 32); }
    }
}

typedef short s16x8 __attribute__((ext_vector_type(8)));
__device__ __forceinline__ float dpp_max_all(float v) {
    int x = __float_as_int(v);
    v = fmaxf(v, __int_as_float(__builtin_amdgcn_update_dpp(x, x, 0xB1, 0xF, 0xF, false))); x = __float_as_int(v);
    v = fmaxf(v, __int_as_float(__builtin_amdgcn_update_dpp(x, x, 0x4E, 0xF, 0xF, false))); x = __float_as_int(v);
    v = fmaxf(v, __int_as_float(__builtin_amdgcn_update_dpp(x, x, 0x141, 0xF, 0xF, false))); x = __float_as_int(v);
    v = fmaxf(v, __int_as_float(__builtin_amdgcn_update_dpp(x, x, 0x140, 0xF, 0xF, false))); x = __float_as_int(v);
    v = fmaxf(v, __int_as_float(__builtin_amdgcn_update_dpp(x, x, 0x142, 0xA, 0xF, false))); x = __float_as_int(v);
    v = fmaxf(v, __int_as_float(__builtin_amdgcn_update_dpp(x, x, 0x143, 0xC, 0xF, false)));
    return __int_as_float(__builtin_amdgcn_readlane(__float_as_int(v), 63));
}
__device__ __forceinline__ float dpp_sum_all(float v) {
    v += __int_as_float(__builtin_amdgcn_update_dpp(0, __float_as_int(v), 0xB1, 0xF, 0xF, false));
    v += __int_as_float(__builtin_amdgcn_update_dpp(0, __float_as_int(v), 0x4E, 0xF, 0xF, false));
    v += __int_as_float(__builtin_amdgcn_update_dpp(0, __float_as_int(v), 0x141, 0xF, 0xF, false));
    v += __int_as_float(__builtin_amdgcn_update_dpp(0, __float_as_int(v), 0x140, 0xF, 0xF, false));
    v += __int_as_float(__builtin_amdgcn_update_dpp(0, __float_as_int(v), 0x142, 0xA, 0xF, false));
    v += __int_as_float(__builtin_amdgcn_update_dpp(0, __float_as_int(v), 0x143, 0xC, 0xF, false));
    return __int_as_float(__builtin_amdgcn_readlane(__float_as_int(v), 63));
}
__device__ __forceinline__ void top16_128(float v0, float v1, int lane, float& outv, int& outi) {
    outv = -INFINITY; outi = 0;
#pragma unroll 1
    for (int r = 0; r < 16; ++r) {
        const float wm = dpp_max_all(fmaxf(v0, v1));
        const unsigned long long b0 = __ballot(v0 == wm), b1 = __ballot(v1 == wm);
        const int idx = b0 ? (int)__builtin_ctzll(b0) : 64 + (int)__builtin_ctzll(b1);
        if (lane == idx) v0 = -INFINITY;
        if (lane + 64 == idx) v1 = -INFINITY;
        if (lane == r) { outv = wm; outi = idx; }
    }
}
__device__ __forceinline__ float gelu_erf(float x) { return 0.5f * x * (1.f + erff(x * 0.7071067811865476f)); }
__device__ __forceinline__ void cvt_fp8_rows(Frame& F, const float* src, unsigned char* dst, float* scales, int rows) {
    const int gw = F.vcu * NWAVES + F.wave, NGW = F.G * NWAVES;
    for (int m = gw; m < rows; m += NGW) {
        f32x4 v[8]; float mx = 0.f;
#pragma unroll
        for (int i = 0; i < 2; ++i)
#pragma unroll
            for (int q = 0; q < 4; ++q) { v[4 * i + q] = *(const GAS f32x4*)(src + (size_t)m * DM + 1024 * i + 16 * F.lane + 4 * q);
                mx = fmaxf(mx, fmaxf(fmaxf(fabsf(v[4 * i + q].x), fabsf(v[4 * i + q].y)), fmaxf(fabsf(v[4 * i + q].z), fabsf(v[4 * i + q].w)))); }
        mx = dpp_max_all(mx); if (!(mx > 0.f)) mx = 1.f;
        const float inv = 448.f / mx;
        if (F.lane == 0) scales[m] = mx * (1.f / 448.f);
#pragma unroll
        for (int i = 0; i < 2; ++i) { v4u o; int w;
            w = __builtin_amdgcn_cvt_pk_fp8_f32(v[4 * i].x * inv, v[4 * i].y * inv, 0, false); w = __builtin_amdgcn_cvt_pk_fp8_f32(v[4 * i].z * inv, v[4 * i].w * inv, w, true); o.x = (unsigned)w;
            w = __builtin_amdgcn_cvt_pk_fp8_f32(v[4 * i + 1].x * inv, v[4 * i + 1].y * inv, 0, false); w = __builtin_amdgcn_cvt_pk_fp8_f32(v[4 * i + 1].z * inv, v[4 * i + 1].w * inv, w, true); o.y = (unsigned)w;
            w = __builtin_amdgcn_cvt_pk_fp8_f32(v[4 * i + 2].x * inv, v[4 * i + 2].y * inv, 0, false); w = __builtin_amdgcn_cvt_pk_fp8_f32(v[4 * i + 2].z * inv, v[4 * i + 2].w * inv, w, true); o.z = (unsigned)w;
            w = __builtin_amdgcn_cvt_pk_fp8_f32(v[4 * i + 3].x * inv, v[4 * i + 3].y * inv, 0, false); w = __builtin_amdgcn_cvt_pk_fp8_f32(v[4 * i + 3].z * inv, v[4 * i + 3].w * inv, w, true); o.w = (unsigned)w;
            *(GAS v4u*)(dst + (size_t)m * DM + 1024 * i + 16 * F.lane) = o; }
    }
}
typedef float f32x2v __attribute__((ext_vector_type(2)));
__device__ __forceinline__ void dot16_fp8(f32x2v& a0, f32x2v& a1, const v4u w, const float* x) {
#define D4(W, O) do { const f32x2v lo = __builtin_amdgcn_cvt_pk_f32_fp8((int)(W), false), hi = __builtin_amdgcn_cvt_pk_f32_fp8((int)(W), true); \
    a0 += lo * (f32x2v){x[O], x[O + 1]}; a1 += hi * (f32x2v){x[O + 2], x[O + 3]}; } while (0)
    D4(w.x, 0); D4(w.y, 4); D4(w.z, 8); D4(w.w, 12);
#undef D4
}
__device__ __forceinline__ void axpy16_fp8(float* acc, const float c, const v4u w) {
#define A4(W, O) do { const f32x2v lo = __builtin_amdgcn_cvt_pk_f32_fp8((int)(W), false), hi = __builtin_amdgcn_cvt_pk_f32_fp8((int)(W), true); \
    acc[O] += c * lo.x; acc[O + 1] += c * lo.y; acc[O + 2] += c * hi.x; acc[O + 3] += c * hi.y; } while (0)
    A4(w.x, 0); A4(w.y, 4); A4(w.z, 8); A4(w.w, 12);
#undef A4
}
__device__ __forceinline__ void peer_phase(Frame& F) {
    LAS float* sc = (LAS float*)(F.lds + RING_OFF);
    const bf16* PQ = (const bf16*)(F.ws + WS_Q); const bf16* SUBK = (const bf16*)(F.ws + WS_SUBK);
    const unsigned char* PU8 = (const unsigned char*)(F.ws + WS_PU8); const unsigned char* PV8 = (const unsigned char*)(F.ws + WS_PV8);
    const float* SU = (const float*)(F.ws + WS_SU); const float* SV = (const float*)(F.ws + WS_SV);
    const float* Z = (const float*)(F.ws + WS_Z); const float* g3 = F.in[18]; const float* b3 = F.in[19];
    const int lane = F.lane, wave = F.wave;
    for (int unit = F.vcu; unit < TOK / 16; unit += F.G) {
        const int t0 = unit * 16;
        __syncthreads();
#pragma unroll 1
        for (int gi = 0; gi < 2; ++gi) { const int g = 2 * wave + gi;
            s16x8 a[4];
#pragma unroll
            for (int ks = 0; ks < 4; ++ks) a[ks] = *(const GAS s16x8*)(PQ + (size_t)(t0 + (lane & 15)) * DM + g * 128 + ks * 32 + 8 * (lane >> 4));
#pragma unroll 2
            for (int nt = 0; nt < 8; ++nt) { f32x4 acc = {0.f, 0.f, 0.f, 0.f};
#pragma unroll
                for (int ks = 0; ks < 4; ++ks) { const s16x8 bfr = *(const GAS s16x8*)(SUBK + (size_t)(g * 128 + nt * 16 + (lane & 15)) * 128 + ks * 32 + 8 * (lane >> 4));
                    acc = __builtin_amdgcn_mfma_f32_16x16x32_bf16(a[ks], bfr, acc, 0, 0, 0); }
#pragma unroll
                for (int r = 0; r < 4; ++r) sc[(4 * (lane >> 4) + r) * 2048 + g * 128 + nt * 16 + (lane & 15)] = acc[r]; } }
        __syncthreads();
#pragma unroll 1
        for (int ti = 0; ti < 2; ++ti) { const int tl = 2 * wave + ti; const size_t t = (size_t)t0 + tl;
            int E0 = 0, E1 = 0; float G0 = 0.f, G1 = 0.f;
#pragma unroll 1
            for (int hh = 0; hh < 8; ++hh) {
                float sA, sB; int iA, iB;
                top16_128(sc[tl * 2048 + (2 * hh) * 128 + lane], sc[tl * 2048 + (2 * hh) * 128 + 64 + lane], lane, sA, iA);
                top16_128(sc[tl * 2048 + (2 * hh + 1) * 128 + lane], sc[tl * 2048 + (2 * hh + 1) * 128 + 64 + lane], lane, sB, iB);
                int ca, cb; const int c = lane;
                if (c < 16) { ca = 0; cb = c; } else if (c < 24) { ca = 1; cb = c - 16; } else if (c < 29) { ca = 2; cb = c - 24; } else if (c < 33) { ca = 3; cb = c - 29; }
                else if (c < 36) { ca = 4; cb = c - 33; } else if (c < 38) { ca = 5; cb = c - 36; } else if (c < 40) { ca = 6; cb = c - 38; } else if (c < 42) { ca = 7; cb = c - 40; }
                else { ca = 8 + ((c - 42) & 7); cb = 0; }
                float cv = __shfl(sA, ca) + __shfl(sB, cb); const int ce = __shfl(iA, ca) * 128 + __shfl(iB, cb);
                if (c >= 50) cv = -INFINITY;
                float bv = -INFINITY; int be = 0;
#pragma unroll 1
                for (int r = 0; r < 16; ++r) { const float wm = dpp_max_all(cv); const unsigned long long bal = __ballot(cv == wm); const int idx = (int)__builtin_ctzll(bal);
                    const int ee = __builtin_amdgcn_readlane(ce, idx); if (lane == idx) cv = -INFINITY; if (lane == r) { bv = wm; be = ee; } }
                const float mx = __int_as_float(__builtin_amdgcn_readlane(__float_as_int(bv), 0)); const float p = (lane < 16) ? __expf(bv - mx) : 0.f; const float gt = p / dpp_sum_all(p);
                const int src = lane & 15; const int e_s = __shfl(be, src); const float g_s = __shfl(gt, src);
                if ((lane >> 4) == (hh & 3)) { if (hh < 4) { E0 = e_s; G0 = g_s; } else { E1 = e_s; G1 = g_s; } }
            }
            float xr[32];
#pragma unroll
            for (int i = 0; i < 2; ++i)
#pragma unroll
                for (int q = 0; q < 4; ++q) { const f32x4 p4 = *(const GAS f32x4*)(Z + t * DM + 1024 * i + 16 * lane + 4 * q);
                    xr[16 * i + 4 * q] = p4.x; xr[16 * i + 4 * q + 1] = p4.y; xr[16 * i + 4 * q + 2] = p4.z; xr[16 * i + 4 * q + 3] = p4.w; }
            const float su0 = SU[E0], su1 = SU[E1], sv0 = SV[E0], sv1 = SV[E1];
            float H0 = 0.f, H1 = 0.f;
            v4u wA[4][2], wB[4][2];
#define PLOAD(BUF, TAB, GRP) do { _Pragma("unroll") for (int k_ = 0; k_ < 4; ++k_) { const int kk_ = (GRP) * 4 + k_; \
                const int e_ = (kk_ < 64) ? __builtin_amdgcn_readlane(E0, kk_ & 63) : __builtin_amdgcn_readlane(E1, kk_ & 63); \
                const unsigned char* r_ = (TAB) + (size_t)e_ * DM + 16 * lane; BUF[k_][0] = *(const GAS v4u*)r_; BUF[k_][1] = *(const GAS v4u*)(r_ + 1024); } } while (0)
#define PDOT(BUF, GRP) do { _Pragma("unroll") for (int k_ = 0; k_ < 4; ++k_) { const int kk_ = (GRP) * 4 + k_; f32x2v a0 = {0.f, 0.f}, a1 = {0.f, 0.f}; \
                dot16_fp8(a0, a1, BUF[k_][0], xr); dot16_fp8(a0, a1, BUF[k_][1], xr + 16); \
                const float d_ = dpp_sum_all((a0.x + a0.y) + (a1.x + a1.y)); \
                if (kk_ < 64) { if (lane == kk_) H0 = d_; } else { if (lane == kk_ - 64) H1 = d_; } } } while (0)
            PLOAD(wA, PU8, 0);
#pragma unroll 1
            for (int grp = 0; grp < 32; grp += 2) { PLOAD(wB, PU8, grp + 1); PDOT(wA, grp); if (grp + 2 < 32) PLOAD(wA, PU8, grp + 2); PDOT(wB, grp + 1); }
#undef PDOT
            const float C0 = G0 * gelu_erf(H0 * su0) * sv0, C1 = G1 * gelu_erf(H1 * su1) * sv1;
            float acc[32];
#pragma unroll
            for (int j = 0; j < 32; ++j) acc[j] = 0.f;
#define PAXPY(BUF, GRP) do { _Pragma("unroll") for (int k_ = 0; k_ < 4; ++k_) { const int kk_ = (GRP) * 4 + k_; \
                const float c_ = __int_as_float((kk_ < 64) ? __builtin_amdgcn_readlane(__float_as_int(C0), kk_ & 63) : __builtin_amdgcn_readlane(__float_as_int(C1), kk_ & 63)); \
                axpy16_fp8(acc, c_, BUF[k_][0]); axpy16_fp8(acc + 16, c_, BUF[k_][1]); } } while (0)
            PLOAD(wA, PV8, 0);
#pragma unroll 1
            for (int grp = 0; grp < 32; grp += 2) { PLOAD(wB, PV8, grp + 1); PAXPY(wA, grp); if (grp + 2 < 32) PLOAD(wA, PV8, grp + 2); PAXPY(wB, grp + 1); }
#undef PAXPY
#undef PLOAD
            float s = 0.f;
#pragma unroll
            for (int j = 0; j < 32; ++j) { acc[j] = DN_ALPHA * xr[j] + acc[j]; s += acc[j]; }
            const float mean = dpp_sum_all(s) * (1.f / DM); float s2 = 0.f;
#pragma unroll
            for (int j = 0; j < 32; ++j) { acc[j] -= mean; s2 += acc[j] * acc[j]; }
            const float rstd = 1.f / sqrtf(dpp_sum_all(s2) * (1.f / DM) + LN_EPS);
#pragma unroll
            for (int i = 0; i < 2; ++i)
#pragma unroll
                for (int q = 0; q < 4; ++q) { const int c0 = 1024 * i + 16 * lane + 4 * q; const int j0 = 16 * i + 4 * q;
                    const f32x4 ga = *(const GAS f32x4*)(g3 + c0), ba = *(const GAS f32x4*)(b3 + c0); f32x4 ya;
                    ya.x = acc[j0] * rstd * ga.x + ba.x; ya.y = acc[j0 + 1] * rstd * ga.y + ba.y; ya.z = acc[j0 + 2] * rstd * ga.z + ba.z; ya.w = acc[j0 + 3] * rstd * ga.w + ba.w;
                    *(GAS f32x4*)(F.out + t * DM + c0) = ya; }
        }
    }
}
typedef float f32x16 __attribute__((ext_vector_type(16)));
typedef float f32x2_t __attribute__((ext_vector_type(2))); typedef __bf16 bf16x2_t __attribute__((ext_vector_type(2)));
__device__ __forceinline__ unsigned cvtpk_s(float lo, float hi) { f32x2_t v = {lo, hi}; bf16x2_t b = __builtin_convertvector(v, bf16x2_t); return __builtin_bit_cast(unsigned, b); }
__device__ __forceinline__ unsigned short bf1(float x) { return (unsigned short)(cvtpk_s(x, 0.f) & 0xffffu); }
__device__ __forceinline__ int crow(int r, int hi) { return (r & 3) + 8 * (r >> 2) + 4 * hi; }
#define MFMA32(a, b, c) __builtin_amdgcn_mfma_f32_32x32x16_bf16((a), (b), (c), 0, 0, 0)
template <int S> __device__ __forceinline__ bf16x8 pack8(const f32x16& x) {
    v4u p; p.x = cvtpk_s(x[8 * S], x[8 * S + 1]); p.y = cvtpk_s(x[8 * S + 2], x[8 * S + 3]); p.z = cvtpk_s(x[8 * S + 4], x[8 * S + 5]); p.w = cvtpk_s(x[8 * S + 6], x[8 * S + 7]);
    return __builtin_bit_cast(bf16x8, p);
}
__device__ __forceinline__ void gla_unit(Frame& F, int unit, bf16* ATTo) {
    const int b = unit >> 2, h = unit & 3, tid = F.tid, lane = F.lane, wave = F.wave, r32 = lane & 31, hi = lane >> 5;
    LAS float* GU = (LAS float*)(F.lds + RING_OFF);
    LAS float* GL = GU + 2048;
    LAS float* TOT = GL + 1024;
    LAS float* DEC = TOT + 512;
    LAS float* SS = DEC + 128;
    LAS float* RS = SS + 512;
    LAS bf16* QD = (LAS bf16*)(RS + 64);
    LAS bf16* KD = QD + 64 * 136;
    LAS bf16* KST = KD + 64 * 136;
    LAS bf16* VT = KST + 128 * 72;
    LAS bf16* AL = VT + 256 * 72;
    const bf16* PROJ = (const bf16*)(F.ws + WS_PROJ); const float* GATE = (const float*)(F.ws + WS_GATE);
    const float* gup = F.in[3]; const float* gbias = F.in[4]; const float* gnorm = F.in[5];
    const int d = tid & 127, g = tid >> 7;
    const int ev = tid & 255, jg = tid >> 8;
    float gu[16];
#pragma unroll
    for (int r = 0; r < 16; ++r) gu[r] = gup[(size_t)r * 512 + h * 128 + d];
    const float bias_d = gbias[h * 128 + d];
    const float gn = gnorm[32 * wave + r32];
    f32x16 st[4];
#pragma unroll
    for (int i = 0; i < 4; ++i)
#pragma unroll
        for (int r = 0; r < 16; ++r) st[i][r] = 0.f;
    __syncthreads();
#pragma unroll 1
    for (int ch = 0; ch < SEQ / 64; ++ch) {
        const size_t row0 = (size_t)b * SEQ + ch * 64;
        if (tid < 256) *(LAS f32x4*)(GL + tid * 4) = *(const GAS f32x4*)(GATE + row0 * 16 + tid * 4);
        __syncthreads();
        float cum[16];
        { float run = 0.f;
#pragma unroll
          for (int tt = 0; tt < 16; ++tt) { const LAS float* gl = GL + (16 * g + tt) * 16; float z = bias_d;
#pragma unroll
              for (int r = 0; r < 16; ++r) z += gl[r] * gu[r];
              const float ls = fminf(z, 0.f) - log1pf(__expf(-fabsf(z)));
              run += ls * (1.f / 16.f); cum[tt] = run; }
          TOT[g * 128 + d] = run; }
        __syncthreads();
        { float off = 0.f, total = 0.f;
#pragma unroll
          for (int gg = 0; gg < 4; ++gg) { const float t = TOT[gg * 128 + d]; total += t; if (gg < g) off += t; }
          unsigned short ks[16];
#pragma unroll
          for (int tt = 0; tt < 16; ++tt) { const int t = 16 * g + tt; const float c = off + cum[tt];
              const float q = bf2f(PROJ[(row0 + t) * NPROJ + C_QG + h * 128 + d]), k = bf2f(PROJ[(row0 + t) * NPROJ + C_KG + h * 128 + d]);
              QD[t * 136 + d] = bf1(q * 0.08838834764831845f * __expf(c)); KD[t * 136 + d] = bf1(k * __expf(-c)); ks[tt] = bf1(k * __expf(total - c)); }
          v4u w0, w1; w0.x = ks[0] | ((unsigned)ks[1] << 16); w0.y = ks[2] | ((unsigned)ks[3] << 16); w0.z = ks[4] | ((unsigned)ks[5] << 16); w0.w = ks[6] | ((unsigned)ks[7] << 16);
          w1.x = ks[8] | ((unsigned)ks[9] << 16); w1.y = ks[10] | ((unsigned)ks[11] << 16); w1.z = ks[12] | ((unsigned)ks[13] << 16); w1.w = ks[14] | ((unsigned)ks[15] << 16);
          *(LAS v4u*)(KST + d * 72 + 16 * g) = w0; *(LAS v4u*)(KST + d * 72 + 16 * g + 8) = w1;
          if (g == 0) DEC[d] = __expf(total); }
        { unsigned short vv[32];
#pragma unroll
          for (int jj = 0; jj < 32; ++jj) vv[jj] = PROJ[(row0 + 32 * jg + jj) * NPROJ + C_VG + h * 256 + ev];
#pragma unroll
          for (int q4 = 0; q4 < 4; ++q4) { v4u w; w.x = vv[8 * q4] | ((unsigned)vv[8 * q4 + 1] << 16); w.y = vv[8 * q4 + 2] | ((unsigned)vv[8 * q4 + 3] << 16);
              w.z = vv[8 * q4 + 4] | ((unsigned)vv[8 * q4 + 5] << 16); w.w = vv[8 * q4 + 6] | ((unsigned)vv[8 * q4 + 7] << 16);
              *(LAS v4u*)(VT + ev * 72 + 32 * jg + 8 * q4) = w; } }
        __syncthreads();
        if (wave < 3) { const int ib = wave > 0, jb = wave > 1; f32x16 acc;
#pragma unroll
            for (int r = 0; r < 16; ++r) acc[r] = 0.f;
#pragma unroll
            for (int s8 = 0; s8 < 8; ++s8) { const bf16x8 a = *(const LAS bf16x8*)(QD + (ib * 32 + r32) * 136 + 16 * s8 + 8 * hi), bb = *(const LAS bf16x8*)(KD + (jb * 32 + r32) * 136 + 16 * s8 + 8 * hi);
                acc = MFMA32(a, bb, acc); }
#pragma unroll
            for (int r = 0; r < 16; ++r) { const int i = ib * 32 + crow(r, hi), j = jb * 32 + r32; AL[i * 72 + j] = bf1(j <= i ? acc[r] : 0.f); } }
        f32x16 o0, o1;
#pragma unroll
        for (int r = 0; r < 16; ++r) { o0[r] = 0.f; o1[r] = 0.f; }
#define GLA_B(DB, S) do { const bf16x8 sb = pack8<S>(st[DB]); \
            const LAS bf16* p0 = QD + r32 * 136 + 32 * (DB) + 16 * (S) + 4 * hi; const LAS bf16* p1 = p0 + 32 * 136; \
            typedef unsigned long long u64; \
            const u64 a0 = *(const LAS u64*)p0, a1 = *(const LAS u64*)(p0 + 8), c0 = *(const LAS u64*)p1, c1 = *(const LAS u64*)(p1 + 8); \
            v4u fa, fc; fa.x = (unsigned)a0; fa.y = (unsigned)(a0 >> 32); fa.z = (unsigned)a1; fa.w = (unsigned)(a1 >> 32); fc.x = (unsigned)c0; fc.y = (unsigned)(c0 >> 32); fc.z = (unsigned)c1; fc.w = (unsigned)(c1 >> 32); \
            o0 = MFMA32(__builtin_bit_cast(bf16x8, fa), sb, o0); o1 = MFMA32(__builtin_bit_cast(bf16x8, fc), sb, o1); } while (0)
        GLA_B(0, 0); GLA_B(0, 1); GLA_B(1, 0); GLA_B(1, 1); GLA_B(2, 0); GLA_B(2, 1); GLA_B(3, 0); GLA_B(3, 1);
#undef GLA_B
        __syncthreads();
        bf16x8 vf[4];
#pragma unroll
        for (int s = 0; s < 4; ++s) vf[s] = *(const LAS bf16x8*)(VT + (32 * wave + r32) * 72 + 16 * s + 8 * hi);
#pragma unroll
        for (int s = 0; s < 2; ++s) o0 = MFMA32(*(const LAS bf16x8*)(AL + r32 * 72 + 16 * s + 8 * hi), vf[s], o0);
#pragma unroll
        for (int s = 0; s < 4; ++s) o1 = MFMA32(*(const LAS bf16x8*)(AL + (32 + r32) * 72 + 16 * s + 8 * hi), vf[s], o1);
#pragma unroll
        for (int db = 0; db < 4; ++db) {
#pragma unroll
            for (int r4 = 0; r4 < 4; ++r4) { const f32x4 dc = *(const LAS f32x4*)(DEC + 32 * db + 8 * r4 + 4 * hi);
                st[db][4 * r4] *= dc.x; st[db][4 * r4 + 1] *= dc.y; st[db][4 * r4 + 2] *= dc.z; st[db][4 * r4 + 3] *= dc.w; }
#pragma unroll
            for (int s = 0; s < 4; ++s) st[db] = MFMA32(*(const LAS bf16x8*)(KST + (32 * db + r32) * 72 + 16 * s + 8 * hi), vf[s], st[db]); }
#pragma unroll
        for (int r = 0; r < 16; ++r) { float a = o0[r] * o0[r], c = o1[r] * o1[r];
#pragma unroll
            for (int m = 1; m < 32; m <<= 1) { a += __shfl_xor(a, m); c += __shfl_xor(c, m); }
            if (r32 == 0) { SS[wave * 64 + crow(r, hi)] = a; SS[wave * 64 + 32 + crow(r, hi)] = c; } }
        __syncthreads();
        if (tid < 64) { float t = 0.f;
#pragma unroll
            for (int w = 0; w < 8; ++w) t += SS[w * 64 + tid];
            RS[tid] = 1.f / sqrtf(t * (1.f / 256.f) + RMS_EPS); }
        __syncthreads();
#pragma unroll
        for (int r = 0; r < 16; ++r) { const int i0 = crow(r, hi), i1 = 32 + i0;
            const float ra = bf2f(PROJ[(row0 + i0) * NPROJ + C_RG + h * 256 + 32 * wave + r32]), rb = bf2f(PROJ[(row0 + i1) * NPROJ + C_RG + h * 256 + 32 * wave + r32]);
            const float ya = o0[r] * RS[i0] * gn * (ra / (1.f + __expf(-ra))), yb = o1[r] * RS[i1] * gn * (rb / (1.f + __expf(-rb)));
            ATTo[(row0 + i0) * DM + 1024 + h * 256 + 32 * wave + r32] = bf1(ya); ATTo[(row0 + i1) * DM + 1024 + h * 256 + 32 * wave + r32] = bf1(yb); }
    }
    __syncthreads();
}
__device__ __forceinline__ void check_diff_bf16(Frame& F, const bf16* A, const bf16* B, int c0, int c1, gu32* word) {
    const size_t nth = (size_t)F.G * NWAVES * 64; const int w8 = (c1 - c0) / 8; float mx = 0.f;
    for (size_t i = (size_t)F.vcu * NWAVES * 64 + F.tid; i < (size_t)TOK * w8; i += nth) { const size_t row = i / w8; const int c = c0 + (int)(i % w8) * 8;
        const us8 a = *(const GAS us8*)(A + row * DM + c), bq = *(const GAS us8*)(B + row * DM + c);
#pragma unroll
        for (int j = 0; j < 8; ++j) { float dv = fabsf(bf2f(a[j]) - bf2f(bq[j])); if (!(dv == dv)) dv = 1e6f; mx = fmaxf(mx, dv); } }
    mx = wave_max(mx);
    if (F.lane == 0) __hip_atomic_fetch_max((unsigned*)word, __float_as_uint(mx), __ATOMIC_RELAXED, __HIP_MEMORY_SCOPE_AGENT);
}
namespace mb {
constexpr int D = 128, NW = 8, QBLK = 32, KVBLK = 64;
constexpr float SCALE = 0.088388347648318440f, THR = 8.f;
constexpr int SHM_V = KVBLK * D * 2, SHM_K = KVBLK * D * 2;
#define KSWZ(row, colB) ((row) * 256 + ((colB) ^ (((row) & 7) << 4)))
#define SBAR() __builtin_amdgcn_sched_barrier(0)
typedef short s16x4 __attribute__((ext_vector_type(4)));
__device__ __forceinline__ unsigned cvtpk(float lo, float hi) { unsigned r; asm volatile("v_cvt_pk_bf16_f32 %0, %1, %2" : "=v"(r) : "v"(lo), "v"(hi)); return r; }
__device__ __forceinline__ void partialSM(f32x16& p0, f32x16& p1, float& m_reg, float& mn, float& alpha) {
    constexpr float C = SCALE * 1.4426950408889634f;
    float pmax = p0[0];
#pragma unroll
    for (int r = 1; r < 16; ++r) pmax = fmaxf(pmax, p0[r]);
#pragma unroll
    for (int r = 0; r < 16; ++r) pmax = fmaxf(pmax, p1[r]);
    { auto rr = __builtin_amdgcn_permlane32_swap(__float_as_uint(pmax), __float_as_uint(pmax), false, false); pmax = fmaxf(__uint_as_float(rr[0]), __uint_as_float(rr[1])); }
    if (__builtin_expect(__all(pmax - m_reg <= THR / SCALE), 1)) { mn = m_reg; alpha = 1.f; }
    else { mn = fmaxf(m_reg, pmax); alpha = __builtin_amdgcn_exp2f((m_reg - mn) * C); m_reg = mn; }
    const float mnC = -mn * C;
#pragma unroll
    for (int r = 0; r < 16; ++r) p0[r] = fmaf(p0[r], C, mnC);
#pragma unroll
    for (int r = 0; r < 16; ++r) p1[r] = fmaf(p1[r], C, mnC);
#pragma unroll
    for (int r = 0; r < 16; ++r) p0[r] = __builtin_amdgcn_exp2f(p0[r]);
}
__device__ __forceinline__ void finishSM(f32x16& p0, f32x16& p1, float alpha, float& l_reg, bf16x8& pa0, bf16x8& pa1, bf16x8& pa2, bf16x8& pa3) {
#pragma unroll
    for (int r = 0; r < 16; ++r) p1[r] = __builtin_amdgcn_exp2f(p1[r]);
    float ps = 0;
#pragma unroll
    for (int r = 0; r < 16; ++r) ps += p0[r];
#pragma unroll
    for (int r = 0; r < 16; ++r) ps += p1[r];
    { auto rr = __builtin_amdgcn_permlane32_swap(__float_as_uint(ps), __float_as_uint(ps), false, false); ps = __uint_as_float(rr[0]) + __uint_as_float(rr[1]); }
    l_reg = l_reg * alpha + ps;
#define PK4(P, BASE, OUT) do { unsigned a0 = cvtpk(P[BASE + 0], P[BASE + 1]), a1 = cvtpk(P[BASE + 2], P[BASE + 3]);   \
    unsigned b0 = cvtpk(P[BASE + 4], P[BASE + 5]), b1 = cvtpk(P[BASE + 6], P[BASE + 7]);                              \
    auto r0 = __builtin_amdgcn_permlane32_swap(a0, b0, false, false); auto r1 = __builtin_amdgcn_permlane32_swap(a1, b1, false, false); \
    v4u w = {r0[0], r1[0], r0[1], r1[1]}; OUT = __builtin_bit_cast(bf16x8, w); } while (0)
    PK4(p0, 0, pa0); PK4(p0, 8, pa1); PK4(p1, 0, pa2); PK4(p1, 8, pa3);
#undef PK4
}
__device__ __forceinline__ void qkt(f32x16& p0, f32x16& p1, const LAS unsigned char* Ks, const bf16x8* qr, int r32, int hi) {
#pragma unroll
    for (int r = 0; r < 16; ++r) { p0[r] = 0.f; p1[r] = 0.f; }
#pragma unroll
    for (int d0 = 0; d0 < 8; ++d0) { const int cb = (d0 * 16 + hi * 8) * 2;
        const bf16x8 b0 = *(const LAS bf16x8*)(Ks + KSWZ(r32, cb)), b1 = *(const LAS bf16x8*)(Ks + KSWZ(32 + r32, cb));
        p0 = MFMA32(b0, qr[d0], p0); p1 = MFMA32(b1, qr[d0], p1); }
}
__device__ __forceinline__ int v_st(int k, int c) { const int kk = (k & ~0xC) | ((k & 4) << 1) | ((k & 8) >> 1); return ((kk >> 3) * 4 + (c >> 5)) * 512 + ((kk & 7) * 32 + (c & 31)) * 2; }
__device__ __forceinline__ int v_rd_base(int lane) { return ((lane & 3) << 3) | (((lane >> 2) & 3) << 6) | (((lane >> 4) & 1) << 5) | (((lane >> 5) & 1) << 8); }
constexpr int v_rd_off(int d0, int ks, int half) { return d0 * 512 + ks * 4096 + half * 2048; }
template <int OFF> __device__ __forceinline__ s16x4 tr_read(int vb) { s16x4 r; asm volatile("ds_read_b64_tr_b16 %0, %1 offset:%2" : "=&v"(r) : "v"(vb), "i"(OFF) : "memory"); return r; }
template <int D0> __device__ __forceinline__ void pv_one(f32x16& od, int vb, bf16x8 pa0, bf16x8 pa1, bf16x8 pa2, bf16x8 pa3) {
    const s16x4 l0 = tr_read<v_rd_off(D0, 0, 0)>(vb), h0 = tr_read<v_rd_off(D0, 0, 1)>(vb), l1 = tr_read<v_rd_off(D0, 1, 0)>(vb), h1 = tr_read<v_rd_off(D0, 1, 1)>(vb);
    const s16x4 l2 = tr_read<v_rd_off(D0, 2, 0)>(vb), h2 = tr_read<v_rd_off(D0, 2, 1)>(vb), l3 = tr_read<v_rd_off(D0, 3, 0)>(vb), h3 = tr_read<v_rd_off(D0, 3, 1)>(vb);
    asm volatile("s_waitcnt lgkmcnt(0)" ::: "memory"); SBAR();
#define PK(L, H) (bf16x8){L[0], L[1], L[2], L[3], H[0], H[1], H[2], H[3]}
    od = MFMA32(pa0, PK(l0, h0), od); od = MFMA32(pa1, PK(l1, h1), od); od = MFMA32(pa2, PK(l2, h2), od); od = MFMA32(pa3, PK(l3, h3), od);
#undef PK
}
__device__ __forceinline__ void pv_d0(f32x16* o, int vb, bf16x8 pa0, bf16x8 pa1, bf16x8 pa2, bf16x8 pa3) {
    pv_one<0>(o[0], vb, pa0, pa1, pa2, pa3); pv_one<1>(o[1], vb, pa0, pa1, pa2, pa3); pv_one<2>(o[2], vb, pa0, pa1, pa2, pa3); pv_one<3>(o[3], vb, pa0, pa1, pa2, pa3);
}
__device__ __forceinline__ void mask_tile(f32x16& p0, f32x16& p1, int j, int qrel, int hi, unsigned sel) {
    if (j < 4) {
        const int kb = 64 * j + 4 * hi;
#pragma unroll
        for (int r = 0; r < 16; ++r) { const int kv = kb + (r & 3) + 8 * (r >> 2); if (kv > qrel) p0[r] = -INFINITY; if (kv + 32 > qrel) p1[r] = -INFINITY; }
    } else if (!((sel >> ((j - 4) >> 2)) & 1u)) {
#pragma unroll
        for (int r = 0; r < 16; ++r) { p0[r] = -INFINITY; p1[r] = -INFINITY; }
    }
}
__device__ __forceinline__ void moba_unit(Frame& F, int unit, bf16* ATTo) {
    const int qb = 7 - (unit >> 6), bh = unit & 63, b = bh >> 3, h = bh & 7;
    const int tid = F.tid, wid = F.wave, lane = F.lane, r32 = lane & 31, hi = lane >> 5;
    LAS unsigned char* lds = F.lds + RING_OFF;
    LAS unsigned char* V_lds = lds; LAS unsigned char* K_lds = lds + 2 * SHM_V;
    LAS float* ws = (LAS float*)(lds + 2 * SHM_V + 2 * SHM_K) + wid * 64; LAS float* li_l = ws; LAS float* al_l = ws + 32;
    const bf16* PROJ = (const bf16*)(F.ws + WS_PROJ);
    const size_t rowb = (size_t)b * SEQ;
    const bf16* Kh = PROJ + rowb * NPROJ + C_KM + h * 128; const bf16* Vh = PROJ + rowb * NPROJ + C_VM + h * 128;
    constexpr int LDK = NPROJ;
    float m_reg = -1e30f, l_reg = 0; f32x16 o[4]; bf16x8 qr[8];
#pragma unroll
    for (int i = 0; i < 4; ++i)
#pragma unroll
        for (int r = 0; r < 16; ++r) o[i][r] = 0.f;
    { const bf16* Qw = PROJ + (rowb + qb * 256 + wid * QBLK + r32) * NPROJ + C_QM + h * 128 + hi * 8;
#pragma unroll
      for (int d0 = 0; d0 < 8; ++d0) qr[d0] = *(const GAS bf16x8*)(Qw + d0 * 16); }
    const int sr = tid >> 4, sc = (tid & 15) * 8, vst0 = v_st(sr, sc), vst1 = v_st(32 + sr, sc);
    const int vb0 = (int)(uintptr_t)V_lds + v_rd_base(lane);
    const int qrel = wid * QBLK + r32;
    __syncthreads();
    unsigned sel = 0;
    {
        float g[7];
#pragma unroll
        for (int n = 0; n < 7; ++n) { g[n] = 0.f;
            if (n < qb) { float gs = 0.f;
#pragma unroll 1
                for (int t = 0; t < 4; ++t) { const int k0 = n * 256 + 64 * t; const int bsel = t & 1;
                    const bf16x8 ka = *(const GAS bf16x8*)(Kh + (size_t)(k0 + sr) * LDK + sc), kb2 = *(const GAS bf16x8*)(Kh + (size_t)(k0 + 32 + sr) * LDK + sc);
                    *(LAS bf16x8*)(K_lds + bsel * SHM_K + KSWZ(sr, sc * 2)) = ka; *(LAS bf16x8*)(K_lds + bsel * SHM_K + KSWZ(32 + sr, sc * 2)) = kb2;
                    __syncthreads();
                    f32x16 p0, p1; qkt(p0, p1, K_lds + bsel * SHM_K, qr, r32, hi);
#pragma unroll
                    for (int r = 0; r < 16; ++r) gs += p0[r] + p1[r]; }
                { auto rr = __builtin_amdgcn_permlane32_swap(__float_as_uint(gs), __float_as_uint(gs), false, false); gs = __uint_as_float(rr[0]) + __uint_as_float(rr[1]); }
                g[n] = gs; } }
#pragma unroll
        for (int n = 0; n < 7; ++n) { int cnt = 0;
#pragma unroll
            for (int m = 0; m < 7; ++m) if (m != n && m < qb && (g[m] > g[n] || (g[m] == g[n] && m < n))) ++cnt;
            if (n < qb && cnt < 3) sel |= 1u << n; }
    }
    __syncthreads();
    const int NT = 4 * (qb + 1);
#define KSTART(j) (((j) < 4) ? (qb * 256 + 64 * (j)) : (((j) - 4) * 64))
    bf16x8 vs0, vs1, ks0, ks1;
#define SLOAD(k0) do { vs0 = *(const GAS bf16x8*)(&Vh[(size_t)((k0) + sr) * LDK + sc]); vs1 = *(const GAS bf16x8*)(&Vh[(size_t)((k0) + 32 + sr) * LDK + sc]); \
    ks0 = *(const GAS bf16x8*)(&Kh[(size_t)((k0) + sr) * LDK + sc]); ks1 = *(const GAS bf16x8*)(&Kh[(size_t)((k0) + 32 + sr) * LDK + sc]); } while (0)
#define SWRITE(bb) do { *(LAS bf16x8*)(V_lds + (bb) * SHM_V + vst0) = vs0; *(LAS bf16x8*)(V_lds + (bb) * SHM_V + vst1) = vs1; const int kc = sc * 2; \
    *(LAS bf16x8*)(K_lds + (bb) * SHM_K + KSWZ(sr, kc)) = ks0; *(LAS bf16x8*)(K_lds + (bb) * SHM_K + KSWZ(32 + sr, kc)) = ks1; } while (0)
    SLOAD(KSTART(0)); SWRITE(0); SLOAD(KSTART(1));
    __syncthreads();
#pragma unroll 1
    for (int j = 0; j < NT; ++j) {
        const int bsel = j & 1;
        if (j + 1 < NT) { SWRITE(bsel ^ 1); }
        if (j + 2 < NT) { const int k2 = KSTART(j + 2); SLOAD(k2); }
        f32x16 p0, p1; float mn, al; bf16x8 pa0, pa1, pa2, pa3;
        qkt(p0, p1, K_lds + bsel * SHM_K, qr, r32, hi); mask_tile(p0, p1, j, qrel, hi, sel);
        partialSM(p0, p1, m_reg, mn, al);
        if (__any(al < 1.f)) { if (hi == 0) al_l[r32] = al; asm volatile("s_waitcnt lgkmcnt(0)" ::: "memory");
#pragma unroll
            for (int d_ = 0; d_ < 4; ++d_)
#pragma unroll
                for (int r = 0; r < 16; ++r) o[d_][r] *= al_l[crow(r, hi)]; }
        finishSM(p0, p1, al, l_reg, pa0, pa1, pa2, pa3); SBAR();
        pv_d0(o, vb0 + bsel * SHM_V, pa0, pa1, pa2, pa3);
        __syncthreads();
    }
    if (hi == 0) li_l[r32] = l_reg; asm volatile("s_waitcnt lgkmcnt(0)" ::: "memory");
    float rli[16];
#pragma unroll
    for (int r = 0; r < 16; ++r) rli[r] = __builtin_amdgcn_rcpf(li_l[crow(r, hi)]);
    bf16* Ow = ATTo + (rowb + qb * 256 + wid * QBLK) * DM + h * 128;
#pragma unroll
    for (int r = 0; r < 16; ++r) { const int orow = crow(r, hi);
#pragma unroll
        for (int d0 = 0; d0 < 4; ++d0) Ow[(size_t)orow * DM + d0 * 32 + r32] = bf1(o[d0][r] * rli[r]); }
    __syncthreads();
#undef SLOAD
#undef SWRITE
#undef KSTART
}
#undef KSWZ
#undef SBAR
}
namespace mb {
__device__ __forceinline__ void qkt_acc(f32x16& p0, f32x16& p1, const LAS unsigned char* Ks, const bf16x8* qr, int r32, int hi) {
#define KSWZ(row, colB) ((row) * 256 + ((colB) ^ (((row) & 7) << 4)))
#pragma unroll
    for (int d0 = 0; d0 < 8; ++d0) { const int cb = (d0 * 16 + hi * 8) * 2;
        const bf16x8 b0 = *(const LAS bf16x8*)(Ks + KSWZ(r32, cb)), b1 = *(const LAS bf16x8*)(Ks + KSWZ(32 + r32, cb));
        p0 = MFMA32(b0, qr[d0], p0); p1 = MFMA32(b1, qr[d0], p1); }
}
__device__ __forceinline__ void xattn_unit(Frame& F, int unit, bf16* XOo) {
    const int b = unit >> 5, h = (unit >> 3) & 3, qt = unit & 7;
    const int tid = F.tid, wid = F.wave, lane = F.lane, r32 = lane & 31, hi = lane >> 5;
    LAS unsigned char* lds = F.lds + RING_OFF;
    LAS unsigned char* V_lds = lds; LAS unsigned char* K_lds = lds + 2 * SHM_V;
    LAS float* wsl = (LAS float*)(lds + 2 * SHM_V + 2 * SHM_K) + wid * 64;
    const bf16* KV = (const bf16*)(F.ws + WS_KV) + (size_t)(b * MEMLEN) * (2 * DM) + h * 512;
    const bf16* Qw = (const bf16*)(F.ws + WS_Q) + ((size_t)b * SEQ + qt * 256 + wid * QBLK + r32) * DM + h * 512 + hi * 8;
    constexpr int LDK = 2 * DM;
    const int sr = tid >> 4, sc = (tid & 15) * 8, vst0 = v_st(sr, sc), vst1 = v_st(32 + sr, sc);
    const int vb0 = (int)(uintptr_t)V_lds + v_rd_base(lane);
    f32x16 s0[4], s1[4];
#pragma unroll
    for (int t = 0; t < 4; ++t)
#pragma unroll
        for (int r = 0; r < 16; ++r) { s0[t][r] = 0.f; s1[t][r] = 0.f; }
    bf16x8 g0, g1;
#define XSRC(s, voff) (KV + (size_t)(64 * ((s) & 3)) * LDK + 128 * ((s) >> 2) + (voff))
#define XLOAD(s, voff) do { const bf16* src_ = XSRC(s, voff); g0 = *(const GAS bf16x8*)(src_ + (size_t)sr * LDK + sc); g1 = *(const GAS bf16x8*)(src_ + (size_t)(32 + sr) * LDK + sc); } while (0)
#define XWRITE_K(bb) do { *(LAS bf16x8*)(K_lds + (bb) * SHM_K + KSWZ(sr, sc * 2)) = g0; *(LAS bf16x8*)(K_lds + (bb) * SHM_K + KSWZ(32 + sr, sc * 2)) = g1; } while (0)
#define XWRITE_V(bb) do { *(LAS bf16x8*)(V_lds + (bb) * SHM_V + vst0) = g0; *(LAS bf16x8*)(V_lds + (bb) * SHM_V + vst1) = g1; } while (0)
    __syncthreads();
    XLOAD(0, 0); XWRITE_K(0); XLOAD(1, 0);
    __syncthreads();
#pragma unroll 1
    for (int dc = 0; dc < 4; ++dc) {
        bf16x8 qr[8];
#pragma unroll
        for (int d0 = 0; d0 < 8; ++d0) qr[d0] = *(const GAS bf16x8*)(Qw + dc * 128 + d0 * 16);
#pragma unroll
        for (int t = 0; t < 4; ++t) { const int step = dc * 4 + t;
            if (step + 1 < 16) XWRITE_K((t & 1) ^ 1);
            if (step + 2 < 16) XLOAD(step + 2, 0);
            qkt_acc(s0[t], s1[t], K_lds + (t & 1) * SHM_K, qr, r32, hi);
            __syncthreads(); }
    }
    constexpr float C = 0.04419417382415922f * 1.4426950408889634f;
    float pmax = s0[0][0];
#pragma unroll
    for (int t = 0; t < 4; ++t)
#pragma unroll
        for (int r = 0; r < 16; ++r) pmax = fmaxf(pmax, fmaxf(s0[t][r], s1[t][r]));
    { auto rr = __builtin_amdgcn_permlane32_swap(__float_as_uint(pmax), __float_as_uint(pmax), false, false); pmax = fmaxf(__uint_as_float(rr[0]), __uint_as_float(rr[1])); }
    const float mC = -pmax * C; float ps = 0.f;
#pragma unroll
    for (int t = 0; t < 4; ++t)
#pragma unroll
        for (int r = 0; r < 16; ++r) { s0[t][r] = __builtin_amdgcn_exp2f(fmaf(s0[t][r], C, mC)); s1[t][r] = __builtin_amdgcn_exp2f(fmaf(s1[t][r], C, mC)); ps += s0[t][r] + s1[t][r]; }
    { auto rr = __builtin_amdgcn_permlane32_swap(__float_as_uint(ps), __float_as_uint(ps), false, false); ps = __uint_as_float(rr[0]) + __uint_as_float(rr[1]); }
    bf16x8 pa[4][4];
#define PK4(P, BASE, OUT) do { unsigned a0 = cvtpk(P[BASE + 0], P[BASE + 1]), a1 = cvtpk(P[BASE + 2], P[BASE + 3]);   \
    unsigned b0 = cvtpk(P[BASE + 4], P[BASE + 5]), b1 = cvtpk(P[BASE + 6], P[BASE + 7]);                              \
    auto r0 = __builtin_amdgcn_permlane32_swap(a0, b0, false, false); auto r1 = __builtin_amdgcn_permlane32_swap(a1, b1, false, false); \
    v4u w = {r0[0], r1[0], r0[1], r1[1]}; OUT = __builtin_bit_cast(bf16x8, w); } while (0)
#pragma unroll
    for (int t = 0; t < 4; ++t) { PK4(s0[t], 0, pa[t][0]); PK4(s0[t], 8, pa[t][1]); PK4(s1[t], 0, pa[t][2]); PK4(s1[t], 8, pa[t][3]); }
#undef PK4
    if (hi == 0) wsl[r32] = ps; asm volatile("s_waitcnt lgkmcnt(0)" ::: "memory");
    float rli[16];
#pragma unroll
    for (int r = 0; r < 16; ++r) rli[r] = __builtin_amdgcn_rcpf(wsl[crow(r, hi)]);
    XLOAD(0, DM); XWRITE_V(0); XLOAD(1, DM);
    __syncthreads();
    bf16* Ow = XOo + ((size_t)b * SEQ + qt * 256 + wid * QBLK) * DM + h * 512;
#pragma unroll 1
    for (int dc = 0; dc < 4; ++dc) {
        f32x16 o[4];
#pragma unroll
        for (int i = 0; i < 4; ++i)
#pragma unroll
            for (int r = 0; r < 16; ++r) o[i][r] = 0.f;
#pragma unroll
        for (int t = 0; t < 4; ++t) { const int step = dc * 4 + t;
            if (step + 1 < 16) XWRITE_V((t & 1) ^ 1);
            if (step + 2 < 16) XLOAD(step + 2, DM);
            pv_d0(o, vb0 + (t & 1) * SHM_V, pa[t][0], pa[t][1], pa[t][2], pa[t][3]);
            __syncthreads(); }
#pragma unroll
        for (int r = 0; r < 16; ++r) { const int orow = crow(r, hi);
#pragma unroll
            for (int d0 = 0; d0 < 4; ++d0) Ow[(size_t)orow * DM + dc * 128 + d0 * 32 + r32] = bf1(o[d0][r] * rli[r]); }
    }
#undef XSRC
#undef XLOAD
#undef XWRITE_K
#undef XWRITE_V
#undef KSWZ
}
}

struct Args { const float* in[20]; float* out; unsigned char* ws; int ph_lo, ph_hi, li, pad; };
__global__ void __launch_bounds__(NWAVES * 64, 2) mk_fwd(Args args) {
    extern __shared__ __attribute__((aligned(16))) unsigned char lds[];
    Frame F;
    F.lds = (LAS unsigned char*)lds;
    F.MISC = (volatile LAS unsigned*)(F.lds + MISC_OFF);
    F.tid = threadIdx.x; F.lane = F.tid & 63; F.wave = __builtin_amdgcn_readfirstlane(F.tid >> 6);
    F.G = gridDim.x; { const int bx = blockIdx.x; F.vcu = (F.G % 8 == 0) ? (bx % 8) * (F.G / 8) + bx / 8 : bx; }
#pragma unroll
    for (int i = 0; i < 20; ++i) F.in[i] = args.in[i];
    F.out = args.out; F.ws = args.ws;
    unsigned char* ws = args.ws;
    F.ctl = (gu32*)(ws + WS_CTL);
    for (int u = F.tid; u < (LDS_BYTES - LDSCTL_OFF) / 4; u += NWAVES * 64) ((LAS unsigned*)(F.lds + LDSCTL_OFF))[u] = 0u;
    __syncthreads();
    XcdBarrier bar; bar.bar = (unsigned*)(F.ctl + CW_BAR); bar.x = 0; bar.st = nullptr;
    if (N_LAUNCHES != PER_PHASE) bar = xcd_barrier_post((unsigned*)(F.ctl + CW_BAR), F.MISC + 8);
#define GRID_BAR() do { if (N_LAUNCHES != PER_PHASE) xcd_barrier(bar); } while (0)
    const int lo = args.ph_lo, hi = args.ph_hi;
#define IN(k) (lo <= (k) && (k) < hi)
#define BOTH(k) (IN(k) && IN((k) + 1))

    if (IN(0)) { p0_prologue(F); if (BOTH(0)) GRID_BAR(); }
    if (IN(1)) {
        { pg8::Gemm g{(const pg8::bf16_t*)(ws + WS_XB), (const pg8::bf16_t*)(ws + WS_WIN), TOK, NPROJ_PAD, DM}; pg8::StaticOrder S; S.init(TOK, NPROJ_PAD, F.G, (int)blockIdx.x);
          EpiProj E{(pg8::bf16_t*)(ws + WS_PROJ), (float*)(ws + WS_GATE)};
          pg8::gemm_phase<EpiProj, pg8::StaticOrder, PG8_ALIGN, PG8_SP2>(F.lds + RING_OFF, g, S, E); }
        { const int nu1 = (TOK / 256) * (NPROJ_PAD / 256); const int shift = nu1 % F.G; const int c2 = ((int)blockIdx.x - shift + F.G) % F.G;
          pg8::Gemm g{(const pg8::bf16_t*)(ws + WS_MEMB), (const pg8::bf16_t*)(ws + WS_WKV), BATCH * MEMLEN, 2 * DM, DM}; pg8::StaticOrder S; S.init(BATCH * MEMLEN, 2 * DM, F.G, c2);
          pg8::EpiBf16<0> E{(pg8::bf16_t*)(ws + WS_KV), 2 * DM, nullptr, 0, 0, 1.f};
          pg8::gemm_phase<pg8::EpiBf16<0>, pg8::StaticOrder, PG8_ALIGN, PG8_SP2>(F.lds + RING_OFF, g, S, E); }
        if (BOTH(1)) GRID_BAR();
    }
#if CHECK_GLA || CHECK_MOBA
    if (IN(2)) { kmean_phase(F); if (BOTH(2)) GRID_BAR(); }
#endif
    if (IN(3)) {
#if CHECK_GLA
        if (F.vcu < 32) { naive_gla_unit(F, F.vcu); gla_unit(F, F.vcu, (bf16*)(ws + WS_Z)); }
        else for (int u = F.vcu - 32; u < BATCH * 8 * 32; u += F.G - 32) naive_attn_unit<128, 64, 0>(F, u);
#elif CHECK_MOBA
        if (F.vcu < 32) gla_unit(F, F.vcu, (bf16*)(ws + WS_ATT));
        else for (int u = F.vcu - 32; u < BATCH * 8 * 32; u += F.G - 32) naive_attn_unit<128, 64, 0>(F, u);
        for (;;) { __syncthreads(); if (F.tid == 0) F.MISC[0] = __hip_atomic_fetch_add((unsigned*)(F.ctl + CW_Q), 1u, __ATOMIC_RELAXED, __HIP_MEMORY_SCOPE_AGENT); __syncthreads();
            const int u = (int)F.MISC[0]; if (u >= BATCH * 8 * 8) break; mb::moba_unit(F, u, (bf16*)(ws + WS_Z)); }
#else
        if (F.vcu < 32) gla_unit(F, F.vcu, (bf16*)(ws + WS_ATT));
        for (;;) { __syncthreads(); if (F.tid == 0) F.MISC[0] = __hip_atomic_fetch_add((unsigned*)(F.ctl + CW_Q), 1u, __ATOMIC_RELAXED, __HIP_MEMORY_SCOPE_AGENT); __syncthreads();
            const int u = (int)F.MISC[0]; if (u >= BATCH * 8 * 8) break; mb::moba_unit(F, u, (bf16*)(ws + WS_ATT)); }
#endif
        if (BOTH(3)) GRID_BAR();
#if CHECK_GLA
        check_diff_bf16(F, (const bf16*)(ws + WS_ATT), (const bf16*)(ws + WS_Z), 1024, 2048, F.ctl + CW_CHK); GRID_BAR();
#elif CHECK_MOBA
        check_diff_bf16(F, (const bf16*)(ws + WS_ATT), (const bf16*)(ws + WS_Z), 0, 1024, F.ctl + CW_CHK); GRID_BAR();
#endif
    }
    if (IN(4)) {
        pg8::Gemm g{(const pg8::bf16_t*)(ws + WS_ATT), (const pg8::bf16_t*)(ws + WS_WOUT), TOK, DM, DM}; pg8::StaticOrder S; S.init(TOK, DM, F.G, (int)blockIdx.x);
        EpiRes E{F.in[0], (float*)(ws + WS_Z), DN_ALPHA};
        pg8::gemm_phase<EpiRes, pg8::StaticOrder, PG8_ALIGN, PG8_SP2>(F.lds + RING_OFF, g, S, E);
        if (BOTH(4)) GRID_BAR();
    }
    if (IN(5)) { ln_phase(F, F.in[7], F.in[8]); if (BOTH(5)) GRID_BAR(); }
    if (IN(6)) {
        pg8::Gemm g{(const pg8::bf16_t*)(ws + WS_HB), (const pg8::bf16_t*)(ws + WS_WQ), TOK, DM, DM}; pg8::StaticOrder S; S.init(TOK, DM, F.G, (int)blockIdx.x);
        pg8::EpiBf16<0> E{(pg8::bf16_t*)(ws + WS_Q), DM, nullptr, 0, 0, 1.f};
        pg8::gemm_phase<pg8::EpiBf16<0>, pg8::StaticOrder, PG8_ALIGN, PG8_SP2>(F.lds + RING_OFF, g, S, E);
        if (BOTH(6)) GRID_BAR();
    }
    if (IN(7)) {
#if CHECK_XATT
        for (int u = F.vcu; u < BATCH * 4 * 32; u += F.G) naive_attn_unit<512, 32, 1>(F, u);
        for (int u = F.vcu; u < BATCH * 4 * 8; u += F.G) mb::xattn_unit(F, u, (bf16*)(ws + WS_ATT));
        GRID_BAR(); check_diff_bf16(F, (const bf16*)(ws + WS_XO), (const bf16*)(ws + WS_ATT), 0, 2048, F.ctl + CW_CHK);
#else
        for (int u = F.vcu; u < BATCH * 4 * 8; u += F.G) mb::xattn_unit(F, u, (bf16*)(ws + WS_XO));
#endif
        if (BOTH(7)) GRID_BAR(); }
    if (IN(8)) {
        pg8::Gemm g{(const pg8::bf16_t*)(ws + WS_XO), (const pg8::bf16_t*)(ws + WS_WO), TOK, DM, DM}; pg8::StaticOrder S; S.init(TOK, DM, F.G, (int)blockIdx.x);
        EpiRes E{(const float*)(ws + WS_Z), (float*)(ws + WS_Z), DN_ALPHA};
        pg8::gemm_phase<EpiRes, pg8::StaticOrder, PG8_ALIGN, PG8_SP2>(F.lds + RING_OFF, g, S, E);
        if (BOTH(8)) GRID_BAR();
    }
    if (IN(9)) {
        ln_phase(F, F.in[12], F.in[13]);
        cvt_fp8_rows(F, F.in[16], ws + WS_PU8, (float*)(ws + WS_SU), 16384);
        cvt_fp8_rows(F, F.in[17], ws + WS_PV8, (float*)(ws + WS_SV), 16384);
        if (BOTH(9)) GRID_BAR();
    }
    if (IN(10)) {
        pg8::Gemm g{(const pg8::bf16_t*)(ws + WS_HB), (const pg8::bf16_t*)(ws + WS_WPQ), TOK, DM, DM}; pg8::StaticOrder S; S.init(TOK, DM, F.G, (int)blockIdx.x);
        pg8::EpiBf16<0> E{(pg8::bf16_t*)(ws + WS_Q), DM, nullptr, 0, 0, 1.f};
        pg8::gemm_phase<pg8::EpiBf16<0>, pg8::StaticOrder, PG8_ALIGN, PG8_SP2>(F.lds + RING_OFF, g, S, E);
        if (BOTH(10)) GRID_BAR();
    }
    if (IN(11)) { peer_phase(F);
#if PROBE_PEER2
        peer_phase(F);
#endif
#if CHECK_ANY
        if (blockIdx.x == 0 && F.tid == 0) { const float md = __uint_as_float(__hip_atomic_load((unsigned*)(F.ctl + CW_CHK), __ATOMIC_RELAXED, __HIP_MEMORY_SCOPE_AGENT)); F.out[0] += 1000.f * md; }
#endif
    }
#undef IN
#undef BOTH
}

extern "C" void kernel_launch(void* const* d_in, const int* in_sizes, int n_in, void* d_out, int out_size, void* d_ws, size_t ws_size, hipStream_t stream) {
    static int grid = 0;
    if (grid == 0) {
        if (n_in != 20 || out_size != TOK * DM || ws_size < WS_END) { fprintf(stderr, "kernel_launch: unexpected shapes (n_in %d out %d ws %zu)\n", n_in, out_size, ws_size); grid = -1; return; }
        int dev = 0, cus = 0;
        if (hipGetDevice(&dev) != hipSuccess || hipDeviceGetAttribute(&cus, hipDeviceAttributeMultiprocessorCount, dev) != hipSuccess) { grid = -1; return; }
        if (hipFuncSetAttribute((const void*)mk_fwd, hipFuncAttributeMaxDynamicSharedMemorySize, LDS_BYTES) != hipSuccess) { fprintf(stderr, "kernel_launch: hipFuncSetAttribute failed\n"); grid = -1; return; }
        (void)hipGetLastError();
        grid = cus;
    }
    if (grid < 0) return;
    (void)hipMemsetAsync((char*)d_ws + WS_CTL, 0, CTL_ZERO_BYTES, stream);
    Args a{};
    for (int i = 0; i < 20; ++i) a.in[i] = (const float*)d_in[i];
    a.out = (float*)d_out; a.ws = (unsigned char*)d_ws;
    if (N_LAUNCHES == 1) { a.ph_lo = 0; a.ph_hi = PER_PHASE; a.li = 0; hipLaunchKernelGGL(mk_fwd, dim3(grid), dim3(NWAVES * 64), LDS_BYTES, stream, a); }
    else for (int li = 0; li < PER_PHASE; ++li) { a.ph_lo = li; a.ph_hi = li + 1; a.li = li; hipLaunchKernelGGL(mk_fwd, dim3(grid), dim3(NWAVES * 64), LDS_BYTES, stream, a); }
}
```

```cpp
#include <hip/hip_runtime.h>
#include <cstdio>
#include <cstdint>
namespace pg8 {
#define PG8_LAS __attribute__((address_space(3)))
typedef unsigned short bf16_t;
typedef short bf16x8 __attribute__((ext_vector_type(8)));
typedef float f32x4 __attribute__((ext_vector_type(4)));
typedef unsigned u32x4 __attribute__((ext_vector_type(4)));
constexpr int BM = 256, BK = 64, HALF = 128, HTB = HALF * BK * 2  , STAGE_BYTES = 8 * HTB, NXCD = 8, WGM = 8;

__host__ __device__ __forceinline__ int lds_byte(int r, int c) { const int st = (r >> 4) * 2 + (c >> 5), rr = r & 15, cc = c & 31, ob = rr * 64 + cc * 2; return st * 1024 + (ob ^ (((ob >> 9) & 1) << 5)); }
__host__ __device__ __forceinline__ void stage_rc(int b, int& R, int& C) { const int st = b / 1024, sb = b % 1024, swz = sb ^ (((sb >> 9) & 1) << 5); R = (st >> 1) * 16 + swz / 64; C = (st & 1) * 32 + (swz % 64) / 2; }
__host__ __device__ __forceinline__ int perm32(int rho) { const int n = rho >> 4, i = rho & 15; return 8 * (i >> 2) + 4 * n + (i & 3); }

struct Unit { int pm, pn; };
struct Gemm { const bf16_t* A; const bf16_t* Bt; int M, N, K; };

struct StaticOrder {
    int nM, nN, nwg, G, c;
    __host__ __device__ void init(int M, int N, int G_, int c_) { nM = M / BM; nN = N / BM; nwg = nM * nN; G = G_; c = c_; }
    __host__ __device__ bool next(int i, Unit& u) const {
        const long L = (long)i * G + c; if (L >= nwg) return false;
        int wgid = (int)L; { const int q = nwg / NXCD, r = nwg % NXCD, xcd = wgid % NXCD, off = wgid / NXCD; wgid = (xcd < r ? xcd * (q + 1) : r * (q + 1) + (xcd - r) * q) + off; }
        const int nig = WGM * nN, gid = wgid / nig, fm = gid * WGM, gsz = (nM - fm) < WGM ? (nM - fm) : WGM;
        u.pm = fm + ((wgid % nig) % gsz); u.pn = (wgid % nig) / gsz; return true;
    }
    __device__ __forceinline__ void a_ready(const Unit&) const {}
    __device__ __forceinline__ void done(const Unit&) const {}
};

__device__ __forceinline__ unsigned cvt_pk_bf16(float lo, float hi) { unsigned r; asm volatile("v_cvt_pk_bf16_f32 %0, %1, %2" : "=v"(r) : "v"(lo), "v"(hi)); return r; }
typedef float f32x2 __attribute__((ext_vector_type(2)));
__device__ __forceinline__ f32x2 gelu_pk(f32x2 v) {
    const f32x2 av = __builtin_elementwise_abs(v), d = av * 0.2316418882f + 1.0f;
    f32x2 t; t.x = __builtin_amdgcn_rcpf(d.x); t.y = __builtin_amdgcn_rcpf(d.y);
    f32x2 q = t * 0.5307027145f + (-0.7265760135f); q = q * t + 0.7107068705f; q = q * t + (-0.142248368f); q = q * t + 0.127414796f; q = q * t;
    const f32x2 s = (v * v) * (-0.72134752044f);
    f32x2 e; e.x = __builtin_amdgcn_exp2f(s.x); e.y = __builtin_amdgcn_exp2f(s.y);
    const f32x2 m = v * (q * e), r = v - m;
    f32x2 o; o.x = v.x < 0.f ? m.x : r.x; o.y = v.y < 0.f ? m.y : r.y; return o;
}

template <int ACT  > struct EpiBf16 {
    static constexpr bool PERM = true, AFTER_DRAIN = false; static_assert(ACT == 0 || ACT == 1, "EpiBf16: ACT is 0 (none) or 1 (gelu_pk)");
    bf16_t* O; int ldc; const float* bias; int split_cols; size_t split_stride; float scale0;
    __device__ __forceinline__ void operator()(const f32x4 (&acc)[2][2][4][2], const Unit& u, int wr, int wc, int fr, int fq) const {
        const int row0 = u.pm * BM + wr * 64 + fr; int colt = u.pn * BM; bf16_t* base = O;
        float sc = 1.f; if (split_cols) { const int t = colt / split_cols; base += (size_t)t * split_stride; colt -= t * split_cols; if (t == 0) sc = scale0; }
        const int col0 = colt + wc * 32 + 8 * fq, bcol0 = u.pn * BM + wc * 32 + 8 * fq;
        f32x4 bv[2][2];
#pragma unroll
        for (int bj = 0; bj < 2; ++bj)
#pragma unroll
            for (int n = 0; n < 2; ++n) bv[bj][n] = bias ? *(const f32x4*)(bias + bcol0 + bj * HALF + 4 * n) : (f32x4){0.f, 0.f, 0.f, 0.f};
#pragma unroll
        for (int ai = 0; ai < 2; ++ai)
#pragma unroll
            for (int m = 0; m < 4; ++m) { bf16_t* rowp = base + (size_t)(row0 + ai * HALF + m * 16) * ldc + col0;
#pragma unroll
                for (int bj = 0; bj < 2; ++bj) { f32x4 v0 = acc[ai][bj][m][0] + bv[bj][0], v1 = acc[ai][bj][m][1] + bv[bj][1];
                    if (ACT == 1) { f32x2 a = gelu_pk((f32x2){v0[0], v0[1]}), b = gelu_pk((f32x2){v0[2], v0[3]}), c = gelu_pk((f32x2){v1[0], v1[1]}), d = gelu_pk((f32x2){v1[2], v1[3]});
                        v0 = (f32x4){a.x, a.y, b.x, b.y}; v1 = (f32x4){c.x, c.y, d.x, d.y}; }
                    v0 = v0 * sc; v1 = v1 * sc; u32x4 w; w.x = cvt_pk_bf16(v0[0], v0[1]); w.y = cvt_pk_bf16(v0[2], v0[3]); w.z = cvt_pk_bf16(v1[0], v1[1]); w.w = cvt_pk_bf16(v1[2], v1[3]);
                    *(u32x4*)(rowp + bj * HALF) = w; } }
    }
};

struct PanelStats {
    unsigned* xbuf;
    unsigned* cnt;
    unsigned* tmo;
    int ntn; float eps;
    unsigned code;
    __device__ __forceinline__ bool run(const f32x4 (&v)[2][2][4][2], const Unit& u, int wr, int wc, int fr, int fq, PG8_LAS unsigned char* lds, int wid, int lane) const {
        typedef float f32x2v __attribute__((ext_vector_type(2)));
        PG8_LAS f32x2v* P = (PG8_LAS f32x2v*)lds;
        PG8_LAS f32x2v* S = (PG8_LAS f32x2v*)(lds + 8192);
        PG8_LAS unsigned* flag = (PG8_LAS unsigned*)(lds + 8192 + 2048);
#pragma unroll
        for (int ai = 0; ai < 2; ++ai)
#pragma unroll
            for (int m = 0; m < 4; ++m) {
                float s = 0.f;
#pragma unroll
                for (int bj = 0; bj < 2; ++bj)
#pragma unroll
                    for (int n = 0; n < 2; ++n) { const f32x4 x = v[ai][bj][m][n]; s += (x[0] + x[1]) + (x[2] + x[3]); }
                s += __shfl_xor(s, 16); s += __shfl_xor(s, 32);
                const float mw = s * (1.0f / 64.0f); float q = 0.f;
#pragma unroll
                for (int bj = 0; bj < 2; ++bj)
#pragma unroll
                    for (int n = 0; n < 2; ++n) { const f32x4 d = v[ai][bj][m][n] - mw; q += (d[0] * d[0] + d[1] * d[1]) + (d[2] * d[2] + d[3] * d[3]); }
                q += __shfl_xor(q, 16); q += __shfl_xor(q, 32);
                if (fq == 0) P[(ai * HALF + wr * 64 + m * 16 + fr) * 4 + wc] = (f32x2v){mw, q};
            }
        asm volatile("s_waitcnt lgkmcnt(0)" ::: "memory"); __builtin_amdgcn_s_barrier(); asm volatile("" ::: "memory");
#if defined(BROKEN_EXCHANGE_NO_WAIT)
#warning BROKEN CONTROL BUILD: the row-statistics exchange does not wait; results are wrong by design
        if (blockIdx.x >= 64) { const long long t0_ = clock64(); while (clock64() - t0_ < 60000) __builtin_amdgcn_s_sleep(8); }
#endif
        const int row = wid * 32 + (lane & 31);
        if (lane < 32) {
            const f32x2v a = P[row * 4 + 0], b = P[row * 4 + 1], c = P[row * 4 + 2], d = P[row * 4 + 3];
            const float mt = (a.x + b.x + c.x + d.x) * 0.25f;
            const float da = a.x - mt, db = b.x - mt, dc = c.x - mt, dd = d.x - mt;
            const float m2 = (a.y + b.y) + (c.y + d.y) + 64.0f * ((da * da + db * db) + (dc * dc + dd * dd));
            unsigned long long* slot = (unsigned long long*)xbuf + ((size_t)(u.pm * BM + row) * 4 + u.pn);
            __hip_atomic_store(slot, ((unsigned long long)__float_as_uint(m2) << 32) | __float_as_uint(mt), __ATOMIC_RELAXED, __HIP_MEMORY_SCOPE_AGENT);
        }
        asm volatile("s_waitcnt vmcnt(0)" ::: "memory");
        if (lane == 0) __hip_atomic_fetch_add(cnt + 64 * u.pm, 1u, __ATOMIC_RELAXED, __HIP_MEMORY_SCOPE_AGENT);
        if (wid == 0) {
            bool dead = false; const unsigned long long t0 = __builtin_amdgcn_s_memrealtime(); const unsigned want = 8u * (unsigned)ntn;
            for (;;) {
#if defined(BROKEN_EXCHANGE_NO_WAIT)
                break;
#endif
                if ((unsigned)__builtin_amdgcn_readfirstlane(__hip_atomic_load(cnt + 64 * u.pm, __ATOMIC_RELAXED, __HIP_MEMORY_SCOPE_AGENT)) >= want) break;
                if (__builtin_amdgcn_s_memrealtime() - t0 > 2000000ull) {
                    if (lane == 0) { unsigned expect = 0u; __hip_atomic_compare_exchange_strong(tmo + 1, &expect, code | (unsigned)(u.pm & 0xff), __ATOMIC_RELAXED, __ATOMIC_RELAXED, __HIP_MEMORY_SCOPE_AGENT);
                                     __hip_atomic_store(tmo, 1u, __ATOMIC_RELAXED, __HIP_MEMORY_SCOPE_AGENT); }
                    dead = true; break; }
                __builtin_amdgcn_s_sleep(2);
            }
            __builtin_amdgcn_fence(__ATOMIC_ACQUIRE, "agent");
            if (lane == 0) flag[0] = dead ? 1u : 0u;
        }
        asm volatile("s_waitcnt vmcnt(0) lgkmcnt(0)" ::: "memory"); __builtin_amdgcn_s_barrier(); asm volatile("" ::: "memory");
        const bool bad = flag[0] != 0u;
        if (lane < 32) {
            const unsigned long long* slot = (const unsigned long long*)xbuf + (size_t)(u.pm * BM + row) * 4; float mt[4], m2[4]; float ms = 0.f;
#pragma unroll
            for (int t = 0; t < 4; ++t) { if (t < ntn) { const unsigned long long w = __hip_atomic_load(slot + t, __ATOMIC_RELAXED, __HIP_MEMORY_SCOPE_AGENT); mt[t] = __uint_as_float((unsigned)w); m2[t] = __uint_as_float((unsigned)(w >> 32)); } else { mt[t] = 0.f; m2[t] = 0.f; } ms += mt[t]; }
            const float mean = ms / (float)ntn; float q = 0.f;
#pragma unroll
            for (int t = 0; t < 4; ++t) if (t < ntn) { const float dm = mt[t] - mean; q += m2[t] + 256.0f * dm * dm; }
            S[row] = (f32x2v){mean, 1.0f / sqrtf(q / (256.0f * (float)ntn) + eps)};
        }
        asm volatile("s_waitcnt lgkmcnt(0)" ::: "memory"); __builtin_amdgcn_s_barrier(); asm volatile("" ::: "memory");
        return bad;
    }
};
struct EpiLnRes {
    static constexpr bool PERM = false, AFTER_DRAIN = true;
    const float* base; float* out; int ldc; const float* bias; PanelStats st; unsigned poison;
    __device__ __forceinline__ void fused(f32x4 (&acc)[2][2][4][2], const Unit& u, int wr, int wc, int fr, int fq, PG8_LAS unsigned char* lds, int wid, int lane) const {
        typedef float f32x2v __attribute__((ext_vector_type(2)));
        const PG8_LAS f32x2v* S = (const PG8_LAS f32x2v*)(lds + 8192);
        const int col0 = u.pn * BM + wc * 32 + 4 * fq;
#pragma unroll
        for (int bj = 0; bj < 2; ++bj)
#pragma unroll
            for (int n = 0; n < 2; ++n) { const f32x4 bv = bias ? *(const f32x4*)(bias + col0 + bj * HALF + n * 16) : (f32x4){0.f, 0.f, 0.f, 0.f};
#pragma unroll
                for (int ai = 0; ai < 2; ++ai)
#pragma unroll
                    for (int m = 0; m < 4; ++m) acc[ai][bj][m][n] += bv; }
        f32x4 pre[4][2][2];
#pragma unroll
        for (int m = 0; m < 4; ++m) { const size_t off = (size_t)(u.pm * BM + wr * 64 + m * 16 + fr) * ldc + col0;
#pragma unroll
            for (int bj = 0; bj < 2; ++bj)
#pragma unroll
                for (int n = 0; n < 2; ++n) pre[m][bj][n] = *(const f32x4*)(base + off + bj * HALF + n * 16); }
        const bool bad = st.run(acc, u, wr, wc, fr, fq, lds, wid, lane) || poison != 0u;
        const float qnan = __builtin_nanf("");
#pragma unroll
        for (int ai = 0; ai < 2; ++ai)
#pragma unroll
            for (int m = 0; m < 4; ++m) { const int r = ai * HALF + wr * 64 + m * 16 + fr; const f32x2v sr = S[r]; const size_t off = (size_t)(u.pm * BM + r) * ldc + col0;
#pragma unroll
                for (int bj = 0; bj < 2; ++bj)
#pragma unroll
                    for (int n = 0; n < 2; ++n) { const f32x4 bs = ai == 0 ? pre[m][bj][n] : *(const f32x4*)(base + off + bj * HALF + n * 16); f32x4 o = bs + (acc[ai][bj][m][n] - sr.x) * sr.y;
                        if (bad) o = (f32x4){qnan, qnan, qnan, qnan}; *(f32x4*)(out + off + bj * HALF + n * 16) = o; }
                if (m & 1) asm volatile("" ::: "memory"); }
    }
};
struct EpiLnResLn {
    static constexpr bool PERM = false, AFTER_DRAIN = true;
    const float* base; float* out; bf16_t* xn; int ldc; const float* bias; PanelStats st1, st2; unsigned poison;
    __device__ __forceinline__ void fused(f32x4 (&acc)[2][2][4][2], const Unit& u, int wr, int wc, int fr, int fq, PG8_LAS unsigned char* lds, int wid, int lane) const {
        typedef float f32x2v __attribute__((ext_vector_type(2))); typedef unsigned u32x2v __attribute__((ext_vector_type(2)));
        const PG8_LAS f32x2v* S = (const PG8_LAS f32x2v*)(lds + 8192);
        const int col0 = u.pn * BM + wc * 32 + 4 * fq;
#pragma unroll
        for (int bj = 0; bj < 2; ++bj)
#pragma unroll
            for (int n = 0; n < 2; ++n) { const f32x4 bv = bias ? *(const f32x4*)(bias + col0 + bj * HALF + n * 16) : (f32x4){0.f, 0.f, 0.f, 0.f};
#pragma unroll
                for (int ai = 0; ai < 2; ++ai)
#pragma unroll
                    for (int m = 0; m < 4; ++m) acc[ai][bj][m][n] += bv; }
        bool bad = st1.run(acc, u, wr, wc, fr, fq, lds, wid, lane) || poison != 0u;
        const float qnan = __builtin_nanf("");
#pragma unroll
        for (int ai = 0; ai < 2; ++ai)
#pragma unroll
            for (int m = 0; m < 4; ++m) { const int r = ai * HALF + wr * 64 + m * 16 + fr; const f32x2v sr = S[r]; const size_t off = (size_t)(u.pm * BM + r) * ldc + col0;
#pragma unroll
                for (int bj = 0; bj < 2; ++bj)
#pragma unroll
                    for (int n = 0; n < 2; ++n) { const f32x4 bs = *(const f32x4*)(base + off + bj * HALF + n * 16); acc[ai][bj][m][n] = bs + (acc[ai][bj][m][n] - sr.x) * sr.y; }
                asm volatile("" : "+v"(acc[ai][0][m][0]), "+v"(acc[ai][0][m][1]), "+v"(acc[ai][1][m][0]), "+v"(acc[ai][1][m][1]));
                if (m & 1) asm volatile("" ::: "memory"); }
        const bool bad1 = bad;
        bad = st2.run(acc, u, wr, wc, fr, fq, lds, wid, lane) || bad;
#pragma unroll
        for (int ai = 0; ai < 2; ++ai)
#pragma unroll
            for (int m = 0; m < 4; ++m) { const int r = ai * HALF + wr * 64 + m * 16 + fr; const f32x2v sr = S[r]; const size_t off = (size_t)(u.pm * BM + r) * ldc + col0;
#pragma unroll
                for (int bj = 0; bj < 2; ++bj)
#pragma unroll
                    for (int n = 0; n < 2; ++n) { const f32x4 x1 = acc[ai][bj][m][n]; *(f32x4*)(out + off + bj * HALF + n * 16) = bad1 ? (f32x4){qnan, qnan, qnan, qnan} : x1;
                        const f32x4 o = (x1 - sr.x) * sr.y; u32x2v w; w.x = cvt_pk_bf16(o[0], o[1]); w.y = cvt_pk_bf16(o[2], o[3]);
                        if (bad) { w.x = 0x7fc07fc0u; w.y = 0x7fc07fc0u; } *(u32x2v*)(xn + off + bj * HALF + n * 16) = w; }
                asm volatile("" ::: "memory"); }
    }
};

template <class Epi, class Sched, bool ALIGN_EPI = false, bool SP2 = false>
__device__ __forceinline__ void gemm_phase(PG8_LAS unsigned char* lds, const Gemm g, const Sched& S, const Epi& E) {
    const int tid = threadIdx.x, wid = __builtin_amdgcn_readfirstlane(tid >> 6), lane = tid & 63, wr = wid >> 2, wc = wid & 3, fr = lane & 15, fq = lane >> 4;
    const int K = g.K, nt = K / BK;
    unsigned voffA[2], voffB[2];
#pragma unroll
    for (int i = 0; i < 2; ++i) { int R, C; stage_rc(tid * 16 + i * 8192, R, C); const int Rb = Epi::PERM ? ((R & ~31) + perm32(R & 31)) : R;
        voffA[i] = (unsigned)(R * K + C) * 2u; voffB[i] = (unsigned)(Rb * K + C) * 2u; }
    const size_t kstep = (size_t)(BK * 2);
    const size_t hstep = (size_t)HALF * K * 2;
    const size_t tstep = 2 * hstep;
    const unsigned ldsw = (unsigned)wid * 1024u;
    const int aoff = lds_byte(wr * 64 + fr, fq * 8), boff = lds_byte(wc * 32 + fr, fq * 8);
#define PG8_SA(b, h) (((b) * 2 + (h)) * HTB)
#define PG8_SB(b, h) ((4 + (b) * 2 + (h)) * HTB)
#define PG8_STAGE(bufoff, gbase, voff) do { _Pragma("unroll") for (int _i = 0; _i < 2; ++_i) \
        __builtin_amdgcn_global_load_lds((const unsigned*)((const char*)(gbase) + (voff)[_i]), (PG8_LAS unsigned*)(lds + (bufoff) + ldsw + _i * 8192), 16, 0, 0); } while (0)
#define PG8_LDA(dst, b, h) do { _Pragma("unroll") for (int m = 0; m < 4; ++m) _Pragma("unroll") for (int k = 0; k < 2; ++k) dst[m][k] = *(const PG8_LAS bf16x8*)(lds + PG8_SA(b, h) + aoff + m * 2048 + k * 1024); } while (0)
#define PG8_LDB(dst, b, h) do { _Pragma("unroll") for (int n = 0; n < 2; ++n) _Pragma("unroll") for (int k = 0; k < 2; ++k) dst[n][k] = *(const PG8_LAS bf16x8*)(lds + PG8_SB(b, h) + boff + n * 2048 + k * 1024); } while (0)
#define PG8_MMA(ai, bj, At, Bt) do { __builtin_amdgcn_s_setprio(1); _Pragma("unroll") for (int m = 0; m < 4; ++m) _Pragma("unroll") for (int n = 0; n < 2; ++n) _Pragma("unroll") for (int k = 0; k < 2; ++k) \
        acc[ai][bj][m][n] = __builtin_amdgcn_mfma_f32_16x16x32_bf16(Bt[n][k], At[m][k], acc[ai][bj][m][n], 0, 0, 0); __builtin_amdgcn_s_setprio(0); } while (0)
#define PG8_WAIT_V(n) asm volatile("s_waitcnt vmcnt(" #n ")" ::: "memory")
#define PG8_WAIT_L(n) asm volatile("s_waitcnt lgkmcnt(" #n ")" ::: "memory")
#define PG8_BAR __builtin_amdgcn_s_barrier()
#define PG8_SCHED __builtin_amdgcn_sched_barrier(0)
    Unit cur, nxt; int ui = 0;
    if (!S.next(0, cur)) return;
    f32x4 acc[2][2][4][2];
#pragma unroll
    for (int a = 0; a < 2; ++a)
#pragma unroll
        for (int b = 0; b < 2; ++b)
#pragma unroll
            for (int m = 0; m < 4; ++m)
#pragma unroll
                for (int n = 0; n < 2; ++n) acc[a][b][m][n] = (f32x4){0.f, 0.f, 0.f, 0.f};
    bf16x8 At[4][2], B0[2][2], B1[2][2];
    const char* cA = (const char*)g.A + (size_t)cur.pm * tstep; const char* cB = (const char*)g.Bt + (size_t)cur.pn * tstep;
    S.a_ready(cur);
    if constexpr (SP2) {
        PG8_STAGE(PG8_SB(0, 0), cB, voffB); PG8_STAGE(PG8_SB(0, 1), cB + hstep, voffB); PG8_STAGE(PG8_SA(0, 0), cA, voffA); PG8_STAGE(PG8_SA(0, 1), cA + hstep, voffA);
        if (wr == 1) PG8_BAR;
        PG8_WAIT_V(2); PG8_BAR;
        PG8_STAGE(PG8_SB(1, 0), cB + kstep, voffB); PG8_STAGE(PG8_SA(1, 0), cA + kstep, voffA); PG8_STAGE(PG8_SB(1, 1), cB + hstep + kstep, voffB);
        PG8_WAIT_V(6); PG8_BAR;
    } else {
        PG8_STAGE(PG8_SB(0, 0), cB, voffB); PG8_STAGE(PG8_SA(0, 0), cA, voffA); PG8_STAGE(PG8_SB(0, 1), cB + hstep, voffB); PG8_STAGE(PG8_SA(0, 1), cA + hstep, voffA);
        if (wr == 1) PG8_BAR;
        PG8_WAIT_V(4); PG8_BAR;
        PG8_STAGE(PG8_SB(1, 0), cB + kstep, voffB); PG8_STAGE(PG8_SA(1, 0), cA + kstep, voffA); PG8_STAGE(PG8_SB(1, 1), cB + hstep + kstep, voffB);
        PG8_WAIT_V(6); PG8_BAR;
    }
    for (;;) {
        const bool has_next = S.next(ui + 1, nxt);
        const char* nA = has_next ? (const char*)g.A + (size_t)nxt.pm * tstep : cA; const char* nB = has_next ? (const char*)g.Bt + (size_t)nxt.pn * tstep : cB;
        for (int t = 0; t < nt; t += 2) {
            const bool last = (t == nt - 2);
            const char* a1 = cA + (size_t)(t + 1) * kstep;
            const char* a2 = last ? nA : cA + (size_t)(t + 2) * kstep; const char* b2 = last ? nB : cB + (size_t)(t + 2) * kstep;
            const char* a3 = a2 + kstep; const char* b3 = b2 + kstep;
            if (last && has_next) S.a_ready(nxt);
            if constexpr (SP2) {
            PG8_LDB(B0, 0, 0); PG8_LDB(B1, 0, 1); PG8_SCHED; PG8_LDA(At, 0, 0); PG8_STAGE(PG8_SA(1, 1), a1 + hstep, voffA);
            PG8_WAIT_V(8); PG8_WAIT_L(0); PG8_BAR; PG8_MMA(0, 0, At, B0); PG8_MMA(0, 1, At, B1); PG8_BAR; PG8_SCHED;
            PG8_LDA(At, 0, 1); PG8_STAGE(PG8_SB(0, 0), b2, voffB); PG8_STAGE(PG8_SB(0, 1), b2 + hstep, voffB); PG8_STAGE(PG8_SA(0, 0), a2, voffA);
            PG8_WAIT_V(8); PG8_WAIT_L(0); PG8_BAR; PG8_MMA(1, 0, At, B0); PG8_MMA(1, 1, At, B1); PG8_BAR; PG8_SCHED;
            PG8_LDB(B0, 1, 0); PG8_LDB(B1, 1, 1); PG8_SCHED; PG8_LDA(At, 1, 0); PG8_STAGE(PG8_SA(0, 1), a2 + hstep, voffA);
            PG8_WAIT_V(8); PG8_WAIT_L(0); PG8_BAR; PG8_MMA(0, 0, At, B0); PG8_MMA(0, 1, At, B1); PG8_BAR; PG8_SCHED;
            PG8_LDA(At, 1, 1); PG8_STAGE(PG8_SB(1, 0), b3, voffB); PG8_STAGE(PG8_SB(1, 1), b3 + hstep, voffB); PG8_STAGE(PG8_SA(1, 0), a3, voffA);
            PG8_WAIT_V(8); PG8_WAIT_L(0); PG8_BAR; PG8_MMA(1, 0, At, B0); PG8_MMA(1, 1, At, B1); PG8_BAR; PG8_SCHED;
            } else {
            PG8_LDB(B0, 0, 0); PG8_SCHED; PG8_LDA(At, 0, 0); PG8_STAGE(PG8_SA(1, 1), a1 + hstep, voffA);
            PG8_WAIT_L(8); PG8_BAR; PG8_WAIT_L(0); PG8_MMA(0, 0, At, B0); PG8_BAR; PG8_SCHED;
            PG8_LDB(B1, 0, 1); PG8_STAGE(PG8_SB(0, 0), b2, voffB);
            PG8_BAR; PG8_WAIT_L(0); PG8_MMA(0, 1, At, B1); PG8_BAR;
            PG8_LDA(At, 0, 1); PG8_STAGE(PG8_SA(0, 0), a2, voffA);
            PG8_BAR; PG8_WAIT_L(0); PG8_MMA(1, 0, At, B0); PG8_BAR; PG8_SCHED;
            PG8_STAGE(PG8_SB(0, 1), b2 + hstep, voffB);
            PG8_WAIT_V(6); PG8_BAR; PG8_MMA(1, 1, At, B1); PG8_BAR;
            PG8_LDB(B0, 1, 0); PG8_SCHED; PG8_LDA(At, 1, 0); PG8_STAGE(PG8_SA(0, 1), a2 + hstep, voffA);
            PG8_WAIT_L(8); PG8_BAR; PG8_WAIT_L(0); PG8_MMA(0, 0, At, B0); PG8_BAR; PG8_SCHED;
            PG8_LDB(B1, 1, 1); PG8_STAGE(PG8_SB(1, 0), b3, voffB);
            PG8_BAR; PG8_WAIT_L(0); PG8_MMA(0, 1, At, B1); PG8_BAR;
            PG8_LDA(At, 1, 1); PG8_STAGE(PG8_SA(1, 0), a3, voffA);
            PG8_BAR; PG8_WAIT_L(0); PG8_MMA(1, 0, At, B0); PG8_BAR; PG8_SCHED;
            PG8_STAGE(PG8_SB(1, 1), b3 + hstep, voffB);
            PG8_WAIT_V(6); PG8_BAR; PG8_MMA(1, 1, At, B1); PG8_BAR;
            }
        }
        if constexpr (ALIGN_EPI) { if (wr == 0) PG8_BAR; }
        if constexpr (!Epi::AFTER_DRAIN) { E(acc, cur, wr, wc, fr, fq); S.done(cur); }
        if (!has_next) break;
#pragma unroll
        for (int a = 0; a < 2; ++a)
#pragma unroll
            for (int b = 0; b < 2; ++b)
#pragma unroll
                for (int m = 0; m < 4; ++m)
#pragma unroll
                    for (int n = 0; n < 2; ++n) acc[a][b][m][n] = (f32x4){0.f, 0.f, 0.f, 0.f};
        cur = nxt; cA = nA; cB = nB; ++ui;
        if constexpr (ALIGN_EPI) { if (wr == 1) PG8_BAR; }
    }
    PG8_WAIT_V(0);
    if constexpr (!ALIGN_EPI) { if (wr == 0) PG8_BAR; }
    PG8_BAR;
    if constexpr (Epi::AFTER_DRAIN) { E.fused(acc, cur, wr, wc, fr, fq, lds, wid, lane); S.done(cur); }
#undef PG8_SA
#undef PG8_SB
#undef PG8_STAGE
#undef PG8_LDA
#undef PG8_LDB
#undef PG8_MMA
#undef PG8_WAIT_V
#undef PG8_WAIT_L
#undef PG8_BAR
#undef PG8_SCHED
}
}
#ifndef PG8_SP2
#define PG8_SP2 true
#endif
#ifndef PG8_ALIGN
#define PG8_ALIGN true
#endif
#include <cmath>
constexpr int NWAVES = 8;
#ifndef MK_N_LAUNCHES
#define MK_N_LAUNCHES 1
#endif
constexpr int PER_PHASE = 12;
constexpr int N_LAUNCHES = MK_N_LAUNCHES;

constexpr int BATCH = 8, SEQ = 2048, DM = 2048, TOK = BATCH * SEQ, MEMLEN = 256;
constexpr int NPROJ = 6144, NPROJ_PAD = 6400, WIN_COLS = 6160;
constexpr int C_QM = 0, C_KM = 1024, C_VM = 2048, C_QG = 3072, C_KG = 3584, C_VG = 4096, C_RG = 5120;
constexpr float DN_ALPHA = 1.189207115002721f;
constexpr float LN_EPS = 1e-5f, RMS_EPS = 1e-6f;

constexpr size_t MiB = 1u << 20;
constexpr size_t WS_CTL = 0, CTL_ZERO_BYTES = 1 * MiB;
constexpr size_t WS_SUBK = 1 * MiB, WS_KMEAN = 1 * MiB + 512 * 1024;
constexpr size_t WS_WOUT = 2 * MiB, WS_WQ = 10 * MiB, WS_WO = 18 * MiB, WS_WPQ = 26 * MiB;
constexpr size_t WS_KV = 34 * MiB, WS_GATE = 50 * MiB;
constexpr size_t WS_PROJ = 52 * MiB, WS_HB = 52 * MiB, WS_Q = 116 * MiB, WS_XO = 180 * MiB, WS_PU = 180 * MiB;
constexpr size_t WS_ATT = 244 * MiB, WS_PV = 244 * MiB;
constexpr size_t WS_PU8 = 180 * MiB, WS_PV8 = 212 * MiB, WS_SU = 1 * MiB + 512 * 1024, WS_SV = 1 * MiB + 512 * 1024 + 65536;
constexpr size_t WS_Z = 308 * MiB, WS_XB = 308 * MiB, WS_WIN = 372 * MiB, WS_WKV = 397 * MiB, WS_MEMB = 413 * MiB;
constexpr size_t WS_END = 436 * MiB;
constexpr int CW_BAR = 4096, CW_CHK = 8192, CW_Q = 8256;
#ifndef CHECK_GLA
#define CHECK_GLA 0
#endif
#ifndef CHECK_MOBA
#define CHECK_MOBA 0
#endif
#ifndef CHECK_XATT
#define CHECK_XATT 0
#endif
#ifndef PROBE_PEER2
#define PROBE_PEER2 0
#endif
#ifndef PROBE_MIX2
#define PROBE_MIX2 0
#endif
#define CHECK_ANY (CHECK_GLA || CHECK_MOBA || CHECK_XATT)

constexpr int RING_OFF = 0, RING_BYTES = 131072;
constexpr int LDSCTL_OFF = RING_BYTES, MISC_OFF = LDSCTL_OFF + 320;
constexpr int LDS_BYTES = 147456;
#define GAS __attribute__((address_space(1)))
#define LAS __attribute__((address_space(3)))
typedef unsigned short bf16;
typedef unsigned v4u __attribute__((ext_vector_type(4)));
typedef float f32x4 __attribute__((ext_vector_type(4)));
typedef short bf16x8 __attribute__((ext_vector_type(8)));
typedef GAS unsigned gu32;
typedef GAS unsigned long long gu64;
#define RLX_AGENT __ATOMIC_RELAXED, __HIP_MEMORY_SCOPE_AGENT
#define LDS_WAIT() asm volatile("s_waitcnt lgkmcnt(0)" ::: "memory")
#define VM_WAIT() asm volatile("s_waitcnt vmcnt(0)" ::: "memory")
__device__ __forceinline__ unsigned long long rt() { return __builtin_amdgcn_s_memrealtime(); }
__device__ __forceinline__ unsigned f2bf(float f) { unsigned u = __builtin_bit_cast(unsigned, f); return (u + 0x7fffu + ((u >> 16) & 1u)) >> 16; }
__device__ __forceinline__ unsigned pk2(float lo, float hi) { return f2bf(lo) | (f2bf(hi) << 16); }

#define XB_TMO      128
#define XB_XCNT(j)  (256  + 64 * (j))
#define XB_XSUB(j)  (1280 + 64 * (j))
#define XB_XGEN(j)  (2304 + 64 * (j))
#define XB_TOP      3328
#define XB_TOPGEN   3392
#define XCD_BAR_WORDS 3456
#define XB_SPIN_CAP (1u << 18)

__device__ __forceinline__ unsigned xb_ld(unsigned* p)              { return __hip_atomic_load(p, __ATOMIC_RELAXED, __HIP_MEMORY_SCOPE_AGENT); }
__device__ __forceinline__ unsigned xb_add(unsigned* p, unsigned v) { return __hip_atomic_fetch_add(p, v, __ATOMIC_RELAXED, __HIP_MEMORY_SCOPE_AGENT); }
__device__ __forceinline__ unsigned xb_xcc_id() { return (unsigned)__builtin_amdgcn_s_getreg((3 << 11) | 20) & 0xFu; }
#define XB_SPIN(cond, bar) do { unsigned _sp = 0; while (cond) { __builtin_amdgcn_s_sleep(1); \
    if ((++_sp & 255u) == 0u) { if (xb_ld(&(bar)[XB_TMO])) break; if (_sp > XB_SPIN_CAP) { atomicAdd(&(bar)[XB_TMO], 1u); break; } } } } while (0)

struct XcdBarrier {
    unsigned* bar; unsigned x;
    volatile LAS unsigned* st;
};

__device__ __forceinline__ XcdBarrier xcd_barrier_post(unsigned* bar, volatile LAS unsigned* st) {
    XcdBarrier b; b.bar = bar; b.x = xb_xcc_id(); b.st = st;
    if (threadIdx.x == 0) (void)xb_add(&bar[XB_XCNT(b.x)], 1u);
    return b;
}
__device__ __forceinline__ void xcd_barrier_complete(unsigned* bar, unsigned x, unsigned& nloc, unsigned& nx) {
    const unsigned G = gridDim.x * gridDim.y * gridDim.z;
    unsigned sum, cnt, mine, sp = 0u;
    for (;;) {
        sum = 0u; cnt = 0u; mine = 0u;
#pragma unroll
        for (unsigned j = 0; j < 16; ++j) { const unsigned c = xb_ld(&bar[XB_XCNT(j)]); sum += c; cnt += (c > 0u) ? 1u : 0u; mine = (j == x) ? c : mine; }
        if (sum == G) break;
        __builtin_amdgcn_s_sleep(1);
        if ((++sp & 255u) == 0u) { if (xb_ld(&bar[XB_TMO])) break; if (sp > XB_SPIN_CAP) { atomicAdd(&bar[XB_TMO], 1u); break; } }
    }
    nloc = mine > 0u ? mine : 1u; nx = cnt > 0u ? cnt : 1u;
}

__device__ __forceinline__ void xcd_barrier(const XcdBarrier& b) {
    asm volatile("s_waitcnt vmcnt(0)" ::: "memory");
    __syncthreads();
    if (threadIdx.x == 0) {
        unsigned* bar = b.bar;
        __builtin_amdgcn_s_waitcnt(0);
        unsigned nloc = b.st[0], nx = b.st[1];
        if (nloc == 0u) { xcd_barrier_complete(bar, b.x, nloc, nx); b.st[0] = nloc; b.st[1] = nx; }
        const unsigned old = xb_add(&bar[XB_XSUB(b.x)], 1u);
        const unsigned gen = old / nloc;
        if (old + 1u == (gen + 1u) * nloc) {
            __builtin_amdgcn_fence(__ATOMIC_RELEASE, "agent");
            asm volatile("s_waitcnt vmcnt(0)" ::: "memory");
            const unsigned og = xb_add(&bar[XB_TOP], 1u);
            const unsigned tg = og / nx;
            if (og + 1u == (tg + 1u) * nx) xb_add(&bar[XB_TOPGEN], 1u);
            else XB_SPIN(xb_ld(&bar[XB_TOPGEN]) == tg, bar);
            __builtin_amdgcn_fence(__ATOMIC_ACQUIRE, "agent");
            xb_add(&bar[XB_XGEN(b.x)], 1u);
            asm volatile("s_waitcnt vmcnt(0)" ::: "memory");
        } else {
            XB_SPIN(xb_ld(&bar[XB_XGEN(b.x)]) == gen, bar);
            __builtin_amdgcn_fence(__ATOMIC_ACQUIRE, "agent");
            asm volatile("s_waitcnt vmcnt(0)" ::: "memory");
        }
    }
    __syncthreads();
}
struct Frame {
    LAS unsigned char* lds;
    volatile LAS unsigned* MISC;
    gu32* ctl;
    int tid, lane, wave;
    int vcu, G;
    const float* in[20]; float* out; unsigned char* ws;
};
__device__ __forceinline__ float bf2f(unsigned short h) { return __uint_as_float(((unsigned)h) << 16); }
__device__ __forceinline__ float wave_sum(float v) {
#pragma unroll
    for (int o = 1; o < 64; o <<= 1) v += __shfl_xor(v, o);
    return v;
}
__device__ __forceinline__ float wave_max(float v) {
#pragma unroll
    for (int o = 1; o < 64; o <<= 1) v = fmaxf(v, __shfl_xor(v, o));
    return v;
}
typedef unsigned short us8 __attribute__((ext_vector_type(8)));

__device__ __forceinline__ void p0_transpose_item(const float* W, int K, int N, int Npad, bf16* WT, LAS float* scr, int item, int lane) {
    const int nblk = Npad / 32, kb = item / nblk, nb = item % nblk, k0 = 64 * kb, n0 = 32 * nb;
    const int nn = n0 + (lane & 31); const bool ok = nn < N;
#pragma unroll 8
    for (int i = 0; i < 32; ++i) { const int kk = 2 * i + (lane >> 5); scr[kk * 33 + (lane & 31)] = ok ? W[(size_t)(k0 + kk) * N + nn] : 0.f; }
    LDS_WAIT(); asm volatile("" ::: "memory");
    const int c = lane & 7;
#pragma unroll
    for (int j = 0; j < 4; ++j) { const int n = (lane >> 3) + 8 * j; const LAS float* s = scr + (8 * c) * 33 + n;
        v4u o; o.x = pk2(s[0 * 33], s[1 * 33]); o.y = pk2(s[2 * 33], s[3 * 33]); o.z = pk2(s[4 * 33], s[5 * 33]); o.w = pk2(s[6 * 33], s[7 * 33]);
        *(GAS v4u*)(WT + (size_t)(n0 + n) * K + k0 + 8 * c) = o; }
    LDS_WAIT(); asm volatile("" ::: "memory");
}
__device__ __forceinline__ void cvt_linear(Frame& F, const float* src, bf16* dst, size_t n8) {
    const size_t nth = (size_t)F.G * NWAVES * 64;
    for (size_t i = (size_t)F.vcu * NWAVES * 64 + F.tid; i < n8; i += nth) {
        const f32x4 a = *(const GAS f32x4*)(src + i * 8), b = *(const GAS f32x4*)(src + i * 8 + 4);
        v4u o; o.x = pk2(a.x, a.y); o.y = pk2(a.z, a.w); o.z = pk2(b.x, b.y); o.w = pk2(b.z, b.w);
        *(GAS v4u*)(dst + i * 8) = o;
    }
}
__device__ __forceinline__ void p0_prologue(Frame& F) {
    LAS float* scr = (LAS float*)(F.lds + RING_OFF + F.wave * 16384);
    const int gw = F.vcu * NWAVES + F.wave, NGW = F.G * NWAVES;
    constexpr int I_IN = (DM / 64) * (NPROJ_PAD / 32), I_SQ = (DM / 64) * (DM / 32), I_KV = (DM / 64) * (2 * DM / 32);
    constexpr int NITEMS = I_IN + 4 * I_SQ + I_KV;
    unsigned char* ws = F.ws;
    for (int it = gw; it < NITEMS; it += NGW) {
        int r = it;
        if (r < I_IN) { p0_transpose_item(F.in[2], DM, WIN_COLS, NPROJ_PAD, (bf16*)(ws + WS_WIN), scr, r, F.lane); continue; } r -= I_IN;
        if (r < I_KV) { p0_transpose_item(F.in[10], DM, 2 * DM, 2 * DM, (bf16*)(ws + WS_WKV), scr, r, F.lane); continue; } r -= I_KV;
        if (r < I_SQ) { p0_transpose_item(F.in[6], DM, DM, DM, (bf16*)(ws + WS_WOUT), scr, r, F.lane); continue; } r -= I_SQ;
        if (r < I_SQ) { p0_transpose_item(F.in[9], DM, DM, DM, (bf16*)(ws + WS_WQ), scr, r, F.lane); continue; } r -= I_SQ;
        if (r < I_SQ) { p0_transpose_item(F.in[11], DM, DM, DM, (bf16*)(ws + WS_WO), scr, r, F.lane); continue; } r -= I_SQ;
        p0_transpose_item(F.in[14], DM, DM, DM, (bf16*)(ws + WS_WPQ), scr, r, F.lane);
    }
    cvt_linear(F, F.in[0], (bf16*)(ws + WS_XB), (size_t)TOK * DM / 8);
    cvt_linear(F, F.in[1], (bf16*)(ws + WS_MEMB), (size_t)BATCH * MEMLEN * DM / 8);
    cvt_linear(F, F.in[15], (bf16*)(ws + WS_SUBK), (size_t)16 * 128 * 128 / 8);
}

struct EpiProj {
    static constexpr bool PERM = true, AFTER_DRAIN = false;
    pg8::bf16_t* O; float* gate;
    __device__ __forceinline__ void operator()(const pg8::f32x4 (&acc)[2][2][4][2], const pg8::Unit& u, int wr, int wc, int fr, int fq) const {
        const int row0 = u.pm * 256 + wr * 64 + fr;
        if (u.pn < 24) {
            const int col0 = u.pn * 256 + wc * 32 + 8 * fq;
#pragma unroll
            for (int ai = 0; ai < 2; ++ai)
#pragma unroll
                for (int m = 0; m < 4; ++m) { pg8::bf16_t* rowp = O + (size_t)(row0 + ai * 128 + m * 16) * NPROJ + col0;
#pragma unroll
                    for (int bj = 0; bj < 2; ++bj) { const pg8::f32x4 v0 = acc[ai][bj][m][0], v1 = acc[ai][bj][m][1];
                        pg8::u32x4 w; w.x = pg8::cvt_pk_bf16(v0[0], v0[1]); w.y = pg8::cvt_pk_bf16(v0[2], v0[3]); w.z = pg8::cvt_pk_bf16(v1[0], v1[1]); w.w = pg8::cvt_pk_bf16(v1[2], v1[3]);
                        *(pg8::u32x4*)(rowp + bj * 128) = w; } }
        } else if (wc == 0 && fq < 2) {
#pragma unroll
            for (int ai = 0; ai < 2; ++ai)
#pragma unroll
                for (int m = 0; m < 4; ++m) { float* gp = gate + (size_t)(row0 + ai * 128 + m * 16) * 16 + 8 * fq;
                    *(pg8::f32x4*)(gp) = acc[ai][0][m][0]; *(pg8::f32x4*)(gp + 4) = acc[ai][0][m][1]; }
        }
    }
};
struct EpiRes {
    static constexpr bool PERM = false, AFTER_DRAIN = false;
    const float* base; float* out; float alpha;
    __device__ __forceinline__ void operator()(const pg8::f32x4 (&acc)[2][2][4][2], const pg8::Unit& u, int wr, int wc, int fr, int fq) const {
        const int row0 = u.pm * 256 + wr * 64 + fr, col0 = u.pn * 256 + wc * 32 + 4 * fq;
#pragma unroll
        for (int ai = 0; ai < 2; ++ai)
#pragma unroll
            for (int m = 0; m < 4; ++m) { const size_t off = (size_t)(row0 + ai * 128 + m * 16) * DM + col0;
#pragma unroll
                for (int bj = 0; bj < 2; ++bj)
#pragma unroll
                    for (int n = 0; n < 2; ++n) { const pg8::f32x4 b = *(const pg8::f32x4*)(base + off + bj * 128 + n * 16);
                        *(pg8::f32x4*)(out + off + bj * 128 + n * 16) = b * alpha + acc[ai][bj][m][n]; } }
    }
};

__device__ __forceinline__ void kmean_phase(Frame& F) {
    const bf16* PROJ = (const bf16*)(F.ws + WS_PROJ); float* KMEAN = (float*)(F.ws + WS_KMEAN);
    const int gw = F.vcu * NWAVES + F.wave, NGW = F.G * NWAVES;
    for (int it = gw; it < BATCH * 8 * 16; it += NGW) {
        const int b = it >> 7, blk = (it >> 4) & 7, cc = it & 15;
        const bf16* p = PROJ + (size_t)(b * SEQ + blk * 256) * NPROJ + C_KM + cc * 64 + F.lane;
        float s = 0.f;
#pragma unroll 8
        for (int r = 0; r < 256; ++r) s += bf2f(p[(size_t)r * NPROJ]);
        KMEAN[(size_t)(b * 8 + blk) * 1024 + cc * 64 + F.lane] = s * (1.f / 256.f);
    }
}

template <int HD, int KC, int MODE>
__device__ __forceinline__ void naive_attn_unit(Frame& F, int unit) {
    constexpr int DPT = HD / 8, PIECES = KC * HD / 8;
    LAS bf16* Kc = (LAS bf16*)(F.lds + RING_OFF); LAS bf16* Vc = Kc + KC * HD;
    const int tid = F.tid, qi = tid >> 3, sub = tid & 7;
    int b, h, qt; const bf16 *Qp, *Kp, *Vp; bf16* Op; int ldq, ldk, ldo, nchunks, qb = 0, qpos = 0; float scale;
    if (MODE == 0) {
        b = unit >> 8; h = (unit >> 5) & 7; qt = unit & 31; qb = qt >> 2; qpos = qt * 64 + qi;
        const bf16* PROJ = (const bf16*)(F.ws + WS_PROJ);
        Qp = PROJ + (size_t)(b * SEQ + qt * 64 + qi) * NPROJ + C_QM + h * 128; ldq = NPROJ;
        Kp = PROJ + (size_t)(b * SEQ) * NPROJ + C_KM + h * 128; Vp = PROJ + (size_t)(b * SEQ) * NPROJ + C_VM + h * 128; ldk = NPROJ;
        Op = (bf16*)(F.ws + WS_ATT) + (size_t)(b * SEQ + qt * 64 + qi) * DM + h * 128; ldo = DM;
        nchunks = 4 * (qb + 1); scale = 0.08838834764831845f;
    } else {
        b = unit >> 7; h = (unit >> 5) & 3; qt = unit & 31;
        Qp = (const bf16*)(F.ws + WS_Q) + (size_t)(b * SEQ + qt * 64 + qi) * DM + h * 512; ldq = DM;
        const bf16* KV = (const bf16*)(F.ws + WS_KV);
        Kp = KV + (size_t)(b * MEMLEN) * (2 * DM) + h * 512; Vp = Kp + DM; ldk = 2 * DM;
        Op = (bf16*)(F.ws + WS_XO) + (size_t)(b * SEQ + qt * 64 + qi) * DM + h * 512; ldo = DM;
        nchunks = MEMLEN / KC; scale = 0.04419417382415922f;
    }
    (void)ldq; (void)ldo;
    float qv[DPT], o[DPT];
#pragma unroll
    for (int j = 0; j < DPT; j += 8) { const us8 w = *(const GAS us8*)(Qp + sub * DPT + j);
#pragma unroll
        for (int e = 0; e < 8; ++e) { qv[j + e] = bf2f(w[e]) * scale; o[j + e] = 0.f; } }
    unsigned sel = 0;
    if (MODE == 0) {
        const float* KM = (const float*)(F.ws + WS_KMEAN) + (size_t)(b * 8) * 1024 + h * 128 + sub * DPT;
        float g[8];
#pragma unroll
        for (int n = 0; n < 8; ++n) { float s = 0.f;
            if (n < qb) {
#pragma unroll
                for (int j = 0; j < DPT; ++j) s += qv[j] * KM[(size_t)n * 1024 + j]; }
            s += __shfl_xor(s, 1); s += __shfl_xor(s, 2); s += __shfl_xor(s, 4); g[n] = s; }
#pragma unroll
        for (int n = 0; n < 8; ++n) { int cnt = 0;
#pragma unroll
            for (int m = 0; m < 8; ++m) if (m != n && m < qb && (g[m] > g[n] || (g[m] == g[n] && m < n))) ++cnt;
            if (n < qb && cnt < 3) sel |= 1u << n; }
    }
    float mrun = -1e30f, lrun = 0.f;
    for (int c = 0; c < nchunks; ++c) {
        int key0; if (MODE == 0) key0 = (c < 4) ? qb * 256 + 64 * c : (c - 4) * 64; else key0 = c * KC;
        __syncthreads();
#pragma unroll
        for (int p = tid; p < PIECES; p += NWAVES * 64) { const int row = p / (HD / 8), c8 = p % (HD / 8);
            *(LAS v4u*)(Kc + row * HD + c8 * 8) = *(const GAS v4u*)(Kp + (size_t)(key0 + row) * ldk + c8 * 8);
            *(LAS v4u*)(Vc + row * HD + c8 * 8) = *(const GAS v4u*)(Vp + (size_t)(key0 + row) * ldk + c8 * 8); }
        __syncthreads();
        const bool blk_ok = (MODE == 1) || (c < 4) || ((sel >> ((c - 4) >> 2)) & 1u);
        for (int kk = 0; kk < KC; ++kk) {
            const LAS bf16* kr = Kc + kk * HD + sub * DPT; float part = 0.f;
#pragma unroll
            for (int j = 0; j < DPT; j += 8) { const us8 w = *(const LAS us8*)(kr + j);
#pragma unroll
                for (int e = 0; e < 8; ++e) part += qv[j + e] * bf2f(w[e]); }
            part += __shfl_xor(part, 1); part += __shfl_xor(part, 2); part += __shfl_xor(part, 4);
            bool ok = blk_ok; if (MODE == 0 && c < 4) ok = (key0 + kk) <= qpos;
            if (ok) {
                const float mn = fmaxf(mrun, part), al = __expf(mrun - mn), pp = __expf(part - mn);
                lrun = lrun * al + pp; mrun = mn;
                const LAS bf16* vr = Vc + kk * HD + sub * DPT;
#pragma unroll
                for (int j = 0; j < DPT; j += 8) { const us8 w = *(const LAS us8*)(vr + j);
#pragma unroll
                    for (int e = 0; e < 8; ++e) o[j + e] = o[j + e] * al + pp * bf2f(w[e]); }
            }
        }
    }
    const float inv = 1.f / lrun;
#pragma unroll
    for (int j = 0; j < DPT; j += 8) { v4u w; w.x = pk2(o[j] * inv, o[j + 1] * inv); w.y = pk2(o[j + 2] * inv, o[j + 3] * inv); w.z = pk2(o[j + 4] * inv, o[j + 5] * inv); w.w = pk2(o[j + 6] * inv, o[j + 7] * inv);
        *(GAS v4u*)(Op + sub * DPT + j) = w; }
}

__device__ __forceinline__ void naive_gla_unit(Frame& F, int unit) {
    const int b = unit >> 2, h = unit & 3, tid = F.tid, e = tid & 255, dh = tid >> 8;
    LAS float* GU = (LAS float*)(F.lds + RING_OFF);
    LAS float* GL = GU + 16 * 128;
    LAS float* As = GL + 32 * 16;
    LAS float* Ks = As + 32 * 128; LAS float* Qs = Ks + 32 * 128;
    LAS float* Op = Qs + 32 * 128;
    const bf16* PROJ = (const bf16*)(F.ws + WS_PROJ); const float* GATE = (const float*)(F.ws + WS_GATE);
    const float* gup = F.in[3]; const float* gbias = F.in[4]; const float* gnorm = F.in[5];
    bf16* ATT = (bf16*)(F.ws + WS_ATT);
    __syncthreads();
    for (int i = tid; i < 16 * 128; i += NWAVES * 64) GU[i] = gup[(size_t)(i >> 7) * 512 + h * 128 + (i & 127)];
    float st[64];
#pragma unroll
    for (int j = 0; j < 64; ++j) st[j] = 0.f;
    for (int ch = 0; ch < SEQ / 32; ++ch) {
        const size_t row0 = (size_t)b * SEQ + ch * 32;
        __syncthreads();
        GL[tid] = GATE[row0 * 16 + tid];
        __syncthreads();
        { const int tt = tid >> 4, dg = tid & 15;
          const us8 qw = *(const GAS us8*)(PROJ + (row0 + tt) * NPROJ + C_QG + h * 128 + dg * 8);
          const us8 kw = *(const GAS us8*)(PROJ + (row0 + tt) * NPROJ + C_KG + h * 128 + dg * 8);
#pragma unroll
          for (int j = 0; j < 8; ++j) { const int d = dg * 8 + j; float z = gbias[h * 128 + d];
#pragma unroll
              for (int r = 0; r < 16; ++r) z += GL[tt * 16 + r] * GU[r * 128 + d];
              const float ls = fminf(z, 0.f) - log1pf(__expf(-fabsf(z)));
              As[tt * 128 + d] = __expf(ls * (1.f / 16.f)); Ks[tt * 128 + d] = bf2f(kw[j]); Qs[tt * 128 + d] = bf2f(qw[j]) * 0.08838834764831845f; } }
        __syncthreads();
        for (int tt = 0; tt < 32; ++tt) {
            const float v = bf2f(PROJ[(row0 + tt) * NPROJ + C_VG + h * 256 + e]); float op = 0.f;
            const LAS float* ar = As + tt * 128 + dh * 64; const LAS float* kr = Ks + tt * 128 + dh * 64; const LAS float* qr = Qs + tt * 128 + dh * 64;
#pragma unroll
            for (int j = 0; j < 64; ++j) { st[j] = ar[j] * st[j] + kr[j] * v; op += qr[j] * st[j]; }
            Op[(dh * 32 + tt) * 256 + e] = op;
        }
        __syncthreads();
#pragma unroll
        for (int ti = 0; ti < 4; ++ti) { const int tt = F.wave * 4 + ti; float val[4], ss = 0.f;
#pragma unroll
            for (int i = 0; i < 4; ++i) { const int ee = F.lane + 64 * i; val[i] = Op[tt * 256 + ee] + Op[(32 + tt) * 256 + ee]; ss += val[i] * val[i]; }
            ss = wave_sum(ss); const float rs = 1.f / sqrtf(ss * (1.f / 256.f) + RMS_EPS);
#pragma unroll
            for (int i = 0; i < 4; ++i) { const int ee = F.lane + 64 * i; const float r = bf2f(PROJ[(row0 + tt) * NPROJ + C_RG + h * 256 + ee]);
                const float y = val[i] * rs * gnorm[ee] * (r / (1.f + __expf(-r)));
                ATT[(row0 + tt) * DM + 1024 + h * 256 + ee] = (bf16)f2bf(y); } }
    }
}

__device__ __forceinline__ void ln_phase(Frame& F, const float* g, const float* bb) {
    float* Z = (float*)(F.ws + WS_Z); bf16* HB = (bf16*)(F.ws + WS_HB);
    const int gw = F.vcu * NWAVES + F.wave, NGW = F.G * NWAVES;
    for (int m = gw; m < TOK; m += NGW) {
        GAS f32x4* zr = (GAS f32x4*)(Z + (size_t)m * DM) + F.lane;
        f32x4 v[8]; float s = 0.f;
#pragma unroll
        for (int j = 0; j < 8; ++j) { v[j] = zr[64 * j]; s += (v[j].x + v[j].y) + (v[j].z + v[j].w); }
        const float mean = wave_sum(s) * (1.f / DM); float s2 = 0.f;
#pragma unroll
        for (int j = 0; j < 8; ++j) { v[j] = v[j] - mean; s2 += (v[j].x * v[j].x + v[j].y * v[j].y) + (v[j].z * v[j].z + v[j].w * v[j].w); }
        const float rstd = 1.f / sqrtf(wave_sum(s2) * (1.f / DM) + LN_EPS);
        GAS unsigned long long* o8 = (GAS unsigned long long*)(HB + (size_t)m * DM) + F.lane;
#pragma unroll
        for (int j = 0; j < 8; ++j) { const f32x4 gg = *((const GAS f32x4*)g + F.lane + 64 * j), b4 = *((const GAS f32x4*)bb + F.lane + 64 * j);
            const f32x4 y = v[j] * rstd * gg + b4; zr[64 * j] = y;
            o8[64 * j] = (unsigned long long)pk2(y.x, y.y) | ((unsigned long long)pk2(y.z, y.w) << 32); }
    }
}

typedef short s16x8 __attribute__((ext_vector_type(8)));
__device__ __forceinline__ float dpp_max_all(float v) {
    int x = __float_as_int(v);
    v = fmaxf(v, __int_as_float(__builtin_amdgcn_update_dpp(x, x, 0xB1, 0xF, 0xF, false))); x = __float_as_int(v);
    v = fmaxf(v, __int_as_float(__builtin_amdgcn_update_dpp(x, x, 0x4E, 0xF, 0xF, false))); x = __float_as_int(v);
    v = fmaxf(v, __int_as_float(__builtin_amdgcn_update_dpp(x, x, 0x141, 0xF, 0xF, false))); x = __float_as_int(v);
    v = fmaxf(v, __int_as_float(__builtin_amdgcn_update_dpp(x, x, 0x140, 0xF, 0xF, false))); x = __float_as_int(v);
    v = fmaxf(v, __int_as_float(__builtin_amdgcn_update_dpp(x, x, 0x142, 0xA, 0xF, false))); x = __float_as_int(v);
    v = fmaxf(v, __int_as_float(__builtin_amdgcn_update_dpp(x, x, 0x143, 0xC, 0xF, false)));
    return __int_as_float(__builtin_amdgcn_readlane(__float_as_int(v), 63));
}
__device__ __forceinline__ float dpp_sum_all(float v) {
    v += __int_as_float(__builtin_amdgcn_update_dpp(0, __float_as_int(v), 0xB1, 0xF, 0xF, false));
    v += __int_as_float(__builtin_amdgcn_update_dpp(0, __float_as_int(v), 0x4E, 0xF, 0xF, false));
    v += __int_as_float(__builtin_amdgcn_update_dpp(0, __float_as_int(v), 0x141, 0xF, 0xF, false));
    v += __int_as_float(__builtin_amdgcn_update_dpp(0, __float_as_int(v), 0x140, 0xF, 0xF, false));
    v += __int_as_float(__builtin_amdgcn_update_dpp(0, __float_as_int(v), 0x142, 0xA, 0xF, false));
    v += __int_as_float(__builtin_amdgcn_update_dpp(0, __float_as_int(v), 0x143, 0xC, 0xF, false));
    return __int_as_float(__builtin_amdgcn_readlane(__float_as_int(v), 63));
}
__device__ __forceinline__ void top16_128(float v0, float v1, int lane, float& outv, int& outi) {
    outv = -INFINITY; outi = 0;
#pragma unroll 1
    for (int r = 0; r < 16; ++r) {
        const float wm = dpp_max_all(fmaxf(v0, v1));
        const unsigned long long b0 = __ballot(v0 == wm), b1 = __ballot(v1 == wm);
        const int idx = b0 ? (int)__builtin_ctzll(b0) : 64 + (int)__builtin_ctzll(b1);
        if (lane == idx) v0 = -INFINITY;
        if (lane + 64 == idx) v1 = -INFINITY;
        if (lane == r) { outv = wm; outi = idx; }
    }
}
__device__ __forceinline__ float gelu_erf(float x) { return 0.5f * x * (1.f + erff(x * 0.7071067811865476f)); }
__device__ __forceinline__ void cvt_fp8_rows(Frame& F, const float* src, unsigned char* dst, float* scales, int rows) {
    const int gw = F.vcu * NWAVES + F.wave, NGW = F.G * NWAVES;
    for (int m = gw; m < rows; m += NGW) {
        f32x4 v[8]; float mx = 0.f;
#pragma unroll
        for (int i = 0; i < 2; ++i)
#pragma unroll
            for (int q = 0; q < 4; ++q) { v[4 * i + q] = *(const GAS f32x4*)(src + (size_t)m * DM + 1024 * i + 16 * F.lane + 4 * q);
                mx = fmaxf(mx, fmaxf(fmaxf(fabsf(v[4 * i + q].x), fabsf(v[4 * i + q].y)), fmaxf(fabsf(v[4 * i + q].z), fabsf(v[4 * i + q].w)))); }
        mx = dpp_max_all(mx); if (!(mx > 0.f)) mx = 1.f;
        const float inv = 448.f / mx;
        if (F.lane == 0) scales[m] = mx * (1.f / 448.f);
#pragma unroll
        for (int i = 0; i < 2; ++i) { v4u o; int w;
            w = __builtin_amdgcn_cvt_pk_fp8_f32(v[4 * i].x * inv, v[4 * i].y * inv, 0, false); w = __builtin_amdgcn_cvt_pk_fp8_f32(v[4 * i].z * inv, v[4 * i].w * inv, w, true); o.x = (unsigned)w;
            w = __builtin_amdgcn_cvt_pk_fp8_f32(v[4 * i + 1].x * inv, v[4 * i + 1].y * inv, 0, false); w = __builtin_amdgcn_cvt_pk_fp8_f32(v[4 * i + 1].z * inv, v[4 * i + 1].w * inv, w, true); o.y = (unsigned)w;
            w = __builtin_amdgcn_cvt_pk_fp8_f32(v[4 * i + 2].x * inv, v[4 * i + 2].y * inv, 0, false); w = __builtin_amdgcn_cvt_pk_fp8_f32(v[4 * i + 2].z * inv, v[4 * i + 2].w * inv, w, true); o.z = (unsigned)w;
            w = __builtin_amdgcn_cvt_pk_fp8_f32(v[4 * i + 3].x * inv, v[4 * i + 3].y * inv, 0, false); w = __builtin_amdgcn_cvt_pk_fp8_f32(v[4 * i + 3].z * inv, v[4 * i + 3].w * inv, w, true); o.w = (unsigned)w;
            *(GAS v4u*)(dst + (size_t)m * DM + 1024 * i + 16 * F.lane) = o; }
    }
}
typedef float f32x2v __attribute__((ext_vector_type(2)));
__device__ __forceinline__ void dot16_fp8(f32x2v& a0, f32x2v& a1, const v4u w, const float* x) {
#define D4(W, O) do { const f32x2v lo = __builtin_amdgcn_cvt_pk_f32_fp8((int)(W), false), hi = __builtin_amdgcn_cvt_pk_f32_fp8((int)(W), true); \
    a0 += lo * (f32x2v){x[O], x[O + 1]}; a1 += hi * (f32x2v){x[O + 2], x[O + 3]}; } while (0)
    D4(w.x, 0); D4(w.y, 4); D4(w.z, 8); D4(w.w, 12);
#undef D4
}
__device__ __forceinline__ void axpy16_fp8(float* acc, const float c, const v4u w) {
#define A4(W, O) do { const f32x2v lo = __builtin_amdgcn_cvt_pk_f32_fp8((int)(W), false), hi = __builtin_amdgcn_cvt_pk_f32_fp8((int)(W), true); \
    acc[O] += c * lo.x; acc[O + 1] += c * lo.y; acc[O + 2] += c * hi.x; acc[O + 3] += c * hi.y; } while (0)
    A4(w.x, 0); A4(w.y, 4); A4(w.z, 8); A4(w.w, 12);
#undef A4
}
__device__ __forceinline__ void peer_phase(Frame& F) {
    LAS float* sc = (LAS float*)(F.lds + RING_OFF);
    const bf16* PQ = (const bf16*)(F.ws + WS_Q); const bf16* SUBK = (const bf16*)(F.ws + WS_SUBK);
    const unsigned char* PU8 = (const unsigned char*)(F.ws + WS_PU8); const unsigned char* PV8 = (const unsigned char*)(F.ws + WS_PV8);
    const float* SU = (const float*)(F.ws + WS_SU); const float* SV = (const float*)(F.ws + WS_SV);
    const float* Z = (const float*)(F.ws + WS_Z); const float* g3 = F.in[18]; const float* b3 = F.in[19];
    const int lane = F.lane, wave = F.wave;
    for (int unit = F.vcu; unit < TOK / 16; unit += F.G) {
        const int t0 = unit * 16;
        __syncthreads();
#pragma unroll 1
        for (int gi = 0; gi < 2; ++gi) { const int g = 2 * wave + gi;
            s16x8 a[4];
#pragma unroll
            for (int ks = 0; ks < 4; ++ks) a[ks] = *(const GAS s16x8*)(PQ + (size_t)(t0 + (lane & 15)) * DM + g * 128 + ks * 32 + 8 * (lane >> 4));
#pragma unroll 2
            for (int nt = 0; nt < 8; ++nt) { f32x4 acc = {0.f, 0.f, 0.f, 0.f};
#pragma unroll
                for (int ks = 0; ks < 4; ++ks) { const s16x8 bfr = *(const GAS s16x8*)(SUBK + (size_t)(g * 128 + nt * 16 + (lane & 15)) * 128 + ks * 32 + 8 * (lane >> 4));
                    acc = __builtin_amdgcn_mfma_f32_16x16x32_bf16(a[ks], bfr, acc, 0, 0, 0); }
#pragma unroll
                for (int r = 0; r < 4; ++r) sc[(4 * (lane >> 4) + r) * 2048 + g * 128 + nt * 16 + (lane & 15)] = acc[r]; } }
        __syncthreads();
#pragma unroll 1
        for (int ti = 0; ti < 2; ++ti) { const int tl = 2 * wave + ti; const size_t t = (size_t)t0 + tl;
            int E0 = 0, E1 = 0; float G0 = 0.f, G1 = 0.f;
#pragma unroll 1
            for (int hh = 0; hh < 8; ++hh) {
                float sA, sB; int iA, iB;
                top16_128(sc[tl * 2048 + (2 * hh) * 128 + lane], sc[tl * 2048 + (2 * hh) * 128 + 64 + lane], lane, sA, iA);
                top16_128(sc[tl * 2048 + (2 * hh + 1) * 128 + lane], sc[tl * 2048 + (2 * hh + 1) * 128 + 64 + lane], lane, sB, iB);
                int ca, cb; const int c = lane;
                if (c < 16) { ca = 0; cb = c; } else if (c < 24) { ca = 1; cb = c - 16; } else if (c < 29) { ca = 2; cb = c - 24; } else if (c < 33) { ca = 3; cb = c - 29; }
                else if (c < 36) { ca = 4; cb = c - 33; } else if (c < 38) { ca = 5; cb = c - 36; } else if (c < 40) { ca = 6; cb = c - 38; } else if (c < 42) { ca = 7; cb = c - 40; }
                else { ca = 8 + ((c - 42) & 7); cb = 0; }
                float cv = __shfl(sA, ca) + __shfl(sB, cb); const int ce = __shfl(iA, ca) * 128 + __shfl(iB, cb);
                if (c >= 50) cv = -INFINITY;
                float bv = -INFINITY; int be = 0;
#pragma unroll 1
                for (int r = 0; r < 16; ++r) { const float wm = dpp_max_all(cv); const unsigned long long bal = __ballot(cv == wm); const int idx = (int)__builtin_ctzll(bal);
                    const int ee = __builtin_amdgcn_readlane(ce, idx); if (lane == idx) cv = -INFINITY; if (lane == r) { bv = wm; be = ee; } }
                const float mx = __int_as_float(__builtin_amdgcn_readlane(__float_as_int(bv), 0)); const float p = (lane < 16) ? __expf(bv - mx) : 0.f; const float gt = p / dpp_sum_all(p);
                const int src = lane & 15; const int e_s = __shfl(be, src); const float g_s = __shfl(gt, src);
                if ((lane >> 4) == (hh & 3)) { if (hh < 4) { E0 = e_s; G0 = g_s; } else { E1 = e_s; G1 = g_s; } }
            }
            float xr[32];
#pragma unroll
            for (int i = 0; i < 2; ++i)
#pragma unroll
                for (int q = 0; q < 4; ++q) { const f32x4 p4 = *(const GAS f32x4*)(Z + t * DM + 1024 * i + 16 * lane + 4 * q);
                    xr[16 * i + 4 * q] = p4.x; xr[16 * i + 4 * q + 1] = p4.y; xr[16 * i + 4 * q + 2] = p4.z; xr[16 * i + 4 * q + 3] = p4.w; }
            const float su0 = SU[E0], su1 = SU[E1], sv0 = SV[E0], sv1 = SV[E1];
            float H0 = 0.f, H1 = 0.f;
            v4u wA[4][2], wB[4][2];
#define PLOAD(BUF, TAB, GRP) do { _Pragma("unroll") for (int k_ = 0; k_ < 4; ++k_) { const int kk_ = (GRP) * 4 + k_; \
                const int e_ = (kk_ < 64) ? __builtin_amdgcn_readlane(E0, kk_ & 63) : __builtin_amdgcn_readlane(E1, kk_ & 63); \
                const unsigned char* r_ = (TAB) + (size_t)e_ * DM + 16 * lane; BUF[k_][0] = *(const GAS v4u*)r_; BUF[k_][1] = *(const GAS v4u*)(r_ + 1024); } } while (0)
#define PDOT(BUF, GRP) do { _Pragma("unroll") for (int k_ = 0; k_ < 4; ++k_) { const int kk_ = (GRP) * 4 + k_; f32x2v a0 = {0.f, 0.f}, a1 = {0.f, 0.f}; \
                dot16_fp8(a0, a1, BUF[k_][0], xr); dot16_fp8(a0, a1, BUF[k_][1], xr + 16); \
                const float d_ = dpp_sum_all((a0.x + a0.y) + (a1.x + a1.y)); \
                if (kk_ < 64) { if (lane == kk_) H0 = d_; } else { if (lane == kk_ - 64) H1 = d_; } } } while (0)
            PLOAD(wA, PU8, 0);
#pragma unroll 1
            for (int grp = 0; grp < 32; grp += 2) { PLOAD(wB, PU8, grp + 1); PDOT(wA, grp); if (grp + 2 < 32) PLOAD(wA, PU8, grp + 2); PDOT(wB, grp + 1); }
#undef PDOT
            const float C0 = G0 * gelu_erf(H0 * su0) * sv0, C1 = G1 * gelu_erf(H1 * su1) * sv1;
            float acc[32];
#pragma unroll
            for (int j = 0; j < 32; ++j) acc[j] = 0.f;
#define PAXPY(BUF, GRP) do { _Pragma("unroll") for (int k_ = 0; k_ < 4; ++k_) { const int kk_ = (GRP) * 4 + k_; \
                const float c_ = __int_as_float((kk_ < 64) ? __builtin_amdgcn_readlane(__float_as_int(C0), kk_ & 63) : __builtin_amdgcn_readlane(__float_as_int(C1), kk_ & 63)); \
                axpy16_fp8(acc, c_, BUF[k_][0]); axpy16_fp8(acc + 16, c_, BUF[k_][1]); } } while (0)
            PLOAD(wA, PV8, 0);
#pragma unroll 1
            for (int grp = 0; grp < 32; grp += 2) { PLOAD(wB, PV8, grp + 1); PAXPY(wA, grp); if (grp + 2 < 32) PLOAD(wA, PV8, grp + 2); PAXPY(wB, grp + 1); }
#undef PAXPY
#undef PLOAD
            float s = 0.f;
#pragma unroll
            for (int j = 0; j < 32; ++j) { acc[j] = DN_ALPHA * xr[j] + acc[j]; s += acc[j]; }
            const float mean = dpp_sum_all(s) * (1.f / DM); float s2 = 0.f;
#pragma unroll
            for (int j = 0; j < 32; ++j) { acc[j] -= mean; s2 += acc[j] * acc[j]; }
            const float rstd = 1.f / sqrtf(dpp_sum_all(s2) * (1.f / DM) + LN_EPS);
#pragma unroll
            for (int i = 0; i < 2; ++i)
#pragma unroll
                for (int q = 0; q < 4; ++q) { const int c0 = 1024 * i + 16 * lane + 4 * q; const int j0 = 16 * i + 4 * q;
                    const f32x4 ga = *(const GAS f32x4*)(g3 + c0), ba = *(const GAS f32x4*)(b3 + c0); f32x4 ya;
                    ya.x = acc[j0] * rstd * ga.x + ba.x; ya.y = acc[j0 + 1] * rstd * ga.y + ba.y; ya.z = acc[j0 + 2] * rstd * ga.z + ba.z; ya.w = acc[j0 + 3] * rstd * ga.w + ba.w;
                    *(GAS f32x4*)(F.out + t * DM + c0) = ya; }
        }
    }
}
typedef float f32x16 __attribute__((ext_vector_type(16)));
typedef float f32x2_t __attribute__((ext_vector_type(2))); typedef __bf16 bf16x2_t __attribute__((ext_vector_type(2)));
__device__ __forceinline__ unsigned cvtpk_s(float lo, float hi) { f32x2_t v = {lo, hi}; bf16x2_t b = __builtin_convertvector(v, bf16x2_t); return __builtin_bit_cast(unsigned, b); }
__device__ __forceinline__ unsigned short bf1(float x) { return (unsigned short)(cvtpk_s(x, 0.f) & 0xffffu); }
__device__ __forceinline__ int crow(int r, int hi) { return (r & 3) + 8 * (r >> 2) + 4 * hi; }
#define MFMA32(a, b, c) __builtin_amdgcn_mfma_f32_32x32x16_bf16((a), (b), (c), 0, 0, 0)
template <int S> __device__ __forceinline__ bf16x8 pack8(const f32x16& x) {
    v4u p; p.x = cvtpk_s(x[8 * S], x[8 * S + 1]); p.y = cvtpk_s(x[8 * S + 2], x[8 * S + 3]); p.z = cvtpk_s(x[8 * S + 4], x[8 * S + 5]); p.w = cvtpk_s(x[8 * S + 6], x[8 * S + 7]);
    return __builtin_bit_cast(bf16x8, p);
}
__device__ __forceinline__ float ex2(float x) { return __builtin_amdgcn_exp2f(x); }
__device__ __forceinline__ void gla_unit(Frame& F, int unit, bf16* ATTo) {
    const int b = unit >> 2, h = unit & 3, tid = F.tid, lane = F.lane, wave = F.wave, r32 = lane & 31, hi = lane >> 5;
    LAS float* GL = (LAS float*)(F.lds + RING_OFF);
    LAS float* TOT = GL + 1024;
    LAS float* DEC = TOT + 1024;
    LAS float* GN = DEC + 128;
    LAS bf16* QD = (LAS bf16*)(GN + 256);
    LAS bf16* KD = QD + 64 * 136;
    LAS bf16* KST = KD + 64 * 136;
    LAS bf16* VT = KST + 128 * 72;
    LAS bf16* AL = VT + 256 * 72;
    LAS bf16* OB = QD;
    const bf16* PROJ = (const bf16*)(F.ws + WS_PROJ); const float* GATE = (const float*)(F.ws + WS_GATE);
    const float* gup = F.in[3]; const float* gbias = F.in[4]; const float* gnorm = F.in[5];
    constexpr float L2E = 1.4426950408889634f;
    const int dp = tid & 63, d0 = 2 * dp, g8 = wave;
    const int ep = tid & 127, e0 = 2 * ep, jq = tid >> 7;
    const int ei = tid >> 3, ec = tid & 7;
    LAS float* GUT = (LAS float*)(AL + 64 * 72);
    const float bias0 = gbias[h * 128 + d0], bias1 = gbias[h * 128 + d0 + 1];
    f32x16 st[4];
#pragma unroll
    for (int i = 0; i < 4; ++i)
#pragma unroll
        for (int r = 0; r < 16; ++r) st[i][r] = 0.f;
    __syncthreads();
    if (tid < 256) GN[tid] = gnorm[tid];
    for (int i = tid; i < 16 * 128; i += NWAVES * 64) GUT[(i & 127) * 20 + (i >> 7)] = gup[(size_t)(i >> 7) * 512 + h * 128 + (i & 127)];
    unsigned pq[8], pk[8], pv[16]; f32x4 pgl = {0.f, 0.f, 0.f, 0.f};
    const unsigned voq = (unsigned)(d0 * 2), vov = (unsigned)(e0 * 2), vog = (unsigned)(tid * 16), vor = (unsigned)((ei * NPROJ + 32 * ec) * 2);
#define GLA_PREFETCH(CH) do { const size_t rw_ = (size_t)b * SEQ + (CH) * 64; \
        const char* qb_ = (const char*)(PROJ + (rw_ + 8 * g8) * NPROJ + C_QG + h * 128); const char* kb_ = (const char*)(PROJ + (rw_ + 8 * g8) * NPROJ + C_KG + h * 128); \
        const char* vb_ = (const char*)(PROJ + (rw_ + 16 * jq) * NPROJ + C_VG + h * 256); \
        _Pragma("unroll") for (int tt = 0; tt < 8; ++tt) { pq[tt] = *(const GAS unsigned*)(qb_ + (size_t)tt * (NPROJ * 2) + voq); pk[tt] = *(const GAS unsigned*)(kb_ + (size_t)tt * (NPROJ * 2) + voq); } \
        _Pragma("unroll") for (int jj = 0; jj < 16; ++jj) pv[jj] = *(const GAS unsigned*)(vb_ + (size_t)jj * (NPROJ * 2) + vov); \
        if (tid < 256) pgl = *(const GAS f32x4*)((const char*)(GATE + rw_ * 16) + vog); } while (0)
    GLA_PREFETCH(0);
#pragma unroll 1
    for (int ch = 0; ch < SEQ / 64; ++ch) {
        const size_t row0 = (size_t)b * SEQ + ch * 64;
        if (tid < 256) *(LAS f32x4*)(GL + tid * 4) = pgl;
        __syncthreads();
        float cum0[8], cum1[8];
        { float run0 = 0.f, run1 = 0.f; float gu0[16], gu1[16];
#pragma unroll
          for (int r4 = 0; r4 < 4; ++r4) { const f32x4 ga = *(const LAS f32x4*)(GUT + d0 * 20 + 4 * r4), gb = *(const LAS f32x4*)(GUT + (d0 + 1) * 20 + 4 * r4);
              gu0[4 * r4] = ga.x; gu0[4 * r4 + 1] = ga.y; gu0[4 * r4 + 2] = ga.z; gu0[4 * r4 + 3] = ga.w; gu1[4 * r4] = gb.x; gu1[4 * r4 + 1] = gb.y; gu1[4 * r4 + 2] = gb.z; gu1[4 * r4 + 3] = gb.w; }
#pragma unroll
          for (int tt = 0; tt < 8; ++tt) { const LAS float* gl = GL + (8 * g8 + tt) * 16; float z0 = bias0, z1 = bias1;
#pragma unroll
              for (int r4 = 0; r4 < 4; ++r4) { const f32x4 gv = *(const LAS f32x4*)(gl + 4 * r4);
                  z0 += gv.x * gu0[4 * r4] + gv.y * gu0[4 * r4 + 1] + gv.z * gu0[4 * r4 + 2] + gv.w * gu0[4 * r4 + 3];
                  z1 += gv.x * gu1[4 * r4] + gv.y * gu1[4 * r4 + 1] + gv.z * gu1[4 * r4 + 2] + gv.w * gu1[4 * r4 + 3]; }
              const float y0 = z0 * L2E, y1 = z1 * L2E;
              const float l0 = fminf(y0, 0.f) - __builtin_amdgcn_logf(1.f + ex2(-fabsf(y0))), l1 = fminf(y1, 0.f) - __builtin_amdgcn_logf(1.f + ex2(-fabsf(y1)));
              run0 += l0 * (1.f / 16.f); run1 += l1 * (1.f / 16.f); cum0[tt] = run0; cum1[tt] = run1; }
          *(LAS f32x2_t*)(TOT + g8 * 128 + d0) = (f32x2_t){run0, run1}; }
        __syncthreads();
        { float off0 = 0.f, off1 = 0.f, tot0 = 0.f, tot1 = 0.f;
#pragma unroll
          for (int gg = 0; gg < 8; ++gg) { const f32x2_t tv = *(const LAS f32x2_t*)(TOT + gg * 128 + d0); tot0 += tv.x; tot1 += tv.y; if (gg < g8) { off0 += tv.x; off1 += tv.y; } }
          unsigned short ks0[8], ks1[8];
#pragma unroll
          for (int tt = 0; tt < 8; ++tt) { const int t = 8 * g8 + tt; const float c0 = off0 + cum0[tt], c1 = off1 + cum1[tt];
              const float q0 = bf2f((unsigned short)(pq[tt] & 0xffffu)), q1 = bf2f((unsigned short)(pq[tt] >> 16)), k0 = bf2f((unsigned short)(pk[tt] & 0xffffu)), k1 = bf2f((unsigned short)(pk[tt] >> 16));
              *(LAS unsigned*)(QD + t * 136 + d0) = cvtpk_s(q0 * 0.08838834764831845f * ex2(c0), q1 * 0.08838834764831845f * ex2(c1));
              *(LAS unsigned*)(KD + t * 136 + d0) = cvtpk_s(k0 * ex2(-c0), k1 * ex2(-c1));
              const unsigned kk = cvtpk_s(k0 * ex2(tot0 - c0), k1 * ex2(tot1 - c1)); ks0[tt] = (unsigned short)(kk & 0xffffu); ks1[tt] = (unsigned short)(kk >> 16); }
          v4u w0, w1; w0.x = ks0[0] | ((unsigned)ks0[1] << 16); w0.y = ks0[2] | ((unsigned)ks0[3] << 16); w0.z = ks0[4] | ((unsigned)ks0[5] << 16); w0.w = ks0[6] | ((unsigned)ks0[7] << 16);
          w1.x = ks1[0] | ((unsigned)ks1[1] << 16); w1.y = ks1[2] | ((unsigned)ks1[3] << 16); w1.z = ks1[4] | ((unsigned)ks1[5] << 16); w1.w = ks1[6] | ((unsigned)ks1[7] << 16);
          *(LAS v4u*)(KST + d0 * 72 + 8 * g8) = w0; *(LAS v4u*)(KST + (d0 + 1) * 72 + 8 * g8) = w1;
          if (g8 == 0) { DEC[d0] = ex2(tot0); DEC[d0 + 1] = ex2(tot1); } }
        { v4u a0, a1, c0, c1;
#define LO2(x, y) (((x) & 0xffffu) | ((y) << 16))
#define HI2(x, y) (((x) >> 16) | ((y) & 0xffff0000u))
          a0.x = LO2(pv[0], pv[1]); a0.y = LO2(pv[2], pv[3]); a0.z = LO2(pv[4], pv[5]); a0.w = LO2(pv[6], pv[7]);
          a1.x = LO2(pv[8], pv[9]); a1.y = LO2(pv[10], pv[11]); a1.z = LO2(pv[12], pv[13]); a1.w = LO2(pv[14], pv[15]);
          c0.x = HI2(pv[0], pv[1]); c0.y = HI2(pv[2], pv[3]); c0.z = HI2(pv[4], pv[5]); c0.w = HI2(pv[6], pv[7]);
          c1.x = HI2(pv[8], pv[9]); c1.y = HI2(pv[10], pv[11]); c1.z = HI2(pv[12], pv[13]); c1.w = HI2(pv[14], pv[15]);
#undef LO2
#undef HI2
          *(LAS v4u*)(VT + e0 * 72 + 16 * jq) = a0; *(LAS v4u*)(VT + e0 * 72 + 16 * jq + 8) = a1;
          *(LAS v4u*)(VT + (e0 + 1) * 72 + 16 * jq) = c0; *(LAS v4u*)(VT + (e0 + 1) * 72 + 16 * jq + 8) = c1; }
        __syncthreads();
        if (ch + 1 < SEQ / 64) GLA_PREFETCH(ch + 1);

        if (wave < 3) { const int ib = wave > 0, jb = wave > 1; f32x16 acc;
#pragma unroll
            for (int r = 0; r < 16; ++r) acc[r] = 0.f;
#pragma unroll
            for (int s8 = 0; s8 < 8; ++s8) { const bf16x8 a = *(const LAS bf16x8*)(QD + (ib * 32 + r32) * 136 + 16 * s8 + 8 * hi), bb = *(const LAS bf16x8*)(KD + (jb * 32 + r32) * 136 + 16 * s8 + 8 * hi);
                acc = MFMA32(a, bb, acc); }
#pragma unroll
            for (int r = 0; r < 16; ++r) { const int i = ib * 32 + crow(r, hi), j = jb * 32 + r32; AL[i * 72 + j] = bf1(j <= i ? acc[r] : 0.f); } }
        f32x16 o0, o1;
#pragma unroll
        for (int r = 0; r < 16; ++r) { o0[r] = 0.f; o1[r] = 0.f; }
#define GLA_B(DB, S) do { const bf16x8 sb = pack8<S>(st[DB]); \
            const LAS bf16* p0 = QD + r32 * 136 + 32 * (DB) + 16 * (S) + 4 * hi; const LAS bf16* p1 = p0 + 32 * 136; \
            typedef unsigned long long u64; \
            const u64 a0 = *(const LAS u64*)p0, a1 = *(const LAS u64*)(p0 + 8), c0 = *(const LAS u64*)p1, c1 = *(const LAS u64*)(p1 + 8); \
            v4u fa, fc; fa.x = (unsigned)a0; fa.y = (unsigned)(a0 >> 32); fa.z = (unsigned)a1; fa.w = (unsigned)(a1 >> 32); fc.x = (unsigned)c0; fc.y = (unsigned)(c0 >> 32); fc.z = (unsigned)c1; fc.w = (unsigned)(c1 >> 32); \
            o0 = MFMA32(__builtin_bit_cast(bf16x8, fa), sb, o0); o1 = MFMA32(__builtin_bit_cast(bf16x8, fc), sb, o1); __builtin_amdgcn_sched_barrier(0); } while (0)
        __builtin_amdgcn_sched_barrier(0);
        GLA_B(0, 0); GLA_B(0, 1); GLA_B(1, 0); GLA_B(1, 1); GLA_B(2, 0); GLA_B(2, 1); GLA_B(3, 0); GLA_B(3, 1);
#undef GLA_B
        __syncthreads();
        bf16x8 vf[4];
#pragma unroll
        for (int s = 0; s < 4; ++s) vf[s] = *(const LAS bf16x8*)(VT + (32 * wave + r32) * 72 + 16 * s + 8 * hi);
#pragma unroll
        for (int s = 0; s < 2; ++s) o0 = MFMA32(*(const LAS bf16x8*)(AL + r32 * 72 + 16 * s + 8 * hi), vf[s], o0);
#pragma unroll
        for (int s = 0; s < 4; ++s) o1 = MFMA32(*(const LAS bf16x8*)(AL + (32 + r32) * 72 + 16 * s + 8 * hi), vf[s], o1);
#pragma unroll
        for (int r = 0; r < 16; ++r) { OB[crow(r, hi) * 264 + 32 * wave + r32] = bf1(o0[r]); OB[(32 + crow(r, hi)) * 264 + 32 * wave + r32] = bf1(o1[r]); }
        __builtin_amdgcn_sched_barrier(0);
#pragma unroll
        for (int db = 0; db < 4; ++db) {
#pragma unroll
            for (int r4 = 0; r4 < 4; ++r4) { const f32x4 dc = *(const LAS f32x4*)(DEC + 32 * db + 8 * r4 + 4 * hi);
                st[db][4 * r4] *= dc.x; st[db][4 * r4 + 1] *= dc.y; st[db][4 * r4 + 2] *= dc.z; st[db][4 * r4 + 3] *= dc.w; }
#pragma unroll
            for (int s = 0; s < 4; ++s) st[db] = MFMA32(*(const LAS bf16x8*)(KST + (32 * db + r32) * 72 + 16 * s + 8 * hi), vf[s], st[db]);
            __builtin_amdgcn_sched_barrier(0); }
        __syncthreads();
        { v4u pr[4]; float ss = 0.f;
          { const char* rb_ = (const char*)(PROJ + row0 * NPROJ + C_RG + h * 256);
#pragma unroll
            for (int q4 = 0; q4 < 4; ++q4) pr[q4] = *(const GAS v4u*)(rb_ + vor + 16 * q4); }
#define UNPK8(W, O) do { O[0] = bf2f((unsigned short)((W).x & 0xffffu)); O[1] = bf2f((unsigned short)((W).x >> 16)); O[2] = bf2f((unsigned short)((W).y & 0xffffu)); O[3] = bf2f((unsigned short)((W).y >> 16)); \
              O[4] = bf2f((unsigned short)((W).z & 0xffffu)); O[5] = bf2f((unsigned short)((W).z >> 16)); O[6] = bf2f((unsigned short)((W).w & 0xffffu)); O[7] = bf2f((unsigned short)((W).w >> 16)); } while (0)
#pragma unroll
          for (int q4 = 0; q4 < 4; ++q4) { const v4u w = *(const LAS v4u*)(OB + ei * 264 + 32 * ec + 8 * q4); float ov[8]; UNPK8(w, ov);
#pragma unroll
              for (int j = 0; j < 8; ++j) ss += ov[j] * ov[j]; }
          ss += __int_as_float(__builtin_amdgcn_update_dpp(0, __float_as_int(ss), 0xB1, 0xF, 0xF, false));
          ss += __int_as_float(__builtin_amdgcn_update_dpp(0, __float_as_int(ss), 0x4E, 0xF, 0xF, false));
          ss += __int_as_float(__builtin_amdgcn_update_dpp(0, __float_as_int(ss), 0x141, 0xF, 0xF, false));
          const float rs = 1.f / sqrtf(ss * (1.f / 256.f) + RMS_EPS);
          __builtin_amdgcn_sched_barrier(0);
#pragma unroll
          for (int q4 = 0; q4 < 4; ++q4) { const v4u w = *(const LAS v4u*)(OB + ei * 264 + 32 * ec + 8 * q4); float ov[8], rv[8], y[8]; UNPK8(w, ov); UNPK8(pr[q4], rv);
#pragma unroll
              for (int j = 0; j < 8; ++j) y[j] = ov[j] * rs * GN[32 * ec + 8 * q4 + j] * rv[j] * __builtin_amdgcn_rcpf(1.f + ex2(-rv[j] * L2E));
              v4u o4; o4.x = cvtpk_s(y[0], y[1]); o4.y = cvtpk_s(y[2], y[3]); o4.z = cvtpk_s(y[4], y[5]); o4.w = cvtpk_s(y[6], y[7]);
              *(GAS v4u*)(ATTo + (row0 + ei) * DM + 1024 + h * 256 + 32 * ec + 8 * q4) = o4;
              __builtin_amdgcn_sched_barrier(0); }
#undef UNPK8
        }
    }
#undef GLA_PREFETCH
    __syncthreads();
}
__device__ __forceinline__ void check_diff_bf16(Frame& F, const bf16* A, const bf16* B, int c0, int c1, gu32* word) {
    const size_t nth = (size_t)F.G * NWAVES * 64; const int w8 = (c1 - c0) / 8; float mx = 0.f;
    for (size_t i = (size_t)F.vcu * NWAVES * 64 + F.tid; i < (size_t)TOK * w8; i += nth) { const size_t row = i / w8; const int c = c0 + (int)(i % w8) * 8;
        const us8 a = *(const GAS us8*)(A + row * DM + c), bq = *(const GAS us8*)(B + row * DM + c);
#pragma unroll
        for (int j = 0; j < 8; ++j) { float dv = fabsf(bf2f(a[j]) - bf2f(bq[j])); if (!(dv == dv)) dv = 1e6f; mx = fmaxf(mx, dv); } }
    mx = wave_max(mx);
    if (F.lane == 0) __hip_atomic_fetch_max((unsigned*)word, __float_as_uint(mx), __ATOMIC_RELAXED, __HIP_MEMORY_SCOPE_AGENT);
}
namespace mb {
constexpr int D = 128, NW = 8, QBLK = 32, KVBLK = 64;
constexpr float SCALE = 0.088388347648318440f, THR = 8.f;
constexpr int SHM_V = KVBLK * D * 2, SHM_K = KVBLK * D * 2;
#define KSWZ(row, colB) ((row) * 256 + ((colB) ^ (((row) & 7) << 4)))
#define SBAR() __builtin_amdgcn_sched_barrier(0)
typedef short s16x4 __attribute__((ext_vector_type(4)));
__device__ __forceinline__ unsigned cvtpk(float lo, float hi) { unsigned r; asm volatile("v_cvt_pk_bf16_f32 %0, %1, %2" : "=v"(r) : "v"(lo), "v"(hi)); return r; }
__device__ __forceinline__ void partialSM(f32x16& p0, f32x16& p1, float& m_reg, float& mn, float& alpha) {
    constexpr float C = SCALE * 1.4426950408889634f;
    float pmax = p0[0];
#pragma unroll
    for (int r = 1; r < 16; ++r) pmax = fmaxf(pmax, p0[r]);
#pragma unroll
    for (int r = 0; r < 16; ++r) pmax = fmaxf(pmax, p1[r]);
    { auto rr = __builtin_amdgcn_permlane32_swap(__float_as_uint(pmax), __float_as_uint(pmax), false, false); pmax = fmaxf(__uint_as_float(rr[0]), __uint_as_float(rr[1])); }
    if (__builtin_expect(__all(pmax - m_reg <= THR / SCALE), 1)) { mn = m_reg; alpha = 1.f; }
    else { mn = fmaxf(m_reg, pmax); alpha = __builtin_amdgcn_exp2f((m_reg - mn) * C); m_reg = mn; }
    const float mnC = -mn * C;
#pragma unroll
    for (int r = 0; r < 16; ++r) p0[r] = fmaf(p0[r], C, mnC);
#pragma unroll
    for (int r = 0; r < 16; ++r) p1[r] = fmaf(p1[r], C, mnC);
#pragma unroll
    for (int r = 0; r < 16; ++r) p0[r] = __builtin_amdgcn_exp2f(p0[r]);
}
__device__ __forceinline__ void finishSM(f32x16& p0, f32x16& p1, float alpha, float& l_reg, bf16x8& pa0, bf16x8& pa1, bf16x8& pa2, bf16x8& pa3) {
#pragma unroll
    for (int r = 0; r < 16; ++r) p1[r] = __builtin_amdgcn_exp2f(p1[r]);
    float ps = 0;
#pragma unroll
    for (int r = 0; r < 16; ++r) ps += p0[r];
#pragma unroll
    for (int r = 0; r < 16; ++r) ps += p1[r];
    { auto rr = __builtin_amdgcn_permlane32_swap(__float_as_uint(ps), __float_as_uint(ps), false, false); ps = __uint_as_float(rr[0]) + __uint_as_float(rr[1]); }
    l_reg = l_reg * alpha + ps;
#define PK4(P, BASE, OUT) do { unsigned a0 = cvtpk(P[BASE + 0], P[BASE + 1]), a1 = cvtpk(P[BASE + 2], P[BASE + 3]);   \
    unsigned b0 = cvtpk(P[BASE + 4], P[BASE + 5]), b1 = cvtpk(P[BASE + 6], P[BASE + 7]);                              \
    auto r0 = __builtin_amdgcn_permlane32_swap(a0, b0, false, false); auto r1 = __builtin_amdgcn_permlane32_swap(a1, b1, false, false); \
    v4u w = {r0[0], r1[0], r0[1], r1[1]}; OUT = __builtin_bit_cast(bf16x8, w); } while (0)
    PK4(p0, 0, pa0); PK4(p0, 8, pa1); PK4(p1, 0, pa2); PK4(p1, 8, pa3);
#undef PK4
}
__device__ __forceinline__ void qkt(f32x16& p0, f32x16& p1, const LAS unsigned char* Ks, const bf16x8* qr, int r32, int hi) {
#pragma unroll
    for (int r = 0; r < 16; ++r) { p0[r] = 0.f; p1[r] = 0.f; }
#pragma unroll
    for (int d0 = 0; d0 < 8; ++d0) { const int cb = (d0 * 16 + hi * 8) * 2;
        const bf16x8 b0 = *(const LAS bf16x8*)(Ks + KSWZ(r32, cb)), b1 = *(const LAS bf16x8*)(Ks + KSWZ(32 + r32, cb));
        p0 = MFMA32(b0, qr[d0], p0); p1 = MFMA32(b1, qr[d0], p1); }
}
__device__ __forceinline__ int v_st(int k, int c) { const int kk = (k & ~0xC) | ((k & 4) << 1) | ((k & 8) >> 1); return ((kk >> 3) * 4 + (c >> 5)) * 512 + ((kk & 7) * 32 + (c & 31)) * 2; }
__device__ __forceinline__ int v_rd_base(int lane) { return ((lane & 3) << 3) | (((lane >> 2) & 3) << 6) | (((lane >> 4) & 1) << 5) | (((lane >> 5) & 1) << 8); }
constexpr int v_rd_off(int d0, int ks, int half) { return d0 * 512 + ks * 4096 + half * 2048; }
template <int OFF> __device__ __forceinline__ s16x4 tr_read(int vb) { s16x4 r; asm volatile("ds_read_b64_tr_b16 %0, %1 offset:%2" : "=&v"(r) : "v"(vb), "i"(OFF) : "memory"); return r; }
template <int D0> __device__ __forceinline__ void pv_one(f32x16& od, int vb, bf16x8 pa0, bf16x8 pa1, bf16x8 pa2, bf16x8 pa3) {
    const s16x4 l0 = tr_read<v_rd_off(D0, 0, 0)>(vb), h0 = tr_read<v_rd_off(D0, 0, 1)>(vb), l1 = tr_read<v_rd_off(D0, 1, 0)>(vb), h1 = tr_read<v_rd_off(D0, 1, 1)>(vb);
    const s16x4 l2 = tr_read<v_rd_off(D0, 2, 0)>(vb), h2 = tr_read<v_rd_off(D0, 2, 1)>(vb), l3 = tr_read<v_rd_off(D0, 3, 0)>(vb), h3 = tr_read<v_rd_off(D0, 3, 1)>(vb);
    asm volatile("s_waitcnt lgkmcnt(0)" ::: "memory"); SBAR();
#define PK(L, H) (bf16x8){L[0], L[1], L[2], L[3], H[0], H[1], H[2], H[3]}
    od = MFMA32(pa0, PK(l0, h0), od); od = MFMA32(pa1, PK(l1, h1), od); od = MFMA32(pa2, PK(l2, h2), od); od = MFMA32(pa3, PK(l3, h3), od);
#undef PK
}
__device__ __forceinline__ void pv_d0(f32x16* o, int vb, bf16x8 pa0, bf16x8 pa1, bf16x8 pa2, bf16x8 pa3) {
    pv_one<0>(o[0], vb, pa0, pa1, pa2, pa3); pv_one<1>(o[1], vb, pa0, pa1, pa2, pa3); pv_one<2>(o[2], vb, pa0, pa1, pa2, pa3); pv_one<3>(o[3], vb, pa0, pa1, pa2, pa3);
}
__device__ __forceinline__ void mask_tile(f32x16& p0, f32x16& p1, int j, int qrel, int hi, unsigned sel) {
    if (j < 4) {
        const int kb = 64 * j + 4 * hi;
#pragma unroll
        for (int r = 0; r < 16; ++r) { const int kv = kb + (r & 3) + 8 * (r >> 2); if (kv > qrel) p0[r] = -INFINITY; if (kv + 32 > qrel) p1[r] = -INFINITY; }
    } else if (!((sel >> ((j - 4) >> 2)) & 1u)) {
#pragma unroll
        for (int r = 0; r < 16; ++r) { p0[r] = -INFINITY; p1[r] = -INFINITY; }
    }
}
__device__ __forceinline__ void moba_unit(Frame& F, int unit, bf16* ATTo) {
    const int qb = 7 - (unit >> 6), bh = unit & 63, b = bh >> 3, h = bh & 7;
    const int tid = F.tid, wid = F.wave, lane = F.lane, r32 = lane & 31, hi = lane >> 5;
    LAS unsigned char* lds = F.lds + RING_OFF;
    LAS unsigned char* V_lds = lds; LAS unsigned char* K_lds = lds + 2 * SHM_V;
    LAS float* ws = (LAS float*)(lds + 2 * SHM_V + 2 * SHM_K) + wid * 64; LAS float* li_l = ws; LAS float* al_l = ws + 32;
    const bf16* PROJ = (const bf16*)(F.ws + WS_PROJ);
    const size_t rowb = (size_t)b * SEQ;
    const bf16* Kh = PROJ + rowb * NPROJ + C_KM + h * 128; const bf16* Vh = PROJ + rowb * NPROJ + C_VM + h * 128;
    constexpr int LDK = NPROJ;
    float m_reg = -1e30f, l_reg = 0; f32x16 o[4]; bf16x8 qr[8];
#pragma unroll
    for (int i = 0; i < 4; ++i)
#pragma unroll
        for (int r = 0; r < 16; ++r) o[i][r] = 0.f;
    { const bf16* Qw = PROJ + (rowb + qb * 256 + wid * QBLK + r32) * NPROJ + C_QM + h * 128 + hi * 8;
#pragma unroll
      for (int d0 = 0; d0 < 8; ++d0) qr[d0] = *(const GAS bf16x8*)(Qw + d0 * 16); }
    const int sr = tid >> 4, sc = (tid & 15) * 8, vst0 = v_st(sr, sc), vst1 = v_st(32 + sr, sc);
    const int vb0 = (int)(uintptr_t)V_lds + v_rd_base(lane);
    const int qrel = wid * QBLK + r32;
    __syncthreads();
    unsigned sel = 0;
    {
        float g[7];
#pragma unroll
        for (int n = 0; n < 7; ++n) { g[n] = 0.f;
            if (n < qb) { float gs = 0.f;
#pragma unroll 1
                for (int t = 0; t < 4; ++t) { const int k0 = n * 256 + 64 * t; const int bsel = t & 1;
                    const bf16x8 ka = *(const GAS bf16x8*)(Kh + (size_t)(k0 + sr) * LDK + sc), kb2 = *(const GAS bf16x8*)(Kh + (size_t)(k0 + 32 + sr) * LDK + sc);
                    *(LAS bf16x8*)(K_lds + bsel * SHM_K + KSWZ(sr, sc * 2)) = ka; *(LAS bf16x8*)(K_lds + bsel * SHM_K + KSWZ(32 + sr, sc * 2)) = kb2;
                    __syncthreads();
                    f32x16 p0, p1; qkt(p0, p1, K_lds + bsel * SHM_K, qr, r32, hi);
#pragma unroll
                    for (int r = 0; r < 16; ++r) gs += p0[r] + p1[r]; }
                { auto rr = __builtin_amdgcn_permlane32_swap(__float_as_uint(gs), __float_as_uint(gs), false, false); gs = __uint_as_float(rr[0]) + __uint_as_float(rr[1]); }
                g[n] = gs; } }
#pragma unroll
        for (int n = 0; n < 7; ++n) { int cnt = 0;
#pragma unroll
            for (int m = 0; m < 7; ++m) if (m != n && m < qb && (g[m] > g[n] || (g[m] == g[n] && m < n))) ++cnt;
            if (n < qb && cnt < 3) sel |= 1u << n; }
    }
    __syncthreads();
    const int NT = 4 * (qb + 1);
#define KSTART(j) (((j) < 4) ? (qb * 256 + 64 * (j)) : (((j) - 4) * 64))
    bf16x8 vs0, vs1, ks0, ks1;
#define SLOAD(k0) do { vs0 = *(const GAS bf16x8*)(&Vh[(size_t)((k0) + sr) * LDK + sc]); vs1 = *(const GAS bf16x8*)(&Vh[(size_t)((k0) + 32 + sr) * LDK + sc]); \
    ks0 = *(const GAS bf16x8*)(&Kh[(size_t)((k0) + sr) * LDK + sc]); ks1 = *(const GAS bf16x8*)(&Kh[(size_t)((k0) + 32 + sr) * LDK + sc]); } while (0)
#define SWRITE(bb) do { *(LAS bf16x8*)(V_lds + (bb) * SHM_V + vst0) = vs0; *(LAS bf16x8*)(V_lds + (bb) * SHM_V + vst1) = vs1; const int kc = sc * 2; \
    *(LAS bf16x8*)(K_lds + (bb) * SHM_K + KSWZ(sr, kc)) = ks0; *(LAS bf16x8*)(K_lds + (bb) * SHM_K + KSWZ(32 + sr, kc)) = ks1; } while (0)
    SLOAD(KSTART(0)); SWRITE(0); SLOAD(KSTART(1));
    __syncthreads();
#pragma unroll 1
    for (int j = 0; j < NT; ++j) {
        const int bsel = j & 1;
        if (j + 1 < NT) { SWRITE(bsel ^ 1); }
        if (j + 2 < NT) { const int k2 = KSTART(j + 2); SLOAD(k2); }
        f32x16 p0, p1; float mn, al; bf16x8 pa0, pa1, pa2, pa3;
        qkt(p0, p1, K_lds + bsel * SHM_K, qr, r32, hi); mask_tile(p0, p1, j, qrel, hi, sel);
        partialSM(p0, p1, m_reg, mn, al);
        if (__any(al < 1.f)) { if (hi == 0) al_l[r32] = al; asm volatile("s_waitcnt lgkmcnt(0)" ::: "memory");
#pragma unroll
            for (int d_ = 0; d_ < 4; ++d_)
#pragma unroll
                for (int r = 0; r < 16; ++r) o[d_][r] *= al_l[crow(r, hi)]; }
        finishSM(p0, p1, al, l_reg, pa0, pa1, pa2, pa3); SBAR();
        pv_d0(o, vb0 + bsel * SHM_V, pa0, pa1, pa2, pa3);
        __syncthreads();
    }
    if (hi == 0) li_l[r32] = l_reg; asm volatile("s_waitcnt lgkmcnt(0)" ::: "memory");
    float rli[16];
#pragma unroll
    for (int r = 0; r < 16; ++r) rli[r] = __builtin_amdgcn_rcpf(li_l[crow(r, hi)]);
    bf16* Ow = ATTo + (rowb + qb * 256 + wid * QBLK) * DM + h * 128;
#pragma unroll
    for (int r = 0; r < 16; ++r) { const int orow = crow(r, hi);
#pragma unroll
        for (int d0 = 0; d0 < 4; ++d0) Ow[(size_t)orow * DM + d0 * 32 + r32] = bf1(o[d0][r] * rli[r]); }
    __syncthreads();
#undef SLOAD
#undef SWRITE
#undef KSTART
}
#undef KSWZ
#undef SBAR
}
namespace mb {
__device__ __forceinline__ void qkt_acc(f32x16& p0, f32x16& p1, const LAS unsigned char* Ks, const bf16x8* qr, int r32, int hi) {
#define KSWZ(row, colB) ((row) * 256 + ((colB) ^ (((row) & 7) << 4)))
#pragma unroll
    for (int d0 = 0; d0 < 8; ++d0) { const int cb = (d0 * 16 + hi * 8) * 2;
        const bf16x8 b0 = *(const LAS bf16x8*)(Ks + KSWZ(r32, cb)), b1 = *(const LAS bf16x8*)(Ks + KSWZ(32 + r32, cb));
        p0 = MFMA32(b0, qr[d0], p0); p1 = MFMA32(b1, qr[d0], p1); }
}
__device__ __forceinline__ void xattn_unit(Frame& F, int unit, bf16* XOo) {
    const int b = unit >> 5, h = (unit >> 3) & 3, qt = unit & 7;
    const int tid = F.tid, wid = F.wave, lane = F.lane, r32 = lane & 31, hi = lane >> 5;
    LAS unsigned char* lds = F.lds + RING_OFF;
    LAS unsigned char* V_lds = lds; LAS unsigned char* K_lds = lds + 2 * SHM_V;
    LAS float* wsl = (LAS float*)(lds + 2 * SHM_V + 2 * SHM_K) + wid * 64;
    const bf16* KV = (const bf16*)(F.ws + WS_KV) + (size_t)(b * MEMLEN) * (2 * DM) + h * 512;
    const bf16* Qw = (const bf16*)(F.ws + WS_Q) + ((size_t)b * SEQ + qt * 256 + wid * QBLK + r32) * DM + h * 512 + hi * 8;
    constexpr int LDK = 2 * DM;
    const int sr = tid >> 4, sc = (tid & 15) * 8, vst0 = v_st(sr, sc), vst1 = v_st(32 + sr, sc);
    const int vb0 = (int)(uintptr_t)V_lds + v_rd_base(lane);
    f32x16 s0[4], s1[4];
#pragma unroll
    for (int t = 0; t < 4; ++t)
#pragma unroll
        for (int r = 0; r < 16; ++r) { s0[t][r] = 0.f; s1[t][r] = 0.f; }
    bf16x8 g0, g1;
#define XSRC(s, voff) (KV + (size_t)(64 * ((s) & 3)) * LDK + 128 * ((s) >> 2) + (voff))
#define XLOAD(s, voff) do { const bf16* src_ = XSRC(s, voff); g0 = *(const GAS bf16x8*)(src_ + (size_t)sr * LDK + sc); g1 = *(const GAS bf16x8*)(src_ + (size_t)(32 + sr) * LDK + sc); } while (0)
#define XWRITE_K(bb) do { *(LAS bf16x8*)(K_lds + (bb) * SHM_K + KSWZ(sr, sc * 2)) = g0; *(LAS bf16x8*)(K_lds + (bb) * SHM_K + KSWZ(32 + sr, sc * 2)) = g1; } while (0)
#define XWRITE_V(bb) do { *(LAS bf16x8*)(V_lds + (bb) * SHM_V + vst0) = g0; *(LAS bf16x8*)(V_lds + (bb) * SHM_V + vst1) = g1; } while (0)
    __syncthreads();
    XLOAD(0, 0); XWRITE_K(0); XLOAD(1, 0);
    __syncthreads();
#pragma unroll 1
    for (int dc = 0; dc < 4; ++dc) {
        bf16x8 qr[8];
#pragma unroll
        for (int d0 = 0; d0 < 8; ++d0) qr[d0] = *(const GAS bf16x8*)(Qw + dc * 128 + d0 * 16);
#pragma unroll
        for (int t = 0; t < 4; ++t) { const int step = dc * 4 + t;
            if (step + 1 < 16) XWRITE_K((t & 1) ^ 1);
            if (step + 2 < 16) XLOAD(step + 2, 0);
            qkt_acc(s0[t], s1[t], K_lds + (t & 1) * SHM_K, qr, r32, hi);
            __syncthreads(); }
    }
    constexpr float C = 0.04419417382415922f * 1.4426950408889634f;
    float pmax = s0[0][0];
#pragma unroll
    for (int t = 0; t < 4; ++t)
#pragma unroll
        for (int r = 0; r < 16; ++r) pmax = fmaxf(pmax, fmaxf(s0[t][r], s1[t][r]));
    { auto rr = __builtin_amdgcn_permlane32_swap(__float_as_uint(pmax), __float_as_uint(pmax), false, false); pmax = fmaxf(__uint_as_float(rr[0]), __uint_as_float(rr[1])); }
    const float mC = -pmax * C; float ps = 0.f;
#pragma unroll
    for (int t = 0; t < 4; ++t)
#pragma unroll
        for (int r = 0; r < 16; ++r) { s0[t][r] = __builtin_amdgcn_exp2f(fmaf(s0[t][r], C, mC)); s1[t][r] = __builtin_amdgcn_exp2f(fmaf(s1[t][r], C, mC)); ps += s0[t][r] + s1[t][r]; }
    { auto rr = __builtin_amdgcn_permlane32_swap(__float_as_uint(ps), __float_as_uint(ps), false, false); ps = __uint_as_float(rr[0]) + __uint_as_float(rr[1]); }
    bf16x8 pa[4][4];
#define PK4(P, BASE, OUT) do { unsigned a0 = cvtpk(P[BASE + 0], P[BASE + 1]), a1 = cvtpk(P[BASE + 2], P[BASE + 3]);   \
    unsigned b0 = cvtpk(P[BASE + 4], P[BASE + 5]), b1 = cvtpk(P[BASE + 6], P[BASE + 7]);                              \
    auto r0 = __builtin_amdgcn_permlane32_swap(a0, b0, false, false); auto r1 = __builtin_amdgcn_permlane32_swap(a1, b1, false, false); \
    v4u w = {r0[0], r1[0], r0[1], r1[1]}; OUT = __builtin_bit_cast(bf16x8, w); } while (0)
#pragma unroll
    for (int t = 0; t < 4; ++t) { PK4(s0[t], 0, pa[t][0]); PK4(s0[t], 8, pa[t][1]); PK4(s1[t], 0, pa[t][2]); PK4(s1[t], 8, pa[t][3]); }
#undef PK4
    if (hi == 0) wsl[r32] = ps; asm volatile("s_waitcnt lgkmcnt(0)" ::: "memory");
    float rli[16];
#pragma unroll
    for (int r = 0; r < 16; ++r) rli[r] = __builtin_amdgcn_rcpf(wsl[crow(r, hi)]);
    XLOAD(0, DM); XWRITE_V(0); XLOAD(1, DM);
    __syncthreads();
    bf16* Ow = XOo + ((size_t)b * SEQ + qt * 256 + wid * QBLK) * DM + h * 512;
#pragma unroll 1
    for (int dc = 0; dc < 4; ++dc) {
        f32x16 o[4];
#pragma unroll
        for (int i = 0; i < 4; ++i)
#pragma unroll
            for (int r = 0; r < 16; ++r) o[i][r] = 0.f;
#pragma unroll
        for (int t = 0; t < 4; ++t) { const int step = dc * 4 + t;
            if (step + 1 < 16) XWRITE_V((t & 1) ^ 1);
            if (step + 2 < 16) XLOAD(step + 2, DM);
            pv_d0(o, vb0 + (t & 1) * SHM_V, pa[t][0], pa[t][1], pa[t][2], pa[t][3]);
            __syncthreads(); }
#pragma unroll
        for (int r = 0; r < 16; ++r) { const int orow = crow(r, hi);
#pragma unroll
            for (int d0 = 0; d0 < 4; ++d0) Ow[(size_t)orow * DM + dc * 128 + d0 * 32 + r32] = bf1(o[d0][r] * rli[r]); }
    }
#undef XSRC
#undef XLOAD
#undef XWRITE_K
#undef XWRITE_V
#undef KSWZ
}
}

struct Args { const float* in[20]; float* out; unsigned char* ws; int ph_lo, ph_hi, li, pad; };
__global__ void __launch_bounds__(NWAVES * 64, 2) mk_fwd(Args args) {
    extern __shared__ __attribute__((aligned(16))) unsigned char lds[];
    Frame F;
    F.lds = (LAS unsigned char*)lds;
    F.MISC = (volatile LAS unsigned*)(F.lds + MISC_OFF);
    F.tid = threadIdx.x; F.lane = F.tid & 63; F.wave = __builtin_amdgcn_readfirstlane(F.tid >> 6);
    F.G = gridDim.x; { const int bx = blockIdx.x; F.vcu = (F.G % 8 == 0) ? (bx % 8) * (F.G / 8) + bx / 8 : bx; }
#pragma unroll
    for (int i = 0; i < 20; ++i) F.in[i] = args.in[i];
    F.out = args.out; F.ws = args.ws;
    unsigned char* ws = args.ws;
    F.ctl = (gu32*)(ws + WS_CTL);
    for (int u = F.tid; u < (LDS_BYTES - LDSCTL_OFF) / 4; u += NWAVES * 64) ((LAS unsigned*)(F.lds + LDSCTL_OFF))[u] = 0u;
    __syncthreads();
    XcdBarrier bar; bar.bar = (unsigned*)(F.ctl + CW_BAR); bar.x = 0; bar.st = nullptr;
    if (N_LAUNCHES != PER_PHASE) bar = xcd_barrier_post((unsigned*)(F.ctl + CW_BAR), F.MISC + 8);
#define GRID_BAR() do { if (N_LAUNCHES != PER_PHASE) xcd_barrier(bar); } while (0)
    const int lo = args.ph_lo, hi = args.ph_hi;
#ifdef ONLY_GLA
    gla_unit(F, F.vcu & 31, (bf16*)(ws + WS_ATT)); return;
#endif
#define IN(k) (lo <= (k) && (k) < hi)
#define BOTH(k) (IN(k) && IN((k) + 1))

    if (IN(0)) { p0_prologue(F); if (BOTH(0)) GRID_BAR(); }
    if (IN(1)) {
        { pg8::Gemm g{(const pg8::bf16_t*)(ws + WS_XB), (const pg8::bf16_t*)(ws + WS_WIN), TOK, NPROJ_PAD, DM}; pg8::StaticOrder S; S.init(TOK, NPROJ_PAD, F.G, (int)blockIdx.x);
          EpiProj E{(pg8::bf16_t*)(ws + WS_PROJ), (float*)(ws + WS_GATE)};
          pg8::gemm_phase<EpiProj, pg8::StaticOrder, PG8_ALIGN, PG8_SP2>(F.lds + RING_OFF, g, S, E); }
        { const int nu1 = (TOK / 256) * (NPROJ_PAD / 256); const int shift = nu1 % F.G; const int c2 = ((int)blockIdx.x - shift + F.G) % F.G;
          pg8::Gemm g{(const pg8::bf16_t*)(ws + WS_MEMB), (const pg8::bf16_t*)(ws + WS_WKV), BATCH * MEMLEN, 2 * DM, DM}; pg8::StaticOrder S; S.init(BATCH * MEMLEN, 2 * DM, F.G, c2);
          pg8::EpiBf16<0> E{(pg8::bf16_t*)(ws + WS_KV), 2 * DM, nullptr, 0, 0, 1.f};
          pg8::gemm_phase<pg8::EpiBf16<0>, pg8::StaticOrder, PG8_ALIGN, PG8_SP2>(F.lds + RING_OFF, g, S, E); }
        if (BOTH(1)) GRID_BAR();
    }
#if CHECK_GLA || CHECK_MOBA
    if (IN(2)) { kmean_phase(F); if (BOTH(2)) GRID_BAR(); }
#endif
    if (IN(3)) {
#if CHECK_GLA
        if (F.vcu < 32) { naive_gla_unit(F, F.vcu); gla_unit(F, F.vcu, (bf16*)(ws + WS_Z)); }
        else for (int u = F.vcu - 32; u < BATCH * 8 * 32; u += F.G - 32) naive_attn_unit<128, 64, 0>(F, u);
#elif CHECK_MOBA
        if (F.vcu < 32) gla_unit(F, F.vcu, (bf16*)(ws + WS_ATT));
        else for (int u = F.vcu - 32; u < BATCH * 8 * 32; u += F.G - 32) naive_attn_unit<128, 64, 0>(F, u);
        for (;;) { __syncthreads(); if (F.tid == 0) F.MISC[0] = __hip_atomic_fetch_add((unsigned*)(F.ctl + CW_Q), 1u, __ATOMIC_RELAXED, __HIP_MEMORY_SCOPE_AGENT); __syncthreads();
            const int u = (int)F.MISC[0]; if (u >= BATCH * 8 * 8) break; mb::moba_unit(F, u, (bf16*)(ws + WS_Z)); }
#else
        if (F.vcu < 32) gla_unit(F, F.vcu, (bf16*)(ws + WS_ATT));
        for (;;) { __syncthreads(); if (F.tid == 0) F.MISC[0] = __hip_atomic_fetch_add((unsigned*)(F.ctl + CW_Q), 1u, __ATOMIC_RELAXED, __HIP_MEMORY_SCOPE_AGENT); __syncthreads();
            const int u = (int)F.MISC[0]; if (u >= BATCH * 8 * 8) break; mb::moba_unit(F, u, (bf16*)(ws + WS_ATT)); }
#endif
        if (BOTH(3)) GRID_BAR();
#if CHECK_GLA
        check_diff_bf16(F, (const bf16*)(ws + WS_ATT), (const bf16*)(ws + WS_Z), 1024, 2048, F.ctl + CW_CHK); GRID_BAR();
#elif CHECK_MOBA
        check_diff_bf16(F, (const bf16*)(ws + WS_ATT), (const bf16*)(ws + WS_Z), 0, 1024, F.ctl + CW_CHK); GRID_BAR();
#endif
    }
    if (IN(4)) {
        pg8::Gemm g{(const pg8::bf16_t*)(ws + WS_ATT), (const pg8::bf16_t*)(ws + WS_WOUT), TOK, DM, DM}; pg8::StaticOrder S; S.init(TOK, DM, F.G, (int)blockIdx.x);
        EpiRes E{F.in[0], (float*)(ws + WS_Z), DN_ALPHA};
        pg8::gemm_phase<EpiRes, pg8::StaticOrder, PG8_ALIGN, PG8_SP2>(F.lds + RING_OFF, g, S, E);
        if (BOTH(4)) GRID_BAR();
    }
    if (IN(5)) { ln_phase(F, F.in[7], F.in[8]); if (BOTH(5)) GRID_BAR(); }
    if (IN(6)) {
        pg8::Gemm g{(const pg8::bf16_t*)(ws + WS_HB), (const pg8::bf16_t*)(ws + WS_WQ), TOK, DM, DM}; pg8::StaticOrder S; S.init(TOK, DM, F.G, (int)blockIdx.x);
        pg8::EpiBf16<0> E{(pg8::bf16_t*)(ws + WS_Q), DM, nullptr, 0, 0, 1.f};
        pg8::gemm_phase<pg8::EpiBf16<0>, pg8::StaticOrder, PG8_ALIGN, PG8_SP2>(F.lds + RING_OFF, g, S, E);
        if (BOTH(6)) GRID_BAR();
    }
    if (IN(7)) {
#if CHECK_XATT
        for (int u = F.vcu; u < BATCH * 4 * 32; u += F.G) naive_attn_unit<512, 32, 1>(F, u);
        for (int u = F.vcu; u < BATCH * 4 * 8; u += F.G) mb::xattn_unit(F, u, (bf16*)(ws + WS_ATT));
        GRID_BAR(); check_diff_bf16(F, (const bf16*)(ws + WS_XO), (const bf16*)(ws + WS_ATT), 0, 2048, F.ctl + CW_CHK);
#else
        for (int u = F.vcu; u < BATCH * 4 * 8; u += F.G) mb::xattn_unit(F, u, (bf16*)(ws + WS_XO));
#endif
        if (BOTH(7)) GRID_BAR(); }
    if (IN(8)) {
        pg8::Gemm g{(const pg8::bf16_t*)(ws + WS_XO), (const pg8::bf16_t*)(ws + WS_WO), TOK, DM, DM}; pg8::StaticOrder S; S.init(TOK, DM, F.G, (int)blockIdx.x);
        EpiRes E{(const float*)(ws + WS_Z), (float*)(ws + WS_Z), DN_ALPHA};
        pg8::gemm_phase<EpiRes, pg8::StaticOrder, PG8_ALIGN, PG8_SP2>(F.lds + RING_OFF, g, S, E);
        if (BOTH(8)) GRID_BAR();
    }
    if (IN(9)) {
        ln_phase(F, F.in[12], F.in[13]);
        cvt_fp8_rows(F, F.in[16], ws + WS_PU8, (float*)(ws + WS_SU), 16384);
        cvt_fp8_rows(F, F.in[17], ws + WS_PV8, (float*)(ws + WS_SV), 16384);
        if (BOTH(9)) GRID_BAR();
    }
    if (IN(10)) {
        pg8::Gemm g{(const pg8::bf16_t*)(ws + WS_HB), (const pg8::bf16_t*)(ws + WS_WPQ), TOK, DM, DM}; pg8::StaticOrder S; S.init(TOK, DM, F.G, (int)blockIdx.x);
        pg8::EpiBf16<0> E{(pg8::bf16_t*)(ws + WS_Q), DM, nullptr, 0, 0, 1.f};
        pg8::gemm_phase<pg8::EpiBf16<0>, pg8::StaticOrder, PG8_ALIGN, PG8_SP2>(F.lds + RING_OFF, g, S, E);
        if (BOTH(10)) GRID_BAR();
    }
    if (IN(11)) { peer_phase(F);
#if PROBE_PEER2
        peer_phase(F);
#endif
#if CHECK_ANY
        if (blockIdx.x == 0 && F.tid == 0) { const float md = __uint_as_float(__hip_atomic_load((unsigned*)(F.ctl + CW_CHK), __ATOMIC_RELAXED, __HIP_MEMORY_SCOPE_AGENT)); F.out[0] += 1000.f * md; }
#endif
    }
#undef IN
#undef BOTH
}

extern "C" void kernel_launch(void* const* d_in, const int* in_sizes, int n_in, void* d_out, int out_size, void* d_ws, size_t ws_size, hipStream_t stream) {
    static int grid = 0;
    if (grid == 0) {
        if (n_in != 20 || out_size != TOK * DM || ws_size < WS_END) { fprintf(stderr, "kernel_launch: unexpected shapes (n_in %d out %d ws %zu)\n", n_in, out_size, ws_size); grid = -1; return; }
        int dev = 0, cus = 0;
        if (hipGetDevice(&dev) != hipSuccess || hipDeviceGetAttribute(&cus, hipDeviceAttributeMultiprocessorCount, dev) != hipSuccess) { grid = -1; return; }
        if (hipFuncSetAttribute((const void*)mk_fwd, hipFuncAttributeMaxDynamicSharedMemorySize, LDS_BYTES) != hipSuccess) { fprintf(stderr, "kernel_launch: hipFuncSetAttribute failed\n"); grid = -1; return; }
        (void)hipGetLastError();
        grid = cus;
    }
    if (grid < 0) return;
    (void)hipMemsetAsync((char*)d_ws + WS_CTL, 0, CTL_ZERO_BYTES, stream);
    Args a{};
    for (int i = 0; i < 20; ++i) a.in[i] = (const float*)d_in[i];
    a.out = (float*)d_out; a.ws = (unsigned char*)d_ws;
    if (N_LAUNCHES == 1) { a.ph_lo = 0; a.ph_hi = PER_PHASE; a.li = 0; hipLaunchKernelGGL(mk_fwd, dim3(grid), dim3(NWAVES * 64), LDS_BYTES, stream, a); }
    else for (int li = 0; li < PER_PHASE; ++li) { a.ph_lo = li; a.ph_hi = li + 1; a.li = li; hipLaunchKernelGGL(mk_fwd, dim3(grid), dim3(NWAVES * 64), LDS_BYTES, stream, a); }
}
```
